# Optimizing an MI355X kernel written in HIP

```python
import math
import jax, jax.numpy as jnp
from jax import lax
import numpy as np

D_MODEL = 1024
BATCH = 8
SEQ = 2048
DEPTH = 1

GRID_W = 64
CTX_LEN = 256

D_MIX = D_MODEL
D_RNN = D_MIX // 2
D_HYENA = D_MIX - D_RNN
RNN_HEADS = 8
RNN_HEAD_DIM = D_RNN // RNN_HEADS
RNN_CONV_W = 4
RNN_CONV_LEFT = 2
LRU_C = 8.0
HYENA_ORDER = 2
HYENA_SHORT_W = 3
FILTER_EMB = 33
FILTER_HIDDEN = 64
DECAY_FAST_PCT = 0.3
DECAY_SLOW_PCT = 1.5
DECAY_TARGET = 1e-2
N_GROUPS = 4
EXPERTS_PER_GROUP = 8
N_EXPERTS = N_GROUPS * EXPERTS_PER_GROUP
TOP_K = 2
D_EXPERT = 512
N_MOD = 6
EPS = 1e-6
D_IN = 2 * D_RNN + (HYENA_ORDER + 1) * D_HYENA

kernel_name = "hybrid_rglru_hyena_hmoe_dit_block"

F32 = jnp.float32


def _rmsnorm(u, g):
    u32 = u.astype(F32)
    y = u32 * lax.rsqrt(jnp.mean(u32 * u32, axis=-1, keepdims=True) + EPS) * g.astype(F32)
    return y.astype(u.dtype)


def _modulate(h, shift, scale):
    return h * (1 + scale) + shift


def _sincos_2d(rows, cols, dim):
    quarter = dim // 4
    omega = 1.0 / (10000.0 ** (jnp.arange(quarter, dtype=F32) / quarter))
    ang_r = jnp.arange(rows, dtype=F32)[:, None] * omega
    ang_c = jnp.arange(cols, dtype=F32)[:, None] * omega
    emb_r = jnp.concatenate([jnp.sin(ang_r), jnp.cos(ang_r)], axis=-1)
    emb_c = jnp.concatenate([jnp.sin(ang_c), jnp.cos(ang_c)], axis=-1)
    pe = jnp.concatenate([jnp.broadcast_to(emb_r[:, None, :], (rows, cols, 2 * quarter)),
                          jnp.broadcast_to(emb_c[None, :, :], (rows, cols, 2 * quarter))], axis=-1)
    return pe.reshape(rows * cols, 4 * quarter)


def _dwconv(u, w, pad_left):
    k_w = w.shape[0]
    n = u.shape[1]
    up = jnp.pad(u, ((0, 0), (pad_left, k_w - 1 - pad_left), (0, 0)))
    y = up[:, 0:n] * w[0]
    for k in range(1, k_w):
        y = y + up[:, k:k + n] * w[k]
    return y


def _block_diag(u, w, b):
    bn, n, _ = u.shape
    uh = u.reshape(bn, n, RNN_HEADS, RNN_HEAD_DIM)
    return jnp.einsum("blhi,hij->blhj", uh, w).reshape(bn, n, D_RNN) + b


def _linear_scan(a, b, h0, reverse):
    if reverse:
        b = b.at[:, -1].add(a[:, -1] * h0)
    else:
        b = b.at[:, 0].add(a[:, 0] * h0)

    def combine(left, right):
        a_l, b_l = left
        a_r, b_r = right
        return a_l * a_r, a_r * b_l + b_r

    _, h = lax.associative_scan(combine, (a, b), axis=1, reverse=reverse)
    return h


def _rglru_scan(u, h0, wa, ba, wx, bx, lam, reverse):
    r = jax.nn.sigmoid(_block_diag(u, wa, ba))
    i = jax.nn.sigmoid(_block_diag(u, wx, bx))
    log_a = -LRU_C * r * jax.nn.softplus(-lam)
    a = jnp.exp(log_a)
    b = jnp.sqrt(-jnp.expm1(2.0 * log_a)) * (i * u)
    return _linear_scan(a, b, h0, reverse)


def _rglru_bidir(u_ctx, u_lat, conv_w, conv_b, wa, ba, wx, bx, lam):
    cw = conv_w.astype(F32)
    cb = conv_b.astype(F32)
    v_ctx = _dwconv(u_ctx.astype(F32), cw, RNN_CONV_LEFT) + cb
    v_lat = _dwconv(u_lat.astype(F32), cw, RNN_CONV_LEFT) + cb
    h0 = jnp.zeros((u_ctx.shape[0], D_RNN), F32)
    fwd = (wa[0].astype(F32), ba[0].astype(F32), wx[0].astype(F32), bx[0].astype(F32), lam[0].astype(F32))
    bwd = (wa[1].astype(F32), ba[1].astype(F32), wx[1].astype(F32), bx[1].astype(F32), lam[1].astype(F32))
    hf_ctx = _rglru_scan(v_ctx, h0, *fwd, reverse=False)
    hb_ctx = _rglru_scan(v_ctx, h0, *bwd, reverse=True)
    hf_lat = _rglru_scan(v_lat, hf_ctx[:, -1], *fwd, reverse=False)
    hb_lat = _rglru_scan(v_lat, hb_ctx[:, 0], *bwd, reverse=True)
    return hf_ctx, hb_ctx, hf_lat + hb_lat


def _hyena_filters(n, w1, b1, f1, w2, b2, f2, w3, b3):
    bands = (FILTER_EMB - 1) // 2
    pos = jnp.arange(n, dtype=F32)
    t = pos / max(n - 1, 1)
    ang = (2.0 * math.pi * pos / n)[:, None] * jnp.linspace(1e-4, bands - 1, bands, dtype=F32)[None, :]
    z = jnp.concatenate([t[:, None], jnp.cos(ang), -jnp.sin(ang)], axis=-1)
    hdn = jnp.sin(f1.astype(F32) * (z @ w1.astype(F32) + b1.astype(F32)))
    hdn = jnp.sin(f2.astype(F32) * (hdn @ w2.astype(F32) + b2.astype(F32)))
    k = (hdn @ w3.astype(F32) + b3.astype(F32)).reshape(n, 2, HYENA_ORDER, D_HYENA)
    min_decay = math.log(DECAY_TARGET) / DECAY_SLOW_PCT
    max_decay = math.log(DECAY_TARGET) / DECAY_FAST_PCT
    deltas = jnp.abs(jnp.linspace(min_decay, max_decay, D_HYENA, dtype=F32))
    k = k * jnp.exp(-t[:, None] * deltas[None, :])[:, None, None, :]
    g = jnp.concatenate([k[:, 0], jnp.zeros((1, HYENA_ORDER, D_HYENA), F32), k[:0:-1, 1]], axis=0)
    g = g / jnp.sum(jnp.abs(g), axis=0, keepdims=True)
    return jnp.fft.rfft(g, axis=0)


def _long_conv(u, spec, bias):
    n = u.shape[1]
    y = jnp.fft.irfft(jnp.fft.rfft(u, n=2 * n, axis=1) * spec[None], n=2 * n, axis=1)[:, :n]
    return y + u * bias


def _hyena(u, conv_w, fbias, w1, b1, f1, w2, b2, f2, w3, b3):
    n = u.shape[1]
    z_all = _dwconv(u.astype(F32), conv_w.astype(F32), HYENA_SHORT_W // 2)
    v, *gates = jnp.split(z_all, HYENA_ORDER + 1, axis=-1)
    spec = _hyena_filters(n, w1, b1, f1, w2, b2, f2, w3, b3)
    fb = fbias.astype(F32)
    z = v
    for o in range(HYENA_ORDER):
        z = gates[o] * _long_conv(z, spec[:, o], fb[o])
    return z


def _merge(ya, yb, g_a, g_b, w_out, dt):
    y = jnp.concatenate([_rmsnorm(ya, g_a), _rmsnorm(yb, g_b)], axis=-1).astype(dt)
    return y @ w_out


def _moe(h, w_rg, b_rg, w_re, b_re, w_gate, w_up, w_down):
    shp = h.shape
    t = h.reshape(-1, shp[-1])
    t32 = t.astype(F32)
    g_prob = jax.nn.softmax(t32 @ w_rg.astype(F32) + b_rg.astype(F32), axis=-1)
    g_p, g_i = lax.top_k(g_prob, 1)
    g_onehot = jax.nn.one_hot(g_i[:, 0], N_GROUPS, dtype=F32)
    e_logits = (t32 @ w_re.astype(F32) + b_re.astype(F32)).reshape(-1, N_GROUPS, EXPERTS_PER_GROUP)
    e_prob = jax.nn.softmax(jnp.einsum("tge,tg->te", e_logits, g_onehot), axis=-1)
    e_p, e_i = lax.top_k(e_prob, TOP_K)
    wts = g_p * e_p / jnp.sum(e_p, axis=-1, keepdims=True)
    idx = g_i * EXPERTS_PER_GROUP + e_i
    combine = jnp.einsum("tk,tke->te", wts, jax.nn.one_hot(idx, N_EXPERTS, dtype=F32)).astype(t.dtype)
    out = jnp.zeros_like(t)
    for e in range(N_EXPERTS):
        ye = (jax.nn.silu(t @ w_gate[e]) * (t @ w_up[e])) @ w_down[e]
        out = out + combine[:, e:e + 1] * ye
    return out.reshape(shp)


def setup_inputs(seed: int = 0) -> dict:
    key = jax.random.key(seed)
    ks = iter(jax.random.split(key, 48))
    D = D_MODEL

    def nrm(shape, scale):
        return scale * jax.random.normal(next(ks), shape, F32)

    lam_u = jax.random.uniform(next(ks), (DEPTH, 2, D_RNN), F32, 0.9, 0.999)
    a0 = lam_u ** (1.0 / LRU_C)
    lam = jnp.log(a0) - jnp.log1p(-a0)
    return {
        "x": nrm((BATCH, SEQ, D), 1.0),
        "c": nrm((BATCH, D), 1.0),
        "ctx": nrm((BATCH, CTX_LEN, D), 1.0),
        "c_ctx": nrm((D,), 1.0),
        "w_ada": nrm((DEPTH, D, N_MOD * D), 0.5 * D ** -0.5),
        "b_ada": nrm((DEPTH, N_MOD * D), 0.01),
        "norm1_g": 1.0 + nrm((DEPTH, D), 0.02),
        "w_in": nrm((DEPTH, D, D_IN), D ** -0.5),
        "conv_a_w": nrm((DEPTH, RNN_CONV_W, D_RNN), RNN_CONV_W ** -0.5),
        "conv_a_b": nrm((DEPTH, D_RNN), 0.01),
        "lru_wa": nrm((DEPTH, 2, RNN_HEADS, RNN_HEAD_DIM, RNN_HEAD_DIM), RNN_HEAD_DIM ** -0.5),
        "lru_ba": nrm((DEPTH, 2, D_RNN), 0.01),
        "lru_wx": nrm((DEPTH, 2, RNN_HEADS, RNN_HEAD_DIM, RNN_HEAD_DIM), RNN_HEAD_DIM ** -0.5),
        "lru_bx": nrm((DEPTH, 2, D_RNN), 0.01),
        "lru_lambda": lam,
        "conv_b_w": nrm((DEPTH, HYENA_SHORT_W, (HYENA_ORDER + 1) * D_HYENA), HYENA_SHORT_W ** -0.5),
        "filt_w1": nrm((DEPTH, FILTER_EMB, FILTER_HIDDEN), FILTER_EMB ** -0.5),
        "filt_b1": nrm((DEPTH, FILTER_HIDDEN), 0.1),
        "filt_freq1": 1.0 + nrm((DEPTH, FILTER_HIDDEN), 0.02),
        "filt_w2": nrm((DEPTH, FILTER_HIDDEN, FILTER_HIDDEN), FILTER_HIDDEN ** -0.5),
        "filt_b2": nrm((DEPTH, FILTER_HIDDEN), 0.1),
        "filt_freq2": 1.0 + nrm((DEPTH, FILTER_HIDDEN), 0.02),
        "filt_w3": nrm((DEPTH, FILTER_HIDDEN, 2 * HYENA_ORDER * D_HYENA), FILTER_HIDDEN ** -0.5),
        "filt_b3": nrm((DEPTH, 2 * HYENA_ORDER * D_HYENA), 0.01),
        "filt_bias": nrm((DEPTH, HYENA_ORDER, D_HYENA), 0.1),
        "out_norm_a": 1.0 + nrm((DEPTH, D_RNN), 0.02),
        "out_norm_b": 1.0 + nrm((DEPTH, D_HYENA), 0.02),
        "w_out": nrm((DEPTH, D_MIX, D), D_MIX ** -0.5),
        "norm2_g": 1.0 + nrm((DEPTH, D), 0.02),
        "w_rg": nrm((DEPTH, D, N_GROUPS), D ** -0.5),
        "b_rg": nrm((DEPTH, N_GROUPS), 0.01),
        "w_re": nrm((DEPTH, D, N_EXPERTS), D ** -0.5),
        "b_re": nrm((DEPTH, N_EXPERTS), 0.01),
        "w_gate": nrm((DEPTH, N_EXPERTS, D, D_EXPERT), D ** -0.5),
        "w_up": nrm((DEPTH, N_EXPERTS, D, D_EXPERT), D ** -0.5),
        "w_down": nrm((DEPTH, N_EXPERTS, D_EXPERT, D), D_EXPERT ** -0.5),
        "final_g": 1.0 + nrm((D,), 0.02),
    }


def reference(x, c, ctx, c_ctx, w_ada, b_ada, norm1_g, w_in, conv_a_w, conv_a_b, lru_wa, lru_ba,
              lru_wx, lru_bx, lru_lambda, conv_b_w, filt_w1, filt_b1, filt_freq1, filt_w2, filt_b2,
              filt_freq2, filt_w3, filt_b3, filt_bias, out_norm_a, out_norm_b, w_out, norm2_g,
              w_rg, b_rg, w_re, b_re, w_gate, w_up, w_down, final_g):
    dt = x.dtype
    n_lat = x.shape[1]
    rows = n_lat // GRID_W
    x = x + _sincos_2d(rows, GRID_W, x.shape[-1]).astype(dt)[None]
    xc = ctx
    for l in range(DEPTH):
        last = l == DEPTH - 1
        mod = jax.nn.silu(c) @ w_ada[l] + b_ada[l]
        mod_c = jax.nn.silu(c_ctx) @ w_ada[l] + b_ada[l]
        sh1, sc1, g1, sh2, sc2, g2 = jnp.split(mod[:, None, :], N_MOD, axis=-1)
        csh1, csc1, cg1, csh2, csc2, cg2 = jnp.split(mod_c, N_MOD, axis=-1)

        p = _modulate(_rmsnorm(x, norm1_g[l]), sh1, sc1) @ w_in[l]
        pc = _modulate(_rmsnorm(xc, norm1_g[l]), csh1, csc1) @ w_in[l]
        filt = (filt_w1[l], filt_b1[l], filt_freq1[l], filt_w2[l], filt_b2[l], filt_freq2[l],
                filt_w3[l], filt_b3[l])

        hf_ctx, hb_ctx, rnn_lat = _rglru_bidir(pc[..., D_RNN:2 * D_RNN], p[..., D_RNN:2 * D_RNN],
                                               conv_a_w[l], conv_a_b[l], lru_wa[l], lru_ba[l],
                                               lru_wx[l], lru_bx[l], lru_lambda[l])
        ya = jax.nn.gelu(p[..., :D_RNN].astype(F32), approximate=True) * rnn_lat
        yb = _hyena(p[..., 2 * D_RNN:], conv_b_w[l], filt_bias[l], *filt)
        y = _merge(ya, yb, out_norm_a[l], out_norm_b[l], w_out[l], dt)

        if not last:
            yac = jax.nn.gelu(pc[..., :D_RNN].astype(F32), approximate=True) * (hf_ctx + hb_ctx)
            ybc = _hyena(pc[..., 2 * D_RNN:], conv_b_w[l], filt_bias[l], *filt)
            xc = xc + cg1 * _merge(yac, ybc, out_norm_a[l], out_norm_b[l], w_out[l], dt)
            hc2 = _modulate(_rmsnorm(xc, norm2_g[l]), csh2, csc2)
            xc = xc + cg2 * _moe(hc2, w_rg[l], b_rg[l], w_re[l], b_re[l], w_gate[l], w_up[l], w_down[l])

        x = x + g1 * y
        h2 = _modulate(_rmsnorm(x, norm2_g[l]), sh2, sc2)
        x = x + g2 * _moe(h2, w_rg[l], b_rg[l], w_re[l], b_re[l], w_gate[l], w_up[l], w_down[l])
    return _rmsnorm(x, final_g)
```

```cpp
#include <hip/hip_runtime.h>
#include <math.h>
#include <stdint.h>
#include <stdio.h>

#define B_ 8
#define S_ 2048
#define D_ 1024
#define CT_ 256
#define NL_ (B_ * S_)
#define NC_ (B_ * CT_)
#define DIN_ 2560
#define NTHR 512
#ifndef REP_MASK
#define REP_MASK 0
#endif

typedef unsigned short bf16_t;
typedef __attribute__((ext_vector_type(8))) short bf16x8;
typedef __attribute__((ext_vector_type(16))) float f32x16;
typedef __attribute__((ext_vector_type(4))) float f32x4;
#define DI __device__ __forceinline__
#define MFMA32(a, b, c) __builtin_amdgcn_mfma_f32_32x32x16_bf16((a), (b), (c), 0, 0, 0)

DI bf16_t f2bf(float x) {
    unsigned u = __float_as_uint(x);
    u += 0x7fffu + ((u >> 16) & 1u);
    return (bf16_t)(u >> 16);
}
DI float bf2f(bf16_t v) { return __uint_as_float(((unsigned)v) << 16); }
DI unsigned pack2(float lo, float hi) { return (unsigned)f2bf(lo) | ((unsigned)f2bf(hi) << 16); }
DI float sigmoidf_(float x) { return 1.f / (1.f + expf(-x)); }
DI float shx(float v, int mask, int lane) { return __int_as_float(__builtin_amdgcn_ds_bpermute((lane ^ mask) << 2, __float_as_int(v))); }

#define OFF_CTL 0ull
#define CTL_BYTES 65536ull
#define OFF_MOD (OFF_CTL + CTL_BYTES)
#define OFF_PE (OFF_MOD + 262144ull)
#define OFF_HDN2 (OFF_PE + 131072ull)
#define OFF_NRM2 (OFF_HDN2 + 262144ull)
#define OFF_RALL (OFF_NRM2 + 8192ull)
#define OFF_WIN_T (OFF_RALL + 8404992ull)
#define OFF_WOUT_T (OFF_WIN_T + 5242880ull)
#define OFF_WRNN_T (OFF_WOUT_T + 2097152ull)
#define OFF_WR_T (OFF_WRNN_T + 262144ull)
#define OFF_WG_T (OFF_WR_T + 131072ull)
#define OFF_WU_T (OFF_WG_T + 33554432ull)
#define OFF_WD_T (OFF_WU_T + 33554432ull)
#define OFF_PHT (OFF_WD_T + 33554432ull)
#define OFF_PA (OFF_PHT + 50331648ull)
#define OFF_PU (OFF_PA + 16777216ull)
#define OFF_H1 (OFF_PU + 18874368ull)
#define OFF_HS (OFF_H1 + 37748736ull)
#define OFF_YBT (OFF_HS + 33554432ull)
#define OFF_H2 OFF_H1
#define OFF_YN (OFF_H1 + 0ull)
#define OFF_ACT OFF_HS
#define OFF_SLOT OFF_PHT
#define OFF_LIST (OFF_YBT + 16777216ull)
#define OFF_TOKSLOT (OFF_LIST + 2097152ull)
#define OFF_EW (OFF_TOKSLOT + 131072ull)
#define WS_END (OFF_EW + 131072ull)
#define QUEUE_WORD 4096

struct Params {
    const float* in[37];
    float* out;
    char* ws;
};

#define XB_TMO 128
#define XB_XCNT(j) (256 + 64 * (j))
#define XB_XSUB(j) (1280 + 64 * (j))
#define XB_XGEN(j) (2304 + 64 * (j))
#define XB_TOP 3328
#define XB_TOPGEN 3392
#define XCD_BAR_WORDS 3456
#define XB_SPIN_CAP (1u << 18)

DI unsigned xb_ld(unsigned* p) { return __hip_atomic_load(p, __ATOMIC_RELAXED, __HIP_MEMORY_SCOPE_AGENT); }
DI unsigned xb_add(unsigned* p, unsigned v) { return __hip_atomic_fetch_add(p, v, __ATOMIC_RELAXED, __HIP_MEMORY_SCOPE_AGENT); }
DI unsigned xb_xcc_id() { return (unsigned)__builtin_amdgcn_s_getreg((3 << 11) | 20) & 0xFu; }
#define XB_SPIN(cond, bar)                                                         \
    do {                                                                           \
        unsigned _sp = 0;                                                          \
        while (cond) {                                                             \
            __builtin_amdgcn_s_sleep(1);                                           \
            if ((++_sp & 255u) == 0u) {                                            \
                if (xb_ld(&(bar)[XB_TMO])) break;                                  \
                if (_sp > XB_SPIN_CAP) { atomicAdd(&(bar)[XB_TMO], 1u); break; }   \
            }                                                                      \
        }                                                                          \
    } while (0)

struct XcdBarrier {
    unsigned* bar;
    unsigned x;
    volatile unsigned* st;
};
DI XcdBarrier xcd_barrier_post(unsigned* bar, volatile unsigned* st) {
    XcdBarrier b;
    b.bar = bar;
    b.x = xb_xcc_id();
    b.st = st;
    if (threadIdx.x == 0) (void)xb_add(&bar[XB_XCNT(b.x)], 1u);
    return b;
}
DI void xcd_barrier_complete(unsigned* bar, unsigned x, unsigned& nloc, unsigned& nx) {
    const unsigned G = gridDim.x * gridDim.y * gridDim.z;
    unsigned sum, cnt, mine, sp = 0u;
    for (;;) {
        sum = 0u; cnt = 0u; mine = 0u;
#pragma unroll
        for (unsigned j = 0; j < 16; ++j) {
            const unsigned c = xb_ld(&bar[XB_XCNT(j)]);
            sum += c;
            cnt += (c > 0u) ? 1u : 0u;
            mine = (j == x) ? c : mine;
        }
        if (sum == G) break;
        __builtin_amdgcn_s_sleep(1);
        if ((++sp & 255u) == 0u) {
            if (xb_ld(&bar[XB_TMO])) break;
            if (sp > XB_SPIN_CAP) { atomicAdd(&bar[XB_TMO], 1u); break; }
        }
    }
    nloc = mine > 0u ? mine : 1u;
    nx = cnt > 0u ? cnt : 1u;
}
DI void xcd_barrier(const XcdBarrier& b) {
    asm volatile("s_waitcnt vmcnt(0)" ::: "memory");
    __syncthreads();
    if (threadIdx.x == 0) {
        unsigned* bar = b.bar;
        __builtin_amdgcn_s_waitcnt(0);
        unsigned nloc = b.st[0], nx = b.st[1];
        if (nloc == 0u) {
            xcd_barrier_complete(bar, b.x, nloc, nx);
            b.st[0] = nloc;
            b.st[1] = nx;
        }
        const unsigned old = xb_add(&bar[XB_XSUB(b.x)], 1u);
        const unsigned gen = old / nloc;
        if (old + 1u == (gen + 1u) * nloc) {
            __builtin_amdgcn_fence(__ATOMIC_RELEASE, "agent");
            asm volatile("s_waitcnt vmcnt(0)" ::: "memory");
            const unsigned og = xb_add(&bar[XB_TOP], 1u);
            const unsigned tg = og / nx;
            if (og + 1u == (tg + 1u) * nx) xb_add(&bar[XB_TOPGEN], 1u);
            else XB_SPIN(xb_ld(&bar[XB_TOPGEN]) == tg, bar);
            __builtin_amdgcn_fence(__ATOMIC_ACQUIRE, "agent");
            xb_add(&bar[XB_XGEN(b.x)], 1u);
            asm volatile("s_waitcnt vmcnt(0)" ::: "memory");
        } else {
            XB_SPIN(xb_ld(&bar[XB_XGEN(b.x)]) == gen, bar);
            __builtin_amdgcn_fence(__ATOMIC_ACQUIRE, "agent");
            asm volatile("s_waitcnt vmcnt(0)" ::: "memory");
        }
    }
    __syncthreads();
}

#define LDS_BYTES 163840
#define LDS_MISC (LDS_BYTES - 1024)
#define LROW 144
#define A_STAGE (256 * LROW)
#define B_STAGE (128 * LROW)
#define STAGE_BYTES (A_STAGE + B_STAGE)

DI void conv_tile(const float* src, int ld_src, bf16_t* dst, int ld_dst, const float* rowscale, float* l, int tid) {
    __syncthreads();
    {
        int r = tid >> 3, c0 = (tid & 7) * 8;
        const float4* s = (const float4*)(src + (size_t)r * ld_src + c0);
        float4 v0 = s[0], v1 = s[1];
        float sc = rowscale ? rowscale[r] : 1.f;
        float* d = l + r * 65 + c0;
        d[0] = v0.x * sc; d[1] = v0.y * sc; d[2] = v0.z * sc; d[3] = v0.w * sc;
        d[4] = v1.x * sc; d[5] = v1.y * sc; d[6] = v1.z * sc; d[7] = v1.w * sc;
    }
    __syncthreads();
    {
        int n = tid >> 3, k0 = (tid & 7) * 8;
        uint4 o;
        o.x = pack2(l[(k0 + 0) * 65 + n], l[(k0 + 1) * 65 + n]);
        o.y = pack2(l[(k0 + 2) * 65 + n], l[(k0 + 3) * 65 + n]);
        o.z = pack2(l[(k0 + 4) * 65 + n], l[(k0 + 5) * 65 + n]);
        o.w = pack2(l[(k0 + 6) * 65 + n], l[(k0 + 7) * 65 + n]);
        *(uint4*)(dst + (size_t)n * ld_dst + k0) = o;
    }
}

#define NCONV_RNN 32
DI void conv_item(const Params& P, int it, char* lds, int tid) {
    float* l = (float*)lds;
    const int hh = it & 7, gate = (it >> 3) & 1, dir = it >> 4;
    const float* src = (gate ? P.in[12] : P.in[10]) + (size_t)(dir * 8 + hh) * 4096;
    conv_tile(src, 64, (bf16_t*)(P.ws + OFF_WRNN_T) + (size_t)(hh * 256 + (dir * 2 + gate) * 64) * 64, 64, nullptr, l, tid);
}

#define NG_WIN 160
#define NG_WOUT 64
#define NG_EXP 1024
#define NG_TOTAL (NG_WIN + NG_WOUT + 3 * NG_EXP)
#define CV_LD 257
struct ConvDesc { const float* src; bf16_t* dst; const float* rs; int ld_src, ld_dst; };
DI ConvDesc conv_desc(const Params& P, int g) {
    ConvDesc d;
    d.rs = nullptr;
    if (g < NG_WIN) {
        const int kt = g / 10, ng = g % 10;
        d.src = P.in[7] + (size_t)kt * 64 * DIN_ + ng * 256; d.ld_src = DIN_;
        d.dst = (bf16_t*)(P.ws + OFF_WIN_T) + (size_t)ng * 256 * 1024 + kt * 64; d.ld_dst = 1024;
    } else if (g < NG_WIN + NG_WOUT) {
        g -= NG_WIN;
        const int kt = g >> 2, ng = g & 3;
        d.src = P.in[27] + (size_t)kt * 64 * 1024 + ng * 256; d.ld_src = 1024;
        d.dst = (bf16_t*)(P.ws + OFF_WOUT_T) + (size_t)ng * 256 * 1024 + kt * 64; d.ld_dst = 1024;
        d.rs = (kt < 8) ? P.in[25] + kt * 64 : P.in[26] + (kt - 8) * 64;
    } else {
        g -= NG_WIN + NG_WOUT;
        const int which = g >> 10, rem0 = g & 1023, e = rem0 >> 5, rem = rem0 & 31;
        if (which < 2) {
            const int kt = rem >> 1, ng = rem & 1;
            d.src = P.in[33 + which] + (size_t)e * 1024 * 512 + (size_t)kt * 64 * 512 + ng * 256; d.ld_src = 512;
            d.dst = (bf16_t*)(P.ws + (which ? OFF_WU_T : OFF_WG_T)) + (size_t)(e * 512 + ng * 256) * 1024 + kt * 64; d.ld_dst = 1024;
        } else {
            const int kt = rem >> 2, ng = rem & 3;
            d.src = P.in[35] + (size_t)e * 512 * 1024 + (size_t)kt * 64 * 1024 + ng * 256; d.ld_src = 1024;
            d.dst = (bf16_t*)(P.ws + OFF_WD_T) + (size_t)(e * 1024 + ng * 256) * 512 + kt * 64; d.ld_dst = 512;
        }
    }
    return d;
}
DI void conv_load(const ConvDesc& d, float4 (&r)[8], int tid) {
#pragma unroll
    for (int i = 0; i < 8; ++i) {
        const int q = tid + NTHR * i;
        r[i] = *(const float4*)(d.src + (size_t)(q >> 6) * d.ld_src + (q & 63) * 4);
    }
}
DI void conv_groups(const Params& P, int g0, int g1, int stride, char* lds, int tid) {
    float* l = (float*)lds;
    float4 r[8];
    int g = g0;
    ConvDesc d;
    if (g < g1) { d = conv_desc(P, g); conv_load(d, r, tid); }
    while (g < g1) {
        __syncthreads();
#pragma unroll
        for (int i = 0; i < 8; ++i) {
            const int q = tid + NTHR * i, row = q >> 6, c = (q & 63) * 4;
            const float sc = d.rs ? d.rs[row] : 1.f;
            float* p = l + row * CV_LD + c;
            p[0] = r[i].x * sc; p[1] = r[i].y * sc; p[2] = r[i].z * sc; p[3] = r[i].w * sc;
        }
        const ConvDesc dc = d;
        const int gn = g + stride;
        if (gn < g1) { d = conv_desc(P, gn); conv_load(d, r, tid); }
        __syncthreads();
#pragma unroll
        for (int i = 0; i < 4; ++i) {
            const int q = tid + NTHR * i, n = q >> 3, k0 = (q & 7) * 8;
            const float* p = l + k0 * CV_LD + n;
            uint4 o;
            o.x = pack2(p[0], p[CV_LD]);
            o.y = pack2(p[2 * CV_LD], p[3 * CV_LD]);
            o.z = pack2(p[4 * CV_LD], p[5 * CV_LD]);
            o.w = pack2(p[6 * CV_LD], p[7 * CV_LD]);
            *(uint4*)(dc.dst + (size_t)n * dc.ld_dst + k0) = o;
        }
        g = gn;
    }
}

DI void mod_item(const Params& P, int it, char* lds, int tid) {
    float* sl = (float*)lds;
    float* red = sl + 9 * 1024;
    __syncthreads();
    for (int i = tid; i < 9 * 1024; i += NTHR) {
        int r = i >> 10, k = i & 1023;
        float v = (r < 8) ? P.in[1][r * 1024 + k] : P.in[3][k];
        sl[i] = v * sigmoidf_(v);
    }
    __syncthreads();
    const int w = tid >> 6, lane = tid & 63, col = lane & 31, kp = lane >> 5;
    const int n0 = it * 32;
    const float* wa = P.in[4] + n0 + col;
    float acc[9];
#pragma unroll
    for (int r = 0; r < 9; ++r) acc[r] = 0.f;
#pragma unroll 8
    for (int i = 0; i < 64; ++i) {
        int k = w * 128 + 2 * i + kp;
        float wv = wa[(size_t)k * 6144];
#pragma unroll
        for (int r = 0; r < 9; ++r) acc[r] += sl[r * 1024 + k] * wv;
    }
#pragma unroll
    for (int r = 0; r < 9; ++r) {
        acc[r] += shx(acc[r], 32, lane);
        if (kp == 0) red[(w * 9 + r) * 32 + col] = acc[r];
    }
    __syncthreads();
    if (tid < 9 * 32) {
        int r = tid >> 5, c = tid & 31;
        float s = P.in[5][n0 + c];
#pragma unroll
        for (int ww = 0; ww < 8; ++ww) s += red[(ww * 9 + r) * 32 + c];
        ((float*)(P.ws + OFF_MOD))[r * 6144 + n0 + c] = s;
    }
}

DI void pe_item(const Params& P, int it, int tid) {
    int p = it, i = tid & 255;
    float omega = 1.0f / powf(10000.0f, (float)i / 256.0f);
    float ang = (float)p * omega;
    ((float*)(P.ws + OFF_PE))[p * 512 + tid] = (tid < 256) ? sinf(ang) : cosf(ang);
}

DI void hdn_item(const Params& P, int it, char* lds, int tid) {
    const int w = tid >> 6, j = tid & 63;
    float* z = (float*)lds + w * 128;
    float* h1s = z + 64;
    const int t = it * 8 + w;
    __syncthreads();
    if (j < 33) {
        float val;
        if (j == 0) val = (float)t / 2047.f;
        else {
            int bi = (j - 1) & 15;
            float freq = 1e-4f + (float)bi * ((15.f - 1e-4f) / 15.f);
            float ang = (6.283185307179586f * (float)t / 2048.f) * freq;
            val = (j <= 16) ? cosf(ang) : -sinf(ang);
        }
        z[j] = val;
    }
    __syncthreads();
    float acc = P.in[17][j];
#pragma unroll 4
    for (int i = 0; i < 33; ++i) acc += z[i] * P.in[16][i * 64 + j];
    h1s[j] = sinf(P.in[18][j] * acc);
    __syncthreads();
    acc = P.in[20][j];
#pragma unroll 4
    for (int i = 0; i < 64; ++i) acc += h1s[i] * P.in[19][i * 64 + j];
    ((bf16_t*)(P.ws + OFF_HDN2))[t * 64 + j] = f2bf(sinf(P.in[21][j] * acc));
}

DI void wr_item(const Params& P, int j, int tid) {
    bf16_t* WRT = (bf16_t*)(P.ws + OFF_WR_T);
    {
        const int k = 16 * j + (tid >> 5), e = tid & 31;
        WRT[(4 + e) * 1024 + k] = f2bf(P.in[31][k * 32 + e]);
    }
    if (tid < 64) {
        const int k = 16 * j + (tid >> 2), n = tid & 3;
        WRT[n * 1024 + k] = f2bf(P.in[29][k * 4 + n]);
    }
    if (tid < 448) WRT[(36 + (tid >> 4)) * 1024 + 16 * j + (tid & 15)] = 0;
}
#define P0A_MOD 192
#define P0A_PE 128
#define P0A_HDN 256
#define P0A_GROUPS 1700
DI void phase0a(const Params& P, char* lds, int tid) {
    const int total = P0A_MOD + P0A_PE + P0A_HDN + NCONV_RNN;
    for (int it = blockIdx.x; it < total; it += gridDim.x) {
        if (it < P0A_MOD) mod_item(P, it, lds, tid);
        else if (it < P0A_MOD + P0A_PE) { if (it - P0A_MOD < 64) pe_item(P, it - P0A_MOD, tid); else wr_item(P, it - P0A_MOD - 64, tid); }
        else if (it < P0A_MOD + P0A_PE + P0A_HDN) hdn_item(P, it - P0A_MOD - P0A_PE, lds, tid);
        else conv_item(P, it - (P0A_MOD + P0A_PE + P0A_HDN), lds, tid);
    }
    conv_groups(P, blockIdx.x, P0A_GROUPS, gridDim.x, lds, tid);
}

DI void h1_item(const Params& P, int it, int tid) {
    const int w = tid >> 6, lane = tid & 63;
    const int row = it * 8 + w;
    const bool lat = row < NL_;
    const float* src = lat ? P.in[0] + (size_t)row * D_ : P.in[2] + (size_t)(row - NL_) * D_;
    const int b = lat ? (row >> 11) : 8;
    const int t = row & 2047;
    const float* mod = (const float*)(P.ws + OFF_MOD) + b * 6144;
    const float* pe = (const float*)(P.ws + OFF_PE);
    const float* g = P.in[6];
    float v[16];
    float ss = 0.f;
#pragma unroll
    for (int i = 0; i < 2; ++i) {
        const int d = i * 512 + lane * 8;
        float4 x0 = *(const float4*)(src + d), x1 = *(const float4*)(src + d + 4);
        if (lat) {
            const float* pp = (i == 0) ? pe + (t >> 6) * 512 + d : pe + (t & 63) * 512 + (d - 512);
            const float4 p0 = *(const float4*)pp, p1 = *(const float4*)(pp + 4);
            x0.x += p0.x; x0.y += p0.y; x0.z += p0.z; x0.w += p0.w;
            x1.x += p1.x; x1.y += p1.y; x1.z += p1.z; x1.w += p1.w;
        }
        v[i * 8 + 0] = x0.x; v[i * 8 + 1] = x0.y; v[i * 8 + 2] = x0.z; v[i * 8 + 3] = x0.w;
        v[i * 8 + 4] = x1.x; v[i * 8 + 5] = x1.y; v[i * 8 + 6] = x1.z; v[i * 8 + 7] = x1.w;
        ss += x0.x * x0.x + x0.y * x0.y + x0.z * x0.z + x0.w * x0.w + x1.x * x1.x + x1.y * x1.y + x1.z * x1.z + x1.w * x1.w;
    }
#pragma unroll
    for (int o = 32; o > 0; o >>= 1) ss += shx(ss, o, lane);
    const float rstd = rsqrtf(ss * (1.f / 1024.f) + 1e-6f);
    bf16_t* dst = (bf16_t*)(P.ws + OFF_H1) + (size_t)row * D_;
#pragma unroll
    for (int i = 0; i < 2; ++i) {
        const int d = i * 512 + lane * 8;
        float o[8];
#pragma unroll
        for (int hh = 0; hh < 2; ++hh) {
            const float4 gv = *(const float4*)(g + d + 4 * hh), sh = *(const float4*)(mod + d + 4 * hh), sc = *(const float4*)(mod + 1024 + d + 4 * hh);
            o[4 * hh + 0] = v[i * 8 + 4 * hh + 0] * rstd * gv.x * (1.f + sc.x) + sh.x;
            o[4 * hh + 1] = v[i * 8 + 4 * hh + 1] * rstd * gv.y * (1.f + sc.y) + sh.y;
            o[4 * hh + 2] = v[i * 8 + 4 * hh + 2] * rstd * gv.z * (1.f + sc.z) + sh.z;
            o[4 * hh + 3] = v[i * 8 + 4 * hh + 3] * rstd * gv.w * (1.f + sc.w) + sh.w;
        }
        *(uint4*)(dst + d) = make_uint4(pack2(o[0], o[1]), pack2(o[2], o[3]), pack2(o[4], o[5]), pack2(o[6], o[7]));
    }
}
#define P0B_H1 ((NL_ + NC_) / 8)
#define P0B_TAPS 64
DI void taps_item(const Params& P, int it, char* lds, int tid);
DI void phase0b(const Params& P, char* lds, int tid) {
    const int total = P0B_TAPS + P0B_H1;
    for (int it = blockIdx.x; it < total; it += gridDim.x) {
        if (it < P0B_TAPS) taps_item(P, it, lds, tid);
        else h1_item(P, it - P0B_TAPS, tid);
    }
    conv_groups(P, P0A_GROUPS + blockIdx.x, NG_TOTAL, gridDim.x, lds, tid);
}

#define GC_LOAD(S, kt_)                                                                                   \
    do {                                                                                                  \
        const int ko_ = (kt_) * 64;                                                                       \
        S##_a0 = *(const uint4*)(a0 + ko_); S##_a1 = *(const uint4*)(a1 + ko_); S##_a2 = *(const uint4*)(a2 + ko_); \
        S##_a3 = *(const uint4*)(a3 + ko_); S##_b0 = *(const uint4*)(b0 + ko_); S##_b1 = *(const uint4*)(b1 + ko_); \
    } while (0)
#define GC_STORE(S, st_)                                                                                  \
    do {                                                                                                  \
        char* s2_ = lds + (st_) * STAGE_BYTES;                                                            \
        *(uint4*)(s2_ + a_w) = S##_a0; *(uint4*)(s2_ + a_w + 64 * LROW) = S##_a1;                          \
        *(uint4*)(s2_ + a_w + 128 * LROW) = S##_a2; *(uint4*)(s2_ + a_w + 192 * LROW) = S##_a3;            \
        *(uint4*)(s2_ + b_w) = S##_b0; *(uint4*)(s2_ + b_w + 64 * LROW) = S##_b1;                          \
    } while (0)
#define GC_BODY(kt_, SL, SS)                                                                              \
    do {                                                                                                  \
        if ((kt_) + 3 < nk) GC_LOAD(SL, (kt_) + 3);                                                       \
        const char* s_ = lds + ((kt_) & 1) * STAGE_BYTES;                                                 \
        _Pragma("unroll") for (int ks = 0; ks < 4; ++ks) {                                                \
            const bf16x8 fa0 = *(const bf16x8*)(s_ + a_r + ks * 32);                                      \
            const bf16x8 fa1 = *(const bf16x8*)(s_ + a_r + 32 * LROW + ks * 32);                          \
            const bf16x8 fb0 = *(const bf16x8*)(s_ + b_r + ks * 32);                                      \
            const bf16x8 fb1 = *(const bf16x8*)(s_ + b_r + 32 * LROW + ks * 32);                          \
            if (SWAP) {                                                                                   \
                acc[0][0] = MFMA32(fb0, fa0, acc[0][0]); acc[0][1] = MFMA32(fb1, fa0, acc[0][1]);         \
                acc[1][0] = MFMA32(fb0, fa1, acc[1][0]); acc[1][1] = MFMA32(fb1, fa1, acc[1][1]);         \
            } else {                                                                                      \
                acc[0][0] = MFMA32(fa0, fb0, acc[0][0]); acc[0][1] = MFMA32(fa0, fb1, acc[0][1]);         \
                acc[1][0] = MFMA32(fa1, fb0, acc[1][0]); acc[1][1] = MFMA32(fa1, fb1, acc[1][1]);         \
            }                                                                                             \
        }                                                                                                 \
        if ((kt_) + 1 < nk) GC_STORE(SS, ((kt_) + 1) & 1);                                                \
        __syncthreads();                                                                                  \
    } while (0)

template <bool SWAP>
DI void gemm_core(f32x16 (&acc)[2][2], const bf16_t* a0, const bf16_t* a1, const bf16_t* a2, const bf16_t* a3,
                  const bf16_t* b0, const bf16_t* b1, int nk, char* lds, int tid) {
    const int lrow = tid >> 3, lchunk = tid & 7;
    const unsigned a_w = lrow * LROW + lchunk * 16;
    const unsigned b_w = A_STAGE + lrow * LROW + lchunk * 16;
    const int lane = tid & 63, w = tid >> 6, wm = w >> 1, wn = w & 1, r = lane & 31, h = lane >> 5;
    const unsigned a_r = (wm * 64 + r) * LROW + h * 16;
    const unsigned b_r = A_STAGE + (wn * 64 + r) * LROW + h * 16;
#pragma unroll
    for (int i = 0; i < 2; ++i)
#pragma unroll
        for (int j = 0; j < 2; ++j)
#pragma unroll
            for (int e = 0; e < 16; ++e) acc[i][j][e] = 0.f;
    uint4 S0_a0, S0_a1, S0_a2, S0_a3, S0_b0, S0_b1, S1_a0, S1_a1, S1_a2, S1_a3, S1_b0, S1_b1, S2_a0, S2_a1, S2_a2, S2_a3, S2_b0, S2_b1;
    GC_LOAD(S0, 0);
    GC_LOAD(S1, 1);
    GC_LOAD(S2, 2);
    __syncthreads();
    GC_STORE(S0, 0);
    __syncthreads();
    for (int kt = 0; kt < nk; kt += 3) {
        GC_BODY(kt, S0, S1);
        if (kt + 1 < nk) GC_BODY(kt + 1, S1, S2);
        if (kt + 2 < nk) GC_BODY(kt + 2, S2, S0);
    }
}

#define ET_ROW 272
DI void acc_to_lds(const f32x16 (&acc)[2][2], char* lds, int wm, int wn, int r, int h) {
#pragma unroll
    for (int i = 0; i < 2; ++i)
#pragma unroll
        for (int j = 0; j < 2; ++j)
#pragma unroll
            for (int e = 0; e < 16; ++e)
                *(bf16_t*)(lds + (wm * 64 + i * 32 + (e & 3) + 8 * (e >> 2) + 4 * h) * ET_ROW + (wn * 64 + j * 32 + r) * 2) = f2bf(acc[i][j][e]);
}
DI void lds_to_rows(char* lds, bf16_t* dst, int ld, int valid, int tid) {
#pragma unroll
    for (int i = 0; i < 8; ++i) {
        const int q = tid + NTHR * i, row = q >> 4, ch = q & 15;
        if (row < valid) *(uint4*)(dst + (size_t)row * ld + ch * 8) = *(const uint4*)(lds + row * ET_ROW + ch * 16);
    }
}
#define ETS_ROW 528
DI void acc_to_lds_swapped(const f32x16 (&acc)[2][2], char* lds, int wm, int wn, int r, int h) {
#pragma unroll
    for (int i = 0; i < 2; ++i)
#pragma unroll
        for (int j = 0; j < 2; ++j)
#pragma unroll
            for (int e = 0; e < 16; ++e)
                *(bf16_t*)(lds + (wn * 64 + j * 32 + (e & 3) + 8 * (e >> 2) + 4 * h) * ETS_ROW + (wm * 64 + i * 32 + r) * 2) = f2bf(acc[i][j][e]);
}

#define P1_NS (64 * 8 + 8 * 4)
#define P1_TILES (P1_NS + 64 * 12)
DI void phase1(const Params& P, char* lds, int tid) {
    const bf16_t* H1 = (const bf16_t*)(P.ws + OFF_H1);
    const bf16_t* WT = (const bf16_t*)(P.ws + OFF_WIN_T);
    bf16_t* PA = (bf16_t*)(P.ws + OFF_PA);
    bf16_t* PU = (bf16_t*)(P.ws + OFF_PU);
    bf16_t* PHT = (bf16_t*)(P.ws + OFF_PHT);
    const int lrow = tid >> 3, lchunk = tid & 7;
    const int lane = tid & 63, w = tid >> 6, wm = w >> 1, wn = w & 1, r = lane & 31, h = lane >> 5;
    int tile = blockIdx.x;
    for (; tile < P1_NS; tile += gridDim.x) {
        int m0, n0;
        if (tile < 512) { m0 = (tile >> 3) * 256; n0 = (tile & 7) * 128; }
        else { const int t2 = tile - 512; m0 = NL_ + (t2 >> 2) * 256; n0 = 512 + (t2 & 3) * 128; }
        const bf16_t* ap = H1 + (size_t)(m0 + lrow) * 1024 + lchunk * 8;
        const bf16_t* bp = WT + (size_t)(n0 + lrow) * 1024 + lchunk * 8;
        f32x16 acc[2][2];
        gemm_core<false>(acc, ap, ap + 64 * 1024, ap + 128 * 1024, ap + 192 * 1024, bp, bp + 64 * 1024, 16, lds, tid);
        acc_to_lds(acc, lds, wm, wn, r, h);
        __syncthreads();
        lds_to_rows(lds, ((n0 < 512) ? PA + n0 : PU + (n0 - 512)) + (size_t)m0 * 512, 512, 256, tid);
    }
    for (; tile < P1_TILES; tile += gridDim.x) {
        const int t2 = tile - P1_NS;
        const int m0 = (t2 / 12) * 256, n0 = 1024 + (t2 % 12) * 128;
        const bf16_t* ap = H1 + (size_t)(m0 + lrow) * 1024 + lchunk * 8;
        const bf16_t* bp = WT + (size_t)(n0 + lrow) * 1024 + lchunk * 8;
        f32x16 acc[2][2];
        gemm_core<true>(acc, ap, ap + 64 * 1024, ap + 128 * 1024, ap + 192 * 1024, bp, bp + 64 * 1024, 16, lds, tid);
        acc_to_lds_swapped(acc, lds, wm, wn, r, h);
        __syncthreads();
#pragma unroll
        for (int i = 0; i < 8; ++i) {
            const int q = tid + NTHR * i, row = q >> 5, ch = q & 31;
            *(uint4*)(PHT + (size_t)(n0 - 1024 + row) * NL_ + m0 + ch * 8) = *(const uint4*)(lds + row * ETS_ROW + ch * 16);
        }
    }
}

DI int crow(int e, int h) { return (e & 3) + 8 * (e >> 2) + 4 * h; }

DI void taps_item(const Params& P, int it, char* lds, int tid) {
    const int lane = tid & 63, w = __builtin_amdgcn_readfirstlane(tid >> 6), r = lane & 31, h = lane >> 5;
    const int col0 = it * 32;
    const int dir = col0 >> 10, o = (col0 >> 9) & 1;
    const float* w3 = P.in[22];
    const float* b3 = P.in[23];
    const bf16_t* HB = (const bf16_t*)(P.ws + OFF_HDN2);
    bf16_t* RALL = (bf16_t*)(P.ws + OFF_RALL);
    float* red = (float*)lds;
    __syncthreads();
    bf16x8 fa[4];
#pragma unroll
    for (int ks = 0; ks < 4; ++ks)
#pragma unroll
        for (int j = 0; j < 8; ++j) fa[ks][j] = (short)f2bf(w3[(size_t)(16 * ks + 8 * h + j) * 2048 + col0 + r]);
    float s[16];
#pragma unroll
    for (int e = 0; e < 16; ++e) s[e] = 0.f;
    const float mind = -3.0701134573253945f, maxd = -15.350567286626973f;
    for (int q = 0; q < 8; ++q) {
        const int t0 = (w * 8 + q) * 32, t = t0 + r;
        f32x16 acc;
#pragma unroll
        for (int e = 0; e < 16; ++e) acc[e] = 0.f;
#pragma unroll
        for (int ks = 0; ks < 4; ++ks) {
            bf16x8 fb = *(const bf16x8*)(HB + (size_t)t * 64 + 16 * ks + 8 * h);
            acc = MFMA32(fa[ks], fb, acc);
        }
        const float tt = (float)t / 2047.f;
        const bool valid = !(dir == 1 && t == 0);
#pragma unroll
        for (int e = 0; e < 16; ++e) {
            const int col = col0 + crow(e, h);
            const int c = col & 511;
            const float delta = fabsf(mind + (float)c * ((maxd - mind) / 511.f));
            const float val = (acc[e] + b3[col]) * __expf(-tt * delta);
            if (valid) s[e] += fabsf(val);
            *(bf16_t*)(lds + 4096 + crow(e, h) * 4112 + (dir ? t : 2048 - t) * 2) = f2bf(valid ? val : 0.f);
        }
    }
#pragma unroll
    for (int e = 0; e < 16; ++e) {
        float v = s[e];
        v += shx(v, 16, lane); v += shx(v, 8, lane); v += shx(v, 4, lane); v += shx(v, 2, lane); v += shx(v, 1, lane);
        if (r == 0) red[w * 32 + crow(e, h)] = v;
    }
    if (dir == 0 && tid < 32) *(bf16_t*)(lds + 4096 + tid * 4112) = 0;
    __syncthreads();
    if (tid < 32) {
        float v = 0.f;
#pragma unroll
        for (int ww = 0; ww < 8; ++ww) v += red[ww * 32 + tid];
        const int c = (col0 + tid) & 511;
        ((float*)(P.ws + OFF_NRM2))[(dir * 2 + o) * 512 + c] = v;
        bf16_t* R = RALL + (size_t)(c * 2 + o) * 4104;
        const bf16_t* img = (const bf16_t*)(lds + 4096 + tid * 4112);
        if (dir == 0) {
            R[2048] = img[2048];
            unsigned z = 0u;
            asm volatile("" : "+v"(z));
            *(uint4*)(R + 4096) = make_uint4(z, z, z, z);
        } else {
#pragma unroll
            for (int k = 1; k < 8; ++k) R[2048 + k] = img[k];
        }
    }
    for (int q = tid; q < 32 * 256; q += NTHR) {
        const int cl = q >> 8, k = q & 255;
        if (dir == 1 && k == 0) continue;
        const int c = (col0 + cl) & 511;
        *(uint4*)(RALL + (size_t)(c * 2 + o) * 4104 + (dir ? 2048 : 0) + 8 * k) = *(const uint4*)(lds + 4096 + cl * 4112 + 16 * k);
    }
}

#define HY_G 0
#define HY_GSTRIDE 8448
#define HY_GOFF(sh) ((0x8D518D50u >> (4 * (sh))) & 15u)
#define HY_U 67584
#define HY_UROW 6160
#define HY_PAD 15
#define HY_GATE (HY_U + 8 * HY_UROW)

DI void conv32(const bf16_t* src, int J, float w0, float w1, float w2, uint4 (&o)[4]) {
    const uint4* p = (const uint4*)(src + 32 * J);
    const uint4 q0 = p[0], q1 = p[1], q2 = p[2], q3 = p[3];
    const float prev = (J > 0) ? bf2f(src[32 * J - 1]) : 0.f;
    const float next = (J < 63) ? bf2f(src[32 * J + 32]) : 0.f;
    const unsigned wv[16] = {q0.x, q0.y, q0.z, q0.w, q1.x, q1.y, q1.z, q1.w, q2.x, q2.y, q2.z, q2.w, q3.x, q3.y, q3.z, q3.w};
    float x[34];
    x[0] = prev;
#pragma unroll
    for (int i = 0; i < 16; ++i) {
        x[1 + 2 * i] = __uint_as_float(wv[i] << 16);
        x[2 + 2 * i] = __uint_as_float(wv[i] & 0xffff0000u);
    }
    x[33] = next;
    unsigned y[16];
#pragma unroll
    for (int i = 0; i < 16; ++i) {
        const float a = w0 * x[2 * i] + w1 * x[2 * i + 1] + w2 * x[2 * i + 2];
        const float b = w0 * x[2 * i + 1] + w1 * x[2 * i + 2] + w2 * x[2 * i + 3];
        y[i] = pack2(a, b);
    }
    o[0] = make_uint4(y[0], y[1], y[2], y[3]);
    o[1] = make_uint4(y[4], y[5], y[6], y[7]);
    o[2] = make_uint4(y[8], y[9], y[10], y[11]);
    o[3] = make_uint4(y[12], y[13], y[14], y[15]);
}

DI void hyena_item(const Params& P, int c, char* lds, int tid) {
    const bf16_t* PHT = (const bf16_t*)(P.ws + OFF_PHT);
    const bf16_t* RALL = (const bf16_t*)(P.ws + OFF_RALL) + (size_t)c * 2 * 4104;
    const float* NRM2 = (const float*)(P.ws + OFF_NRM2);
    bf16_t* YBT = (bf16_t*)(P.ws + OFF_YBT);
    const float* cw = P.in[15];
    const int lane = tid & 63;
    const int w = __builtin_amdgcn_readfirstlane(tid >> 6);
    const int g = w & 3, par = w >> 2;
    const int h = lane >> 5, i_ = lane & 31;
    const int lb = tid >> 6, lJ = tid & 63;
    __syncthreads();
    for (int q = tid; q < 8 * 2 * 60; q += NTHR) {
        const int b = q / 120, rem = q % 120, side = rem / 60, k = rem % 60;
        *(uint4*)(lds + HY_U + b * HY_UROW + (side ? (HY_PAD + 64) * 64 : 0) + k * 16) = make_uint4(0u, 0u, 0u, 0u);
    }
    {
        uint4 o[4];
        conv32(PHT + (size_t)c * NL_ + lb * S_, lJ, cw[c], cw[1536 + c], cw[3072 + c], o);
        uint4* d = (uint4*)(lds + HY_U + lb * HY_UROW + (HY_PAD + lJ) * 64);
        d[0] = o[0]; d[1] = o[1]; d[2] = o[2]; d[3] = o[3];
        conv32(PHT + (size_t)(512 + c) * NL_ + lb * S_, lJ, cw[512 + c], cw[1536 + 512 + c], cw[3072 + 512 + c], o);
        uint4* e = (uint4*)(lds + HY_GATE + lb * 4096 + lJ * 64);
        e[0] = o[0]; e[1] = o[1]; e[2] = o[2]; e[3] = o[3];
    }
    const int sh_ = (-i_) & 7;
    const int a_base = HY_G + sh_ * HY_GSTRIDE + (int)HY_GOFF(sh_) * 16 + (2048 - i_ + 8 * h - sh_) * 2;
    const int batch = i_ >> 2, blk = i_ & 3;
    const int b_base = HY_U + batch * HY_UROW + ((HY_PAD + blk) * 32 + 8 * h) * 2;
    for (int o_ = 0; o_ < 2; ++o_) {
        __syncthreads();
        if (o_ == 1) {
            uint4 o[4];
            conv32(PHT + (size_t)(1024 + c) * NL_ + lb * S_, lJ, cw[1024 + c], cw[1536 + 1024 + c], cw[3072 + 1024 + c], o);
            uint4* e = (uint4*)(lds + HY_GATE + lb * 4096 + lJ * 64);
            e[0] = o[0]; e[1] = o[1]; e[2] = o[2]; e[3] = o[3];
        }
        {
            const uint4* Rg = (const uint4*)(RALL + (size_t)o_ * 4104);
            const uint4 lo = Rg[tid], hi = Rg[tid + 1];
            const unsigned wv[8] = {lo.x, lo.y, lo.z, lo.w, hi.x, hi.y, hi.z, hi.w};
#pragma unroll
            for (int sh = 0; sh < 8; ++sh) {
                const int s2 = sh >> 1;
                uint4 ov;
                if (sh & 1) {
                    ov.x = (wv[s2] >> 16) | (wv[s2 + 1] << 16);
                    ov.y = (wv[s2 + 1] >> 16) | (wv[s2 + 2] << 16);
                    ov.z = (wv[s2 + 2] >> 16) | (wv[s2 + 3] << 16);
                    ov.w = (wv[s2 + 3] >> 16) | (wv[s2 + 4] << 16);
                } else {
                    ov = make_uint4(wv[s2], wv[s2 + 1], wv[s2 + 2], wv[s2 + 3]);
                }
                *(uint4*)(lds + HY_G + sh * HY_GSTRIDE + (int)HY_GOFF(sh) * 16 + tid * 16) = ov;
            }
        }
        __syncthreads();
        f32x16 acc[4];
#pragma unroll
        for (int tt = 0; tt < 4; ++tt)
#pragma unroll
            for (int e = 0; e < 16; ++e) acc[tt][e] = 0.f;
#pragma unroll 2
        for (int D = 16 * g - 63 + par; D <= 16 * g + 15; D += 2) {
#pragma unroll
            for (int ks = 0; ks < 2; ++ks) {
                const bf16x8 fa = *(const bf16x8*)(lds + a_base + (-64 * D + 32 * ks));
#pragma unroll
                for (int tt = 0; tt < 4; ++tt) {
                    const bf16x8 fb = *(const bf16x8*)(lds + b_base + ((4 * (4 * g + tt) - D) * 64 + 32 * ks));
                    acc[tt] = MFMA32(fa, fb, acc[tt]);
                }
            }
        }
        __syncthreads();
        float* scr = (float*)(lds + HY_G);
        if (par == 1) {
#pragma unroll
            for (int tt = 0; tt < 4; ++tt)
#pragma unroll
                for (int e = 0; e < 16; ++e) scr[((g * 4 + tt) * 16 + e) * 64 + lane] = acc[tt][e];
        }
        __syncthreads();
        if (par == 0) {
            const float inv = 1.f / (NRM2[(0 * 2 + o_) * 512 + c] + NRM2[(1 * 2 + o_) * 512 + c]);
            const float bias = P.in[24][o_ * 512 + c];
#pragma unroll
            for (int tt = 0; tt < 4; ++tt) {
                const int I = 4 * (4 * g + tt) + blk;
#pragma unroll
                for (int q = 0; q < 4; ++q) {
                    const int i0 = 8 * q + 4 * h;
                    char* up = lds + HY_U + batch * HY_UROW + ((HY_PAD + I) * 32 + i0) * 2;
                    const uint2 uu = *(const uint2*)up;
                    const uint2 gg = *(const uint2*)(lds + HY_GATE + batch * 4096 + (32 * I + i0) * 2);
                    float rr[4];
#pragma unroll
                    for (int e = 0; e < 4; ++e) {
                        const float a = acc[tt][4 * q + e] + scr[((g * 4 + tt) * 16 + 4 * q + e) * 64 + lane];
                        const unsigned uw = (e < 2) ? uu.x : uu.y, gw = (e < 2) ? gg.x : gg.y;
                        const float uf = (e & 1) ? __uint_as_float(uw & 0xffff0000u) : __uint_as_float(uw << 16);
                        const float gf = (e & 1) ? __uint_as_float(gw & 0xffff0000u) : __uint_as_float(gw << 16);
                        rr[e] = gf * (a * inv + uf * bias);
                    }
                    uint2 ov;
                    ov.x = pack2(rr[0], rr[1]);
                    ov.y = pack2(rr[2], rr[3]);
                    *(uint2*)up = ov;
                }
            }
        }
    }
    __syncthreads();
    {
        const uint4* sp = (const uint4*)(lds + HY_U + lb * HY_UROW + (HY_PAD + lJ) * 64);
        uint4* gp = (uint4*)(YBT + (size_t)c * NL_ + lb * S_ + lJ * 32);
        gp[0] = sp[0]; gp[1] = sp[1]; gp[2] = sp[2]; gp[3] = sp[3];
    }
}

#define RN_V 0
#define RN_W 36864
#define RN_AGG 55296
#define RN_CARRY 59392

DI void rnn_item(const Params& P, int it, char* lds, int tid) {
    const int b = it >> 4, hd = (it >> 1) & 7, dir = it & 1;
    const bf16_t* PU = (const bf16_t*)(P.ws + OFF_PU);
    const bf16_t* WR = (const bf16_t*)(P.ws + OFF_WRNN_T);
    bf16_t* HS = (bf16_t*)(P.ws + OFF_HS) + (size_t)dir * NL_ * 512;
    const int lane = tid & 63, w = __builtin_amdgcn_readfirstlane(tid >> 6), r = lane & 31, h = lane >> 5;
    float* AGG = (float*)(lds + RN_AGG);
    float* CARRY = (float*)(lds + RN_CARRY);
    __syncthreads();
    for (int q = tid; q < 1024; q += NTHR) {
        const int n = q >> 3, ch = q & 7;
        *(uint4*)(lds + RN_W + n * LROW + ch * 16) = *(const uint4*)(WR + (size_t)(hd * 256 + dir * 128 + n) * 64 + ch * 8);
    }
    if (tid < 64) CARRY[tid] = 0.f;
    float ba[2], bx[2], sp[2];
#pragma unroll
    for (int jh = 0; jh < 2; ++jh) {
        const int ch = hd * 64 + jh * 32 + r;
        ba[jh] = P.in[11][dir * 512 + ch];
        bx[jh] = P.in[13][dir * 512 + ch];
        sp[jh] = log1pf(expf(-P.in[14][dir * 512 + ch]));
    }
    const int cc = tid & 7, tg = tid >> 3;
    for (int ci = 0; ci < 9; ++ci) {
        const bool isctx = (ci == 0);
        const int n = isctx ? CT_ : S_;
        const int tbase = isctx ? 0 : (dir ? (8 - ci) * 256 : (ci - 1) * 256);
        const bf16_t* src = (isctx ? PU + (size_t)(NL_ + b * CT_) * 512 : PU + (size_t)(b * S_) * 512) + hd * 64 + cc * 8;
        const int tlo = dir ? (tbase + 255 - 4 * tg - 3) : (tbase + 4 * tg);
        {
            float cwv[4][8], cbv[8];
            {
                const float4* cb4 = (const float4*)(P.in[9] + hd * 64 + cc * 8);
                const float4 c0 = cb4[0], c1 = cb4[1];
                cbv[0] = c0.x; cbv[1] = c0.y; cbv[2] = c0.z; cbv[3] = c0.w; cbv[4] = c1.x; cbv[5] = c1.y; cbv[6] = c1.z; cbv[7] = c1.w;
#pragma unroll
                for (int m = 0; m < 4; ++m) {
                    const float4* cw4 = (const float4*)(P.in[8] + m * 512 + hd * 64 + cc * 8);
                    const float4 d0 = cw4[0], d1 = cw4[1];
                    cwv[m][0] = d0.x; cwv[m][1] = d0.y; cwv[m][2] = d0.z; cwv[m][3] = d0.w;
                    cwv[m][4] = d1.x; cwv[m][5] = d1.y; cwv[m][6] = d1.z; cwv[m][7] = d1.w;
                }
            }
            float x[7][8];
#pragma unroll
            for (int m = 0; m < 7; ++m) {
                const int t = tlo - 2 + m;
                uint4 q = make_uint4(0u, 0u, 0u, 0u);
                if (t >= 0 && t < n) q = *(const uint4*)(src + (size_t)t * 512);
                x[m][0] = __uint_as_float(q.x << 16); x[m][1] = __uint_as_float(q.x & 0xffff0000u);
                x[m][2] = __uint_as_float(q.y << 16); x[m][3] = __uint_as_float(q.y & 0xffff0000u);
                x[m][4] = __uint_as_float(q.z << 16); x[m][5] = __uint_as_float(q.z & 0xffff0000u);
                x[m][6] = __uint_as_float(q.w << 16); x[m][7] = __uint_as_float(q.w & 0xffff0000u);
            }
#pragma unroll
            for (int k = 0; k < 4; ++k) {
                float v[8];
#pragma unroll
                for (int j = 0; j < 8; ++j)
                    v[j] = cbv[j] + cwv[0][j] * x[k][j] + cwv[1][j] * x[k + 1][j] + cwv[2][j] * x[k + 2][j] + cwv[3][j] * x[k + 3][j];
                const int rho = dir ? (4 * tg + 3 - k) : (4 * tg + k);
                *(uint4*)(lds + RN_V + rho * LROW + cc * 16) = make_uint4(pack2(v[0], v[1]), pack2(v[2], v[3]), pack2(v[4], v[5]), pack2(v[6], v[7]));
            }
        }
        __syncthreads();
        f32x16 acc[4];
#pragma unroll
        for (int nt = 0; nt < 4; ++nt)
#pragma unroll
            for (int e = 0; e < 16; ++e) acc[nt][e] = 0.f;
#pragma unroll
        for (int ks = 0; ks < 4; ++ks) {
            const bf16x8 fa = *(const bf16x8*)(lds + RN_V + (32 * w + r) * LROW + ks * 32 + h * 16);
#pragma unroll
            for (int nt = 0; nt < 4; ++nt) {
                const bf16x8 fb = *(const bf16x8*)(lds + RN_W + (32 * nt + r) * LROW + ks * 32 + h * 16);
                acc[nt] = MFMA32(fa, fb, acc[nt]);
            }
        }
        float av[2][16], bv[2][16];
#pragma unroll
        for (int jh = 0; jh < 2; ++jh)
#pragma unroll
            for (int e = 0; e < 16; ++e) {
                const int rho = 32 * w + crow(e, h);
                const float vv = bf2f(*(const bf16_t*)(lds + RN_V + rho * LROW + (jh * 32 + r) * 2));
                const float ra = acc[jh][e] + ba[jh], ri = acc[2 + jh][e] + bx[jh];
                const float rg = __builtin_amdgcn_rcpf(1.f + __expf(-ra));
                const float ig = __builtin_amdgcn_rcpf(1.f + __expf(-ri));
                const float la = -8.f * rg * sp[jh];
                const float x2 = 2.f * la;
                const float em = -x2 * (1.f + x2 * (0.5f + x2 * (0.16666667f + x2 * (0.041666668f + x2 * (0.0083333338f + x2 * 0.0013888889f)))));
                av[jh][e] = __expf(la);
                bv[jh][e] = __builtin_amdgcn_sqrtf(fmaxf(em, 0.f)) * ig * vv;
            }
        float s0A[2][4], s0B[2][4], PA_[2][4], PB_[2][4], WA[2], WB[2];
#pragma unroll
        for (int jh = 0; jh < 2; ++jh) {
#pragma unroll
            for (int q = 0; q < 4; ++q) {
                const float A = av[jh][4 * q] * av[jh][4 * q + 1] * av[jh][4 * q + 2] * av[jh][4 * q + 3];
                float x = bv[jh][4 * q];
                x = av[jh][4 * q + 1] * x + bv[jh][4 * q + 1];
                x = av[jh][4 * q + 2] * x + bv[jh][4 * q + 2];
                x = av[jh][4 * q + 3] * x + bv[jh][4 * q + 3];
                const float oA = shx(A, 32, lane), oB = shx(x, 32, lane);
                s0A[jh][q] = h ? oA : A;
                s0B[jh][q] = h ? oB : x;
                const float s1A = h ? A : oA, s1B = h ? x : oB;
                PA_[jh][q] = s1A * s0A[jh][q];
                PB_[jh][q] = s1A * s0B[jh][q] + s1B;
            }
            WA[jh] = PA_[jh][0] * PA_[jh][1] * PA_[jh][2] * PA_[jh][3];
            float x = PB_[jh][0];
            x = PA_[jh][1] * x + PB_[jh][1];
            x = PA_[jh][2] * x + PB_[jh][2];
            x = PA_[jh][3] * x + PB_[jh][3];
            WB[jh] = x;
            if (h == 0) {
                AGG[(w * 64 + jh * 32 + r) * 2] = WA[jh];
                AGG[(w * 64 + jh * 32 + r) * 2 + 1] = WB[jh];
            }
        }
        __syncthreads();
        float cout_[2];
        char* hvp = lds + RN_V + (32 * w + 4 * h) * LROW + r * 2;
#pragma unroll
        for (int jh = 0; jh < 2; ++jh) {
            const int j = jh * 32 + r;
            float cin = CARRY[j];
            for (int w2 = 0; w2 < w; ++w2) cin = AGG[(w2 * 64 + j) * 2] * cin + AGG[(w2 * 64 + j) * 2 + 1];
            cout_[jh] = WA[jh] * cin + WB[jh];
            float C = cin;
#pragma unroll
            for (int q = 0; q < 4; ++q) {
                const float c1 = s0A[jh][q] * C + s0B[jh][q];
                float x = h ? c1 : C;
#pragma unroll
                for (int e4 = 0; e4 < 4; ++e4) {
                    x = av[jh][4 * q + e4] * x + bv[jh][4 * q + e4];
                    if (!isctx) *(bf16_t*)(hvp + (e4 + 8 * q) * LROW + jh * 64) = f2bf(x);
                }
                C = PA_[jh][q] * C + PB_[jh][q];
            }
        }
        __syncthreads();
        if (w == 7 && h == 0) {
            CARRY[r] = cout_[0];
            CARRY[32 + r] = cout_[1];
        }
        if (!isctx) {
            const int rho = tid >> 1, hf2 = tid & 1;
            const int t = dir ? (tbase + 255 - rho) : (tbase + rho);
            const uint4* sp = (const uint4*)(lds + RN_V + rho * LROW + hf2 * 64);
            uint4* gp = (uint4*)(HS + (size_t)(b * S_ + t) * 512 + hd * 64 + hf2 * 32);
            const uint4 v0 = sp[0], v1 = sp[1], v2 = sp[2], v3 = sp[3];
            gp[0] = v0; gp[1] = v1; gp[2] = v2; gp[3] = v3;
            __syncthreads();
        }
    }
}

#define P2_RNN 128
#define P2_HY 512
DI void phase2(const Params& P, char* lds, int tid, volatile unsigned* misc, int pass) {
    unsigned* qctr = (unsigned*)(P.ws + OFF_CTL) + QUEUE_WORD + pass;
    for (;;) {
        __syncthreads();
        if (tid == 0) misc[8] = atomicAdd(qctr, 1u);
        __syncthreads();
        const int it = __builtin_amdgcn_readfirstlane((int)misc[8]);
        if (it >= P2_RNN + P2_HY) break;
        int tq = tid;
        asm volatile("" : "+v"(tq));
#ifdef PROBE_P2
        if (pass == 1 && ((PROBE_P2 == 1) != (it < P2_RNN))) continue;
#endif
        if (it < P2_RNN) rnn_item(P, it, lds, tq);
        else hyena_item(P, it - P2_RNN, lds, tq);
    }
}

#define P3_A 0
#define P3_AROW 2064
#define P3_LG 132096
#define P3_SC 148480
#define P3_RED 149760
#define CNT_WORD 4160

DI float gelu_tanh(float x) {
    const float u = 0.7978845608028654f * (x + 0.044715f * x * x * x);
    const float t = 1.f - 2.f * __builtin_amdgcn_rcpf(1.f + __expf(2.f * u));
    return 0.5f * x * (1.f + t);
}
DI float bflo(unsigned v) { return __uint_as_float(v << 16); }
DI float bfhi(unsigned v) { return __uint_as_float(v & 0xffff0000u); }

DI void p2b_item(const Params& P, int it, char* lds, int tid) {
    const int tok0 = it * 64;
    const bf16_t* PA = (const bf16_t*)(P.ws + OFF_PA);
    const bf16_t* HF = (const bf16_t*)(P.ws + OFF_HS);
    const bf16_t* HB = HF + (size_t)NL_ * 512;
    const bf16_t* YBT = (const bf16_t*)(P.ws + OFF_YBT);
    bf16_t* YN = (bf16_t*)(P.ws + OFF_YN);
    float* sc = (float*)(lds + P3_SC);
    float* red = (float*)(lds + P3_RED);
    const int lane = tid & 63, w = __builtin_amdgcn_readfirstlane(tid >> 6);
    __syncthreads();
#pragma unroll 2
    for (int i = 0; i < 8; ++i) {
        const int tok = w + 8 * i, c8 = lane;
        const size_t g = (size_t)(tok0 + tok) * 512 + c8 * 8;
        const uint4 pa = *(const uint4*)(PA + g), hf = *(const uint4*)(HF + g), hb = *(const uint4*)(HB + g);
        const unsigned pw[4] = {pa.x, pa.y, pa.z, pa.w}, fw[4] = {hf.x, hf.y, hf.z, hf.w}, bw[4] = {hb.x, hb.y, hb.z, hb.w};
        unsigned ow[4];
        float ss = 0.f;
#pragma unroll
        for (int k = 0; k < 4; ++k) {
            const float y0 = gelu_tanh(bflo(pw[k])) * (bflo(fw[k]) + bflo(bw[k]));
            const float y1 = gelu_tanh(bfhi(pw[k])) * (bfhi(fw[k]) + bfhi(bw[k]));
            ss += y0 * y0 + y1 * y1;
            ow[k] = pack2(y0, y1);
        }
        *(uint4*)(lds + P3_A + tok * P3_AROW + c8 * 16) = make_uint4(ow[0], ow[1], ow[2], ow[3]);
#pragma unroll
        for (int o = 32; o > 0; o >>= 1) ss += shx(ss, o, lane);
        if (lane == 0) sc[tok] = ss;
    }
    {
        float sb[8];
#pragma unroll
        for (int e = 0; e < 8; ++e) sb[e] = 0.f;
        const int j = tid & 7;
#pragma unroll 2
        for (int pass = 0; pass < 8; ++pass) {
            const int c = pass * 64 + (tid >> 3);
            const uint4 v = *(const uint4*)(YBT + (size_t)c * NL_ + tok0 + 8 * j);
            const unsigned vw[4] = {v.x, v.y, v.z, v.w};
#pragma unroll
            for (int k = 0; k < 4; ++k) {
                const float f0 = bflo(vw[k]), f1 = bfhi(vw[k]);
                sb[2 * k] += f0 * f0;
                sb[2 * k + 1] += f1 * f1;
                *(bf16_t*)(lds + P3_A + (8 * j + 2 * k) * P3_AROW + (512 + c) * 2) = (bf16_t)(vw[k] & 0xffffu);
                *(bf16_t*)(lds + P3_A + (8 * j + 2 * k + 1) * P3_AROW + (512 + c) * 2) = (bf16_t)(vw[k] >> 16);
            }
        }
#pragma unroll
        for (int e = 0; e < 8; ++e) {
            float v = sb[e];
            v += shx(v, 8, lane); v += shx(v, 16, lane); v += shx(v, 32, lane);
            if (lane < 8) red[w * 64 + 8 * j + e] = v;
        }
    }
    __syncthreads();
    if (tid < 64) {
        float ssb = 0.f;
#pragma unroll
        for (int ww = 0; ww < 8; ++ww) ssb += red[ww * 64 + tid];
        sc[128 + tid] = rsqrtf(sc[tid] * (1.f / 512.f) + 1e-6f);
        sc[192 + tid] = rsqrtf(ssb * (1.f / 512.f) + 1e-6f);
    }
    __syncthreads();
#pragma unroll 4
    for (int i = 0; i < 16; ++i) {
        const int q = tid + NTHR * i, row = q >> 7, c16 = q & 127;
        const uint4 v = *(const uint4*)(lds + P3_A + row * P3_AROW + c16 * 16);
        const float scl = sc[(c16 < 64 ? 128 : 192) + row];
        uint4 o;
        o.x = pack2(bflo(v.x) * scl, bfhi(v.x) * scl);
        o.y = pack2(bflo(v.y) * scl, bfhi(v.y) * scl);
        o.z = pack2(bflo(v.z) * scl, bfhi(v.z) * scl);
        o.w = pack2(bflo(v.w) * scl, bfhi(v.w) * scl);
        *(uint4*)(YN + (size_t)(tok0 + row) * 1024 + c16 * 8) = o;
    }
}
DI void phase2b(const Params& P, char* lds, int tid) {
    for (int it = blockIdx.x; it < NL_ / 64; it += gridDim.x) p2b_item(P, it, lds, tid);
}

template <int i>
DI void p3_epi_half(const Params& P, const f32x16 a0, const f32x16 a1, int m0, int n0, const float* mod, const float* pe,
                    char* lds, int tid, int wm, int wn, int r, int h) {
    float* T = (float*)lds;
    __syncthreads();
#pragma unroll
    for (int e = 0; e < 16; ++e) {
        (T + (wm * 32 + 4 * h) * 132 + wn * 64 + r)[((e & 3) + 8 * (e >> 2)) * 132] = a0[e];
        (T + (wm * 32 + 4 * h) * 132 + wn * 64 + 32 + r)[((e & 3) + 8 * (e >> 2)) * 132] = a1[e];
    }
    __syncthreads();
#pragma unroll
    for (int k = 0; k < 8; ++k) {
        const int q = tid + NTHR * k, lr = q >> 5, c4 = (q & 31) * 4;
        const int tok = m0 + (lr >> 5) * 64 + i * 32 + (lr & 31), t = tok & 2047, col = n0 + c4;
        const float4 y = *(const float4*)(T + lr * 132 + c4);
        const float4 xv = *(const float4*)(P.in[0] + (size_t)tok * 1024 + col);
        const float4 g1 = *(const float4*)(mod + 2048 + col);
        const float4 pv = *(const float4*)((n0 < 512) ? pe + (t >> 6) * 512 + col : pe + (t & 63) * 512 + col - 512);
        float4 o;
        o.x = xv.x + pv.x + g1.x * y.x; o.y = xv.y + pv.y + g1.y * y.y; o.z = xv.z + pv.z + g1.z * y.z; o.w = xv.w + pv.w + g1.w * y.w;
        *(float4*)(P.out + (size_t)tok * 1024 + col) = o;
    }
}
DI void phase3(const Params& P, char* lds, int tid) {
    const bf16_t* YN = (const bf16_t*)(P.ws + OFF_YN);
    const bf16_t* WT = (const bf16_t*)(P.ws + OFF_WOUT_T);
    const float* pe = (const float*)(P.ws + OFF_PE);
    const int lrow = tid >> 3, lchunk = tid & 7;
    const int lane = tid & 63, w = __builtin_amdgcn_readfirstlane(tid >> 6), wm = w >> 1, wn = w & 1, r = lane & 31, h = lane >> 5;
    for (int tile = blockIdx.x; tile < 512; tile += gridDim.x) {
        const int m0 = (tile >> 3) * 256, n0 = (tile & 7) * 128;
        const bf16_t* ap = YN + (size_t)(m0 + lrow) * 1024 + lchunk * 8;
        const bf16_t* bp = WT + (size_t)(n0 + lrow) * 1024 + lchunk * 8;
        f32x16 acc[2][2];
        gemm_core<false>(acc, ap, ap + 64 * 1024, ap + 128 * 1024, ap + 192 * 1024, bp, bp + 64 * 1024, 16, lds, tid);
        const float* mod = (const float*)(P.ws + OFF_MOD) + (m0 >> 11) * 6144;
        p3_epi_half<0>(P, acc[0][0], acc[0][1], m0, n0, mod, pe, lds, tid, wm, wn, r, h);
        p3_epi_half<1>(P, acc[1][0], acc[1][1], m0, n0, mod, pe, lds, tid, wm, wn, r, h);
    }
}

DI void p3b_item(const Params& P, int it, char* lds, int tid, int pass) {
    const int tok0 = it * 64, b = tok0 >> 11;
    const bf16_t* WRT = (const bf16_t*)(P.ws + OFF_WR_T);
    bf16_t* H2 = (bf16_t*)(P.ws + OFF_H2);
    const float* mod = (const float*)(P.ws + OFF_MOD) + b * 6144;
    float* LG = (float*)(lds + P3_LG);
    const int lane = tid & 63, w = __builtin_amdgcn_readfirstlane(tid >> 6), r = lane & 31, h = lane >> 5;
    __syncthreads();
#pragma unroll 1
    for (int rb = 0; rb < 8; rb += 4) {
        float4 xv[4][4];
#pragma unroll
        for (int q = 0; q < 4; ++q)
#pragma unroll
            for (int i = 0; i < 4; ++i) xv[q][i] = *(const float4*)(P.out + (size_t)(tok0 + w * 8 + rb + q) * 1024 + (i >> 1) * 512 + lane * 8 + (i & 1) * 4);
        float ss[4];
#pragma unroll
        for (int q = 0; q < 4; ++q) {
            ss[q] = 0.f;
#pragma unroll
            for (int i = 0; i < 4; ++i) ss[q] += xv[q][i].x * xv[q][i].x + xv[q][i].y * xv[q][i].y + xv[q][i].z * xv[q][i].z + xv[q][i].w * xv[q][i].w;
        }
#pragma unroll
        for (int o = 32; o > 0; o >>= 1)
#pragma unroll
            for (int q = 0; q < 4; ++q) ss[q] += shx(ss[q], o, lane);
#pragma unroll
        for (int i2 = 0; i2 < 2; ++i2) {
            const int d = i2 * 512 + lane * 8;
            float gm[8], shf[8];
#pragma unroll
            for (int hh = 0; hh < 2; ++hh) {
                const float4 gn = *(const float4*)(P.in[28] + d + 4 * hh), s2v = *(const float4*)(mod + 4096 + d + 4 * hh), shv = *(const float4*)(mod + 3072 + d + 4 * hh);
                gm[4 * hh + 0] = gn.x * (1.f + s2v.x); gm[4 * hh + 1] = gn.y * (1.f + s2v.y); gm[4 * hh + 2] = gn.z * (1.f + s2v.z); gm[4 * hh + 3] = gn.w * (1.f + s2v.w);
                shf[4 * hh + 0] = shv.x; shf[4 * hh + 1] = shv.y; shf[4 * hh + 2] = shv.z; shf[4 * hh + 3] = shv.w;
            }
#pragma unroll
            for (int q = 0; q < 4; ++q) {
                const int row = w * 8 + rb + q;
                const float rs = rsqrtf(ss[q] * (1.f / 1024.f) + 1e-6f);
                const float4 a = xv[q][2 * i2], bq = xv[q][2 * i2 + 1];
                uint4 pk;
                pk.x = pack2(a.x * rs * gm[0] + shf[0], a.y * rs * gm[1] + shf[1]);
                pk.y = pack2(a.z * rs * gm[2] + shf[2], a.w * rs * gm[3] + shf[3]);
                pk.z = pack2(bq.x * rs * gm[4] + shf[4], bq.y * rs * gm[5] + shf[5]);
                pk.w = pack2(bq.z * rs * gm[6] + shf[6], bq.w * rs * gm[7] + shf[7]);
                *(uint4*)(H2 + (size_t)(tok0 + row) * 1024 + d) = pk;
                *(uint4*)(lds + P3_A + row * P3_AROW + d * 2) = pk;
            }
        }
    }
    __syncthreads();
    if (w < 4) {
        const int mi = w >> 1, ni = w & 1;
        f32x16 lg;
#pragma unroll
        for (int e = 0; e < 16; ++e) lg[e] = 0.f;
        const bf16_t* wr = WRT + (size_t)(32 * ni + r) * 1024 + 8 * h;
        const char* ar = lds + P3_A + (32 * mi + r) * P3_AROW + 16 * h;
#pragma unroll 8
        for (int ks = 0; ks < 64; ++ks) {
            const bf16x8 fa = *(const bf16x8*)(ar + ks * 32);
            const bf16x8 fbb = *(const bf16x8*)(wr + ks * 16);
            lg = MFMA32(fa, fbb, lg);
        }
#pragma unroll
        for (int e = 0; e < 16; ++e) LG[(32 * mi + crow(e, h)) * 64 + 32 * ni + r] = lg[e];
    }
    __syncthreads();
    if (tid < 64 && pass == 0) {
        float* l = LG + tid * 64;
        const int tok = tok0 + tid;
        for (int j = 0; j < 4; ++j) l[j] += P.in[30][j];
        for (int j = 0; j < 32; ++j) l[4 + j] += P.in[32][j];
        int gi = 0;
        float gmx = l[0];
        for (int j = 1; j < 4; ++j) if (l[j] > gmx) { gmx = l[j]; gi = j; }
        float gs = 0.f;
        for (int j = 0; j < 4; ++j) gs += __expf(l[j] - gmx);
        const float gp = 1.f / gs;
        const float* el = l + 4 + gi * 8;
        int e0 = 0;
        float m0 = el[0];
        for (int j = 1; j < 8; ++j) if (el[j] > m0) { m0 = el[j]; e0 = j; }
        int e1 = 0;
        float m1 = -1e30f;
        for (int j = 0; j < 8; ++j) if (j != e0 && el[j] > m1) { m1 = el[j]; e1 = j; }
        const float p1 = __expf(m1 - m0);
        const float w0 = gp / (1.f + p1), w1 = gp * p1 / (1.f + p1);
        unsigned* cnt = (unsigned*)(P.ws + OFF_CTL) + CNT_WORD;
        unsigned* LIST = (unsigned*)(P.ws + OFF_LIST);
        unsigned* TS = (unsigned*)(P.ws + OFF_TOKSLOT);
        float* EW = (float*)(P.ws + OFF_EW);
        const int ex0 = gi * 8 + e0, ex1 = gi * 8 + e1;
        const unsigned p0 = atomicAdd(&cnt[ex0], 1u);
        LIST[ex0 * 16384 + p0] = tok * 2;
        TS[tok * 2] = ((unsigned)ex0 << 16) | p0;
        EW[tok * 2] = w0;
        const unsigned p1i = atomicAdd(&cnt[ex1], 1u);
        LIST[ex1 * 16384 + p1i] = tok * 2 + 1;
        TS[tok * 2 + 1] = ((unsigned)ex1 << 16) | p1i;
        EW[tok * 2 + 1] = w1;
    }
}
DI void phase3b(const Params& P, char* lds, int tid, int pass) {
    for (int it = blockIdx.x; it < NL_ / 64; it += gridDim.x) p3b_item(P, it, lds, tid, pass);
}

#define MISC_TB 16
#define MISC_SB 56
#define MISC_CNT 96
DI void moe_tables(const Params& P, volatile unsigned* misc, int tid) {
    __syncthreads();
    if (tid == 0) {
        unsigned* cnt = (unsigned*)(P.ws + OFF_CTL) + CNT_WORD;
        unsigned t = 0, sb = 0;
        for (int e = 0; e < 32; ++e) {
            const unsigned c = __hip_atomic_load(&cnt[e], __ATOMIC_RELAXED, __HIP_MEMORY_SCOPE_AGENT);
            misc[MISC_TB + e] = t;
            misc[MISC_SB + e] = sb;
            misc[MISC_CNT + e] = c;
            t += (c + 255u) >> 8;
            sb += c;
        }
        misc[MISC_TB + 32] = t;
    }
    __syncthreads();
}

DI void phase4(const Params& P, char* lds, int tid, volatile unsigned* misc) {
    moe_tables(P, misc, tid);
    const bf16_t* H2 = (const bf16_t*)(P.ws + OFF_H2);
    const bf16_t* WG = (const bf16_t*)(P.ws + OFF_WG_T);
    const bf16_t* WU = (const bf16_t*)(P.ws + OFF_WU_T);
    const unsigned* LIST = (const unsigned*)(P.ws + OFF_LIST);
    bf16_t* ACT = (bf16_t*)(P.ws + OFF_ACT);
    const int lrow = tid >> 3, lchunk = tid & 7;
    const int lane = tid & 63, w = __builtin_amdgcn_readfirstlane(tid >> 6), wm = w >> 1, wn = w & 1, r = lane & 31, h = lane >> 5;
    const int total = (int)misc[MISC_TB + 32] * 8;
    for (int item = blockIdx.x; item < total; item += gridDim.x) {
        const int mtg = item >> 3, ntile = item & 7;
        int e = 0;
        for (int q = 1; q < 32; ++q) e = ((int)misc[MISC_TB + q] <= mtg) ? q : e;
        const int mt = mtg - (int)misc[MISC_TB + e];
        const int cnt_e = (int)misc[MISC_CNT + e];
        const int valid = min(256, cnt_e - mt * 256);
        const bf16_t* ap[4];
#pragma unroll
        for (int i = 0; i < 4; ++i) {
            const int idx = min(mt * 256 + lrow + 64 * i, cnt_e - 1);
            const unsigned slot = LIST[e * 16384 + idx];
            ap[i] = H2 + (size_t)(slot >> 1) * 1024 + lchunk * 8;
        }
        const int half = (lrow >> 5) & 1, wi = lrow & 31;
        const bf16_t* wsel = half ? WU : WG;
        const bf16_t* bp0 = wsel + (size_t)(e * 512 + ntile * 64 + wi) * 1024 + lchunk * 8;
        const bf16_t* bp1 = bp0 + (size_t)32 * 1024;
        f32x16 acc[2][2];
        gemm_core<false>(acc, ap[0], ap[1], ap[2], ap[3], bp0, bp1, 16, lds, tid);
        const int pos0 = (int)misc[MISC_SB + e] + mt * 256;
#pragma unroll
        for (int i = 0; i < 2; ++i)
#pragma unroll
            for (int ee = 0; ee < 16; ++ee) {
                const float g = acc[i][0][ee], u = acc[i][1][ee];
                const float a = g * __builtin_amdgcn_rcpf(1.f + __expf(-g)) * u;
                *(bf16_t*)(lds + (wm * 64 + i * 32 + (ee & 3) + 8 * (ee >> 2) + 4 * h) * 144 + (wn * 32 + r) * 2) = f2bf(a);
            }
        __syncthreads();
#pragma unroll
        for (int i = 0; i < 4; ++i) {
            const int q = tid + NTHR * i, row = q >> 3, ch = q & 7;
            if (row < valid) *(uint4*)(ACT + (size_t)(pos0 + row) * 512 + ntile * 64 + ch * 8) = *(const uint4*)(lds + row * 144 + ch * 16);
        }
    }
}

DI void phase5(const Params& P, char* lds, int tid, volatile unsigned* misc) {
    const bf16_t* ACT = (const bf16_t*)(P.ws + OFF_ACT);
    const bf16_t* WD = (const bf16_t*)(P.ws + OFF_WD_T);
    const unsigned* LIST = (const unsigned*)(P.ws + OFF_LIST);
    const float* EW = (const float*)(P.ws + OFF_EW);
    bf16_t* SLOT = (bf16_t*)(P.ws + OFF_SLOT);
    const int lrow = tid >> 3, lchunk = tid & 7;
    const int lane = tid & 63, w = __builtin_amdgcn_readfirstlane(tid >> 6), wm = w >> 1, wn = w & 1, r = lane & 31, h = lane >> 5;
    const int total = (int)misc[MISC_TB + 32] * 8;
    for (int item = blockIdx.x; item < total; item += gridDim.x) {
        const int mtg = item >> 3, ntile = item & 7;
        int e = 0;
        for (int q = 1; q < 32; ++q) e = ((int)misc[MISC_TB + q] <= mtg) ? q : e;
        const int mt = mtg - (int)misc[MISC_TB + e];
        const int cnt_e = (int)misc[MISC_CNT + e];
        const int valid = min(256, cnt_e - mt * 256);
        const int pos0 = (int)misc[MISC_SB + e] + mt * 256;
        const bf16_t* ap[4];
#pragma unroll
        for (int i = 0; i < 4; ++i) ap[i] = ACT + (size_t)(pos0 + min(lrow + 64 * i, valid - 1)) * 512 + lchunk * 8;
        const bf16_t* bp0 = WD + (size_t)(e * 1024 + ntile * 128 + lrow) * 512 + lchunk * 8;
        const bf16_t* bp1 = bp0 + (size_t)64 * 512;
        float* wgt = (float*)(lds + 2 * STAGE_BYTES);
        if (tid < 256) wgt[tid] = (tid < valid) ? EW[LIST[e * 16384 + mt * 256 + tid]] : 0.f;
        f32x16 acc[2][2];
        gemm_core<false>(acc, ap[0], ap[1], ap[2], ap[3], bp0, bp1, 8, lds, tid);
#pragma unroll
        for (int i = 0; i < 2; ++i)
#pragma unroll
            for (int ee = 0; ee < 16; ++ee) {
                const float wv = (wgt + wm * 64 + i * 32 + 4 * h)[(ee & 3) + 8 * (ee >> 2)];
#pragma unroll
                for (int j = 0; j < 2; ++j) acc[i][j][ee] *= wv;
            }
        acc_to_lds(acc, lds, wm, wn, r, h);
        __syncthreads();
        lds_to_rows(lds, SLOT + (size_t)pos0 * 1024 + ntile * 128, 1024, valid, tid);
    }
}

DI void phase6(const Params& P, int tid, volatile unsigned* misc, bool dummy) {
    const bf16_t* SLOT = (const bf16_t*)(P.ws + OFF_SLOT);
    const unsigned* TS = (const unsigned*)(P.ws + OFF_TOKSLOT);
    const float* modb = (const float*)(P.ws + OFF_MOD);
    const int lane = tid & 63, w = tid >> 6;
    for (int it = blockIdx.x; it < NL_ / 8; it += gridDim.x) {
        const int tok = it * 8 + w;
        const float* g2 = modb + (tok >> 11) * 6144 + 5120;
        const unsigned t0 = TS[tok * 2], t1 = TS[tok * 2 + 1];
        const bf16_t* s0 = SLOT + (size_t)(misc[MISC_SB + (t0 >> 16)] + (t0 & 0xffffu)) * 1024;
        const bf16_t* s1 = SLOT + (size_t)(misc[MISC_SB + (t1 >> 16)] + (t1 & 0xffffu)) * 1024;
        float* xo = P.out + (size_t)tok * 1024;
        float* xw = dummy ? (float*)(P.ws + OFF_H1) + (size_t)tok * 1024 : xo;
        float v[16];
        float ss = 0.f;
#pragma unroll
        for (int i = 0; i < 4; ++i) {
            const int d = i * 256 + lane * 4;
            const float4 xv = *(const float4*)(xo + d);
            const float4 gv = *(const float4*)(g2 + d);
            const uint2 a = *(const uint2*)(s0 + d), bq = *(const uint2*)(s1 + d);
            v[i * 4 + 0] = xv.x + gv.x * (bflo(a.x) + bflo(bq.x));
            v[i * 4 + 1] = xv.y + gv.y * (bfhi(a.x) + bfhi(bq.x));
            v[i * 4 + 2] = xv.z + gv.z * (bflo(a.y) + bflo(bq.y));
            v[i * 4 + 3] = xv.w + gv.w * (bfhi(a.y) + bfhi(bq.y));
            ss += v[i * 4] * v[i * 4] + v[i * 4 + 1] * v[i * 4 + 1] + v[i * 4 + 2] * v[i * 4 + 2] + v[i * 4 + 3] * v[i * 4 + 3];
        }
#pragma unroll
        for (int o = 32; o > 0; o >>= 1) ss += shx(ss, o, lane);
        const float rstd = rsqrtf(ss * (1.f / 1024.f) + 1e-6f);
#pragma unroll
        for (int i = 0; i < 4; ++i) {
            const int d = i * 256 + lane * 4;
            const float4 fg = *(const float4*)(P.in[36] + d);
            float4 o;
            o.x = v[i * 4 + 0] * rstd * fg.x; o.y = v[i * 4 + 1] * rstd * fg.y;
            o.z = v[i * 4 + 2] * rstd * fg.z; o.w = v[i * 4 + 3] * rstd * fg.w;
            *(float4*)(xw + d) = o;
        }
    }
}

#define NPHASE 10
DI void run_phase(const Params& P, int ph, int pass, int npass, char* lds, int tq, volatile unsigned* misc) {
    if (ph == 0) phase0a(P, lds, tq);
    else if (ph == 1) phase0b(P, lds, tq);
    else if (ph == 2) phase1(P, lds, tq);
    else if (ph == 3) phase2(P, lds, tq, misc, pass);
    else if (ph == 4) phase2b(P, lds, tq);
    else if (ph == 5) phase3(P, lds, tq);
    else if (ph == 6) phase3b(P, lds, tq, pass);
    else if (ph == 7) phase4(P, lds, tq, misc);
    else if (ph == 8) phase5(P, lds, tq, misc);
    else if (ph == 9) phase6(P, tq, misc, pass + 1 < npass);
}
__global__ void __launch_bounds__(NTHR, 2) mk_fwd(Params P, int ph_lo, int ph_hi, int rep_mask) {
    extern __shared__ __attribute__((aligned(16))) char lds[];
    const int tid = threadIdx.x;
    volatile unsigned* misc = (volatile unsigned*)(lds + LDS_MISC);
    if (tid < 256) misc[tid] = 0u;
    __syncthreads();
    XcdBarrier bar = xcd_barrier_post((unsigned*)(P.ws + OFF_CTL), misc);
    for (int ph = ph_lo; ph < ph_hi; ++ph) {
        const int npass = ((rep_mask >> ph) & 1) ? 2 : 1;
        for (int pass = 0; pass < npass; ++pass) {
            int tq = tid;
            asm volatile("" : "+v"(tq));
            run_phase(P, ph, pass, npass, lds, tq, misc);
            if (pass + 1 < npass || ph + 1 < ph_hi) xcd_barrier(bar);
        }
    }
#ifdef EXTRA_BARRIERS
    for (int q = 0; q < EXTRA_BARRIERS; ++q) xcd_barrier(bar);
#endif
}

extern "C" void kernel_launch(void* const* d_in, const int* in_sizes, int n_in, void* d_out, int out_size, void* d_ws,
                              size_t ws_size, hipStream_t stream) {
    static int grid = 0;
    if (grid == 0) {
        int dev = 0, cus = 0, per_cu = 0;
        hipGetDevice(&dev);
        hipDeviceGetAttribute(&cus, hipDeviceAttributeMultiprocessorCount, dev);
        hipFuncSetAttribute((const void*)mk_fwd, hipFuncAttributeMaxDynamicSharedMemorySize, LDS_BYTES);
        hipOccupancyMaxActiveBlocksPerMultiprocessor(&per_cu, (const void*)mk_fwd, NTHR, LDS_BYTES);
        (void)hipGetLastError();
        grid = (per_cu >= 1 && ws_size >= WS_END && n_in == 37) ? cus : -1;
        if (grid < 0) fprintf(stderr, "kernel_launch: refusing to launch (per_cu %d, ws %zu, n_in %d)\n", per_cu, ws_size, n_in);
    }
    if (grid < 0) return;
    Params P{};
    for (int i = 0; i < 37; ++i) P.in[i] = (const float*)d_in[i];
    P.out = (float*)d_out;
    P.ws = (char*)d_ws;
    char* ws = (char*)d_ws;

    hipMemsetAsync(ws + OFF_CTL, 0, CTL_BYTES, stream);
    hipLaunchKernelGGL(mk_fwd, dim3(grid), dim3(NTHR), LDS_BYTES, stream, P, 0, NPHASE, REP_MASK);
}
```

```cpp
#include <hip/hip_runtime.h>
#include <math.h>
#include <stdint.h>
#include <stdio.h>

#define B_ 8
#define S_ 2048
#define D_ 1024
#define CT_ 256
#define NL_ (B_ * S_)
#define NC_ (B_ * CT_)
#define DIN_ 2560
#define NTHR 512
#ifndef REP_MASK
#define REP_MASK 0
#endif

typedef unsigned short bf16_t;
typedef __attribute__((ext_vector_type(8))) short bf16x8;
typedef __attribute__((ext_vector_type(16))) float f32x16;
typedef __attribute__((ext_vector_type(4))) float f32x4;
typedef __attribute__((ext_vector_type(4))) unsigned u32x4;
#define DI __device__ __forceinline__
#define MFMA32(a, b, c) __builtin_amdgcn_mfma_f32_32x32x16_bf16((a), (b), (c), 0, 0, 0)

DI bf16_t f2bf(float x) {
    unsigned u = __float_as_uint(x);
    u += 0x7fffu + ((u >> 16) & 1u);
    return (bf16_t)(u >> 16);
}
DI float bf2f(bf16_t v) { return __uint_as_float(((unsigned)v) << 16); }
DI unsigned pack2(float lo, float hi) { return (unsigned)f2bf(lo) | ((unsigned)f2bf(hi) << 16); }
DI float sigmoidf_(float x) { return 1.f / (1.f + expf(-x)); }
DI float shx(float v, int mask, int lane) { return __int_as_float(__builtin_amdgcn_ds_bpermute((lane ^ mask) << 2, __float_as_int(v))); }

#define OFF_CTL 0ull
#define CTL_BYTES 65536ull
#define OFF_MOD (OFF_CTL + CTL_BYTES)
#define OFF_PE (OFF_MOD + 262144ull)
#define OFF_HDN2 (OFF_PE + 131072ull)
#define OFF_NRM2 (OFF_HDN2 + 262144ull)
#define OFF_RALL (OFF_NRM2 + 8192ull)
#define OFF_WIN_T (OFF_RALL + 8404992ull)
#define OFF_WOUT_T (OFF_WIN_T + 5242880ull)
#define OFF_WRNN_T (OFF_WOUT_T + 2097152ull)
#define OFF_WR_T (OFF_WRNN_T + 262144ull)
#define OFF_WG_T (OFF_WR_T + 131072ull)
#define OFF_WU_T (OFF_WG_T + 33554432ull)
#define OFF_WD_T (OFF_WU_T + 33554432ull)
#define OFF_PHT (OFF_WD_T + 33554432ull)
#define OFF_PA (OFF_PHT + 50331648ull)
#define OFF_PU (OFF_PA + 16777216ull)
#define OFF_H1 (OFF_PU + 18874368ull)
#define OFF_HS (OFF_H1 + 37748736ull)
#define OFF_YBT (OFF_HS + 33554432ull)
#define OFF_H2 OFF_H1
#define OFF_YN (OFF_H1 + 0ull)
#define OFF_ACT OFF_HS
#define OFF_Y OFF_HS
#define OFF_SLOT OFF_PHT
#define OFF_LIST (OFF_YBT + 16777216ull)
#define OFF_TOKSLOT (OFF_LIST + 2097152ull)
#define OFF_EW (OFF_TOKSLOT + 131072ull)
#define OFF_EWS (OFF_EW + 131072ull)
#define WS_END (OFF_EWS + 131072ull)
#define QUEUE_WORD 4096

struct Params {
    const float* in[37];
    float* out;
    char* ws;
};

#define XB_TMO 128
#define XB_XCNT(j) (256 + 64 * (j))
#define XB_XSUB(j) (1280 + 64 * (j))
#define XB_XGEN(j) (2304 + 64 * (j))
#define XB_TOP 3328
#define XB_TOPGEN 3392
#define XCD_BAR_WORDS 3456
#define XB_SPIN_CAP (1u << 18)

DI unsigned xb_ld(unsigned* p) { return __hip_atomic_load(p, __ATOMIC_RELAXED, __HIP_MEMORY_SCOPE_AGENT); }
DI unsigned xb_add(unsigned* p, unsigned v) { return __hip_atomic_fetch_add(p, v, __ATOMIC_RELAXED, __HIP_MEMORY_SCOPE_AGENT); }
DI unsigned xb_xcc_id() { return (unsigned)__builtin_amdgcn_s_getreg((3 << 11) | 20) & 0xFu; }
#define XB_SPIN(cond, bar)                                                         \
    do {                                                                           \
        unsigned _sp = 0;                                                          \
        while (cond) {                                                             \
            __builtin_amdgcn_s_sleep(1);                                           \
            if ((++_sp & 255u) == 0u) {                                            \
                if (xb_ld(&(bar)[XB_TMO])) break;                                  \
                if (_sp > XB_SPIN_CAP) { atomicAdd(&(bar)[XB_TMO], 1u); break; }   \
            }                                                                      \
        }                                                                          \
    } while (0)

struct XcdBarrier {
    unsigned* bar;
    unsigned x;
    volatile unsigned* st;
};
DI XcdBarrier xcd_barrier_post(unsigned* bar, volatile unsigned* st) {
    XcdBarrier b;
    b.bar = bar;
    b.x = xb_xcc_id();
    b.st = st;
    if (threadIdx.x == 0) (void)xb_add(&bar[XB_XCNT(b.x)], 1u);
    return b;
}
DI void xcd_barrier_complete(unsigned* bar, unsigned x, unsigned& nloc, unsigned& nx) {
    const unsigned G = gridDim.x * gridDim.y * gridDim.z;
    unsigned sum, cnt, mine, sp = 0u;
    for (;;) {
        sum = 0u; cnt = 0u; mine = 0u;
#pragma unroll
        for (unsigned j = 0; j < 16; ++j) {
            const unsigned c = xb_ld(&bar[XB_XCNT(j)]);
            sum += c;
            cnt += (c > 0u) ? 1u : 0u;
            mine = (j == x) ? c : mine;
        }
        if (sum == G) break;
        __builtin_amdgcn_s_sleep(1);
        if ((++sp & 255u) == 0u) {
            if (xb_ld(&bar[XB_TMO])) break;
            if (sp > XB_SPIN_CAP) { atomicAdd(&bar[XB_TMO], 1u); break; }
        }
    }
    nloc = mine > 0u ? mine : 1u;
    nx = cnt > 0u ? cnt : 1u;
}
DI void xcd_barrier(const XcdBarrier& b) {
    asm volatile("s_waitcnt vmcnt(0)" ::: "memory");
    __syncthreads();
    if (threadIdx.x == 0) {
        unsigned* bar = b.bar;
        __builtin_amdgcn_s_waitcnt(0);
        unsigned nloc = b.st[0], nx = b.st[1];
        if (nloc == 0u) {
            xcd_barrier_complete(bar, b.x, nloc, nx);
            b.st[0] = nloc;
            b.st[1] = nx;
        }
        const unsigned old = xb_add(&bar[XB_XSUB(b.x)], 1u);
        const unsigned gen = old / nloc;
        if (old + 1u == (gen + 1u) * nloc) {
            __builtin_amdgcn_fence(__ATOMIC_RELEASE, "agent");
            asm volatile("s_waitcnt vmcnt(0)" ::: "memory");
            const unsigned og = xb_add(&bar[XB_TOP], 1u);
            const unsigned tg = og / nx;
            if (og + 1u == (tg + 1u) * nx) xb_add(&bar[XB_TOPGEN], 1u);
            else XB_SPIN(xb_ld(&bar[XB_TOPGEN]) == tg, bar);
            __builtin_amdgcn_fence(__ATOMIC_ACQUIRE, "agent");
            xb_add(&bar[XB_XGEN(b.x)], 1u);
            asm volatile("s_waitcnt vmcnt(0)" ::: "memory");
        } else {
            XB_SPIN(xb_ld(&bar[XB_XGEN(b.x)]) == gen, bar);
            __builtin_amdgcn_fence(__ATOMIC_ACQUIRE, "agent");
            asm volatile("s_waitcnt vmcnt(0)" ::: "memory");
        }
    }
    __syncthreads();
}

#define LDS_BYTES 163840
#define LDS_MISC (LDS_BYTES - 1024)
#define LROW 144
#define A_STAGE (256 * LROW)
#define B_STAGE (128 * LROW)
#define STAGE_BYTES (A_STAGE + B_STAGE)

DI void conv_tile(const float* src, int ld_src, bf16_t* dst, int ld_dst, const float* rowscale, float* l, int tid) {
    __syncthreads();
    {
        int r = tid >> 3, c0 = (tid & 7) * 8;
        const float4* s = (const float4*)(src + (size_t)r * ld_src + c0);
        float4 v0 = s[0], v1 = s[1];
        float sc = rowscale ? rowscale[r] : 1.f;
        float* d = l + r * 65 + c0;
        d[0] = v0.x * sc; d[1] = v0.y * sc; d[2] = v0.z * sc; d[3] = v0.w * sc;
        d[4] = v1.x * sc; d[5] = v1.y * sc; d[6] = v1.z * sc; d[7] = v1.w * sc;
    }
    __syncthreads();
    {
        int n = tid >> 3, k0 = (tid & 7) * 8;
        uint4 o;
        o.x = pack2(l[(k0 + 0) * 65 + n], l[(k0 + 1) * 65 + n]);
        o.y = pack2(l[(k0 + 2) * 65 + n], l[(k0 + 3) * 65 + n]);
        o.z = pack2(l[(k0 + 4) * 65 + n], l[(k0 + 5) * 65 + n]);
        o.w = pack2(l[(k0 + 6) * 65 + n], l[(k0 + 7) * 65 + n]);
        *(uint4*)(dst + (size_t)n * ld_dst + k0) = o;
    }
}

#define NCONV_RNN 32
DI void conv_item(const Params& P, int it, char* lds, int tid) {
    float* l = (float*)lds;
    const int hh = it & 7, gate = (it >> 3) & 1, dir = it >> 4;
    const float* src = (gate ? P.in[12] : P.in[10]) + (size_t)(dir * 8 + hh) * 4096;
    conv_tile(src, 64, (bf16_t*)(P.ws + OFF_WRNN_T) + (size_t)(hh * 256 + (dir * 2 + gate) * 64) * 64, 64, nullptr, l, tid);
}

#define NG_WIN 160
#define NG_WOUT 64
#define NG_EXP 1024
#define NG_TOTAL (NG_WIN + NG_WOUT + 3 * NG_EXP)
#define CV_LD 257
struct ConvDesc { const float* src; bf16_t* dst; const float* rs; int ld_src, ld_dst; };
DI ConvDesc conv_desc(const Params& P, int g) {
    ConvDesc d;
    d.rs = nullptr;
    if (g < NG_WIN) {
        const int kt = g / 10, ng = g % 10;
        d.src = P.in[7] + (size_t)kt * 64 * DIN_ + ng * 256; d.ld_src = DIN_;
        d.dst = (bf16_t*)(P.ws + OFF_WIN_T) + (size_t)ng * 256 * 1024 + kt * 64; d.ld_dst = 1024;
    } else if (g < NG_WIN + NG_WOUT) {
        g -= NG_WIN;
        const int kt = g >> 2, ng = g & 3;
        d.src = P.in[27] + (size_t)kt * 64 * 1024 + ng * 256; d.ld_src = 1024;
        d.dst = (bf16_t*)(P.ws + OFF_WOUT_T) + (size_t)ng * 256 * 1024 + kt * 64; d.ld_dst = 1024;
        d.rs = (kt < 8) ? P.in[25] + kt * 64 : P.in[26] + (kt - 8) * 64;
    } else {
        g -= NG_WIN + NG_WOUT;
        const int which = g >> 10, rem0 = g & 1023, e = rem0 >> 5, rem = rem0 & 31;
        if (which < 2) {
            const int kt = rem >> 1, ng = rem & 1;
            d.src = P.in[33 + which] + (size_t)e * 1024 * 512 + (size_t)kt * 64 * 512 + ng * 256; d.ld_src = 512;
            d.dst = (bf16_t*)(P.ws + (which ? OFF_WU_T : OFF_WG_T)) + (size_t)(e * 512 + ng * 256) * 1024 + kt * 64; d.ld_dst = 1024;
        } else {
            const int kt = rem >> 2, ng = rem & 3;
            d.src = P.in[35] + (size_t)e * 512 * 1024 + (size_t)kt * 64 * 1024 + ng * 256; d.ld_src = 1024;
            d.dst = (bf16_t*)(P.ws + OFF_WD_T) + (size_t)(e * 1024 + ng * 256) * 512 + kt * 64; d.ld_dst = 512;
        }
    }
    return d;
}
DI void conv_load(const ConvDesc& d, float4 (&r)[8], int tid) {
#pragma unroll
    for (int i = 0; i < 8; ++i) {
        const int q = tid + NTHR * i;
        r[i] = *(const float4*)(d.src + (size_t)(q >> 6) * d.ld_src + (q & 63) * 4);
    }
}
DI void conv_groups(const Params& P, int g0, int g1, int stride, char* lds, int tid) {
    float* l = (float*)lds;
    float4 r[8];
    int g = g0;
    ConvDesc d;
    if (g < g1) { d = conv_desc(P, g); conv_load(d, r, tid); }
    while (g < g1) {
        __syncthreads();
#pragma unroll
        for (int i = 0; i < 8; ++i) {
            const int q = tid + NTHR * i, row = q >> 6, c = (q & 63) * 4;
            const float sc = d.rs ? d.rs[row] : 1.f;
            float* p = l + row * CV_LD + c;
            p[0] = r[i].x * sc; p[1] = r[i].y * sc; p[2] = r[i].z * sc; p[3] = r[i].w * sc;
        }
        const ConvDesc dc = d;
        const int gn = g + stride;
        if (gn < g1) { d = conv_desc(P, gn); conv_load(d, r, tid); }
        __syncthreads();
#pragma unroll
        for (int i = 0; i < 4; ++i) {
            const int q = tid + NTHR * i, n = q >> 3, k0 = (q & 7) * 8;
            const float* p = l + k0 * CV_LD + n;
            uint4 o;
            o.x = pack2(p[0], p[CV_LD]);
            o.y = pack2(p[2 * CV_LD], p[3 * CV_LD]);
            o.z = pack2(p[4 * CV_LD], p[5 * CV_LD]);
            o.w = pack2(p[6 * CV_LD], p[7 * CV_LD]);
            *(uint4*)(dc.dst + (size_t)n * dc.ld_dst + k0) = o;
        }
        g = gn;
    }
}

DI void mod_item(const Params& P, int it, char* lds, int tid) {
    float* sl = (float*)lds;
    float* red = sl + 9 * 1024;
    __syncthreads();
    for (int i = tid; i < 9 * 1024; i += NTHR) {
        int r = i >> 10, k = i & 1023;
        float v = (r < 8) ? P.in[1][r * 1024 + k] : P.in[3][k];
        sl[i] = v * sigmoidf_(v);
    }
    __syncthreads();
    const int w = tid >> 6, lane = tid & 63, col = lane & 31, kp = lane >> 5;
    const int n0 = it * 32;
    const float* wa = P.in[4] + n0 + col;
    float acc[9];
#pragma unroll
    for (int r = 0; r < 9; ++r) acc[r] = 0.f;
#pragma unroll 16
    for (int i = 0; i < 64; ++i) {
        int k = w * 128 + 2 * i + kp;
        float wv = wa[(size_t)k * 6144];
#pragma unroll
        for (int r = 0; r < 9; ++r) acc[r] += sl[r * 1024 + k] * wv;
    }
#pragma unroll
    for (int r = 0; r < 9; ++r) {
        acc[r] += shx(acc[r], 32, lane);
        if (kp == 0) red[(w * 9 + r) * 32 + col] = acc[r];
    }
    __syncthreads();
    if (tid < 9 * 32) {
        int r = tid >> 5, c = tid & 31;
        float s = P.in[5][n0 + c];
#pragma unroll
        for (int ww = 0; ww < 8; ++ww) s += red[(ww * 9 + r) * 32 + c];
        ((float*)(P.ws + OFF_MOD))[r * 6144 + n0 + c] = s;
    }
}

DI void pe_item(const Params& P, int it, int tid) {
    int p = it, i = tid & 255;
    float omega = 1.0f / powf(10000.0f, (float)i / 256.0f);
    float ang = (float)p * omega;
    ((float*)(P.ws + OFF_PE))[p * 512 + tid] = (tid < 256) ? sinf(ang) : cosf(ang);
}

DI void hdn_item(const Params& P, int it, char* lds, int tid) {
    const int w = tid >> 6, j = tid & 63;
    float* w1s = (float*)lds;
    float* w2s = w1s + 33 * 64;
    float* zz = w2s + 64 * 64 + w * 128;
    float* h1s = zz + 64;
    __syncthreads();
    for (int i = tid; i < 33 * 64; i += NTHR) w1s[i] = P.in[16][i];
    for (int i = tid; i < 64 * 64; i += NTHR) w2s[i] = P.in[19][i];
    const float b1 = P.in[17][j], f1 = P.in[18][j], b2 = P.in[20][j], f2 = P.in[21][j];
    __syncthreads();
    for (int q = 0; q < 8; ++q) {
        const int t = it * 64 + w * 8 + q;
        if (j < 33) {
            float val;
            if (j == 0) val = (float)t / 2047.f;
            else {
                int bi = (j - 1) & 15;
                float freq = 1e-4f + (float)bi * ((15.f - 1e-4f) / 15.f);
                float ang = (6.283185307179586f * (float)t / 2048.f) * freq;
                val = (j <= 16) ? cosf(ang) : -sinf(ang);
            }
            zz[j] = val;
        }
        float acc = b1;
#pragma unroll 11
        for (int i = 0; i < 33; ++i) acc += zz[i] * w1s[i * 64 + j];
        h1s[j] = sinf(f1 * acc);
        acc = b2;
#pragma unroll 16
        for (int i = 0; i < 64; ++i) acc += h1s[i] * w2s[i * 64 + j];
        ((bf16_t*)(P.ws + OFF_HDN2))[t * 64 + j] = f2bf(sinf(f2 * acc));
    }
}

DI void wr_item(const Params& P, int j, int tid) {
    bf16_t* WRT = (bf16_t*)(P.ws + OFF_WR_T);
    {
        const int k = 16 * j + (tid >> 5), e = tid & 31;
        WRT[(4 + e) * 1024 + k] = f2bf(P.in[31][k * 32 + e]);
    }
    if (tid < 64) {
        const int k = 16 * j + (tid >> 2), n = tid & 3;
        WRT[n * 1024 + k] = f2bf(P.in[29][k * 4 + n]);
    }
    if (tid < 448) WRT[(36 + (tid >> 4)) * 1024 + 16 * j + (tid & 15)] = 0;
}
#define P0A_MOD 192
#define P0A_PE 128
#define P0A_HDN 32
#define P0A_GROUPS 2100
DI void phase0a(const Params& P, char* lds, int tid) {
    const int total = P0A_MOD + P0A_PE + P0A_HDN + NCONV_RNN;
    for (int it = blockIdx.x; it < total; it += gridDim.x) {
        if (it < P0A_MOD) mod_item(P, it, lds, tid);
        else if (it < P0A_MOD + P0A_PE) { if (it - P0A_MOD < 64) pe_item(P, it - P0A_MOD, tid); else wr_item(P, it - P0A_MOD - 64, tid); }
        else if (it < P0A_MOD + P0A_PE + P0A_HDN) hdn_item(P, it - P0A_MOD - P0A_PE, lds, tid);
        else conv_item(P, it - (P0A_MOD + P0A_PE + P0A_HDN), lds, tid);
    }
    conv_groups(P, blockIdx.x, P0A_GROUPS, gridDim.x, lds, tid);
}

DI void h1_item(const Params& P, int it, int tid) {
    const int w = tid >> 6, lane = tid & 63;
    const int row = it * 8 + w;
    const bool lat = row < NL_;
    const float* src = lat ? P.in[0] + (size_t)row * D_ : P.in[2] + (size_t)(row - NL_) * D_;
    const int b = lat ? (row >> 11) : 8;
    const int t = row & 2047;
    const float* mod = (const float*)(P.ws + OFF_MOD) + b * 6144;
    const float* pe = (const float*)(P.ws + OFF_PE);
    const float* g = P.in[6];
    float v[16];
    float ss = 0.f;
#pragma unroll
    for (int i = 0; i < 2; ++i) {
        const int d = i * 512 + lane * 8;
        float4 x0 = *(const float4*)(src + d), x1 = *(const float4*)(src + d + 4);
        if (lat) {
            const float* pp = (i == 0) ? pe + (t >> 6) * 512 + d : pe + (t & 63) * 512 + (d - 512);
            const float4 p0 = *(const float4*)pp, p1 = *(const float4*)(pp + 4);
            x0.x += p0.x; x0.y += p0.y; x0.z += p0.z; x0.w += p0.w;
            x1.x += p1.x; x1.y += p1.y; x1.z += p1.z; x1.w += p1.w;
        }
        v[i * 8 + 0] = x0.x; v[i * 8 + 1] = x0.y; v[i * 8 + 2] = x0.z; v[i * 8 + 3] = x0.w;
        v[i * 8 + 4] = x1.x; v[i * 8 + 5] = x1.y; v[i * 8 + 6] = x1.z; v[i * 8 + 7] = x1.w;
        ss += x0.x * x0.x + x0.y * x0.y + x0.z * x0.z + x0.w * x0.w + x1.x * x1.x + x1.y * x1.y + x1.z * x1.z + x1.w * x1.w;
    }
#pragma unroll
    for (int o = 32; o > 0; o >>= 1) ss += shx(ss, o, lane);
    const float rstd = rsqrtf(ss * (1.f / 1024.f) + 1e-6f);
    bf16_t* dst = (bf16_t*)(P.ws + OFF_H1) + (size_t)row * D_;
#pragma unroll
    for (int i = 0; i < 2; ++i) {
        const int d = i * 512 + lane * 8;
        float o[8];
#pragma unroll
        for (int hh = 0; hh < 2; ++hh) {
            const float4 gv = *(const float4*)(g + d + 4 * hh), sh = *(const float4*)(mod + d + 4 * hh), sc = *(const float4*)(mod + 1024 + d + 4 * hh);
            o[4 * hh + 0] = v[i * 8 + 4 * hh + 0] * rstd * gv.x * (1.f + sc.x) + sh.x;
            o[4 * hh + 1] = v[i * 8 + 4 * hh + 1] * rstd * gv.y * (1.f + sc.y) + sh.y;
            o[4 * hh + 2] = v[i * 8 + 4 * hh + 2] * rstd * gv.z * (1.f + sc.z) + sh.z;
            o[4 * hh + 3] = v[i * 8 + 4 * hh + 3] * rstd * gv.w * (1.f + sc.w) + sh.w;
        }
        *(uint4*)(dst + d) = make_uint4(pack2(o[0], o[1]), pack2(o[2], o[3]), pack2(o[4], o[5]), pack2(o[6], o[7]));
    }
}
#define P0B_H1 ((NL_ + NC_) / 8)
#define P0B_TAPS 64
DI void taps_item(const Params& P, int it, char* lds, int tid);
DI void phase0b(const Params& P, char* lds, int tid) {
    const int total = P0B_TAPS + P0B_H1;
    for (int it = blockIdx.x; it < total; it += gridDim.x) {
        if (it < P0B_TAPS) taps_item(P, it, lds, tid);
        else h1_item(P, it - P0B_TAPS, tid);
    }
    conv_groups(P, P0A_GROUPS + blockIdx.x, NG_TOTAL, gridDim.x, lds, tid);
}

namespace pg8 {
typedef f32x4 f32x4r;
#define PG8_LAS __attribute__((address_space(3)))
constexpr int BM = 256, BK = 64, HALF = 128, HTB = HALF * BK * 2, STAGE_BYTES8 = 8 * HTB;
DI int lds_byte(int r, int c) { const int st = (r >> 4) * 2 + (c >> 5), rr = r & 15, cc = c & 31, ob = rr * 64 + cc * 2; return st * 1024 + (ob ^ (((ob >> 9) & 1) << 5)); }
DI void stage_rc(int b, int& R, int& C) { const int st = b / 1024, sb = b % 1024, swz = sb ^ (((sb >> 9) & 1) << 5); R = (st >> 1) * 16 + swz / 64; C = (st & 1) * 32 + (swz % 64) / 2; }
DI int perm32(int rho) { const int n = rho >> 4, i = rho & 15; return 8 * (i >> 2) + 4 * n + (i & 3); }
DI unsigned cvt_pk_bf16(float lo, float hi) { unsigned r; asm volatile("v_cvt_pk_bf16_f32 %0, %1, %2" : "=v"(r) : "v"(lo), "v"(hi)); return r; }

struct GUnit { const char* A; const char* B; const char* B1; bf16_t* O; int ldc, valid, aux; const char* ga[2][2]; };
DI void stage_piece(int tid, int i, int& R, int& C) { stage_rc(tid * 16 + i * 8192, R, C); }

struct EpiStore {
    DI void operator()(const f32x4 (&acc)[2][2][4][2], const GUnit& u, int wr, int wc, int fr, int fq, char* lds) const {
        asm volatile("" : "+v"(fr), "+v"(fq));
#pragma unroll
        for (int ai = 0; ai < 2; ++ai)
#pragma unroll
            for (int m = 0; m < 4; ++m) {
                const int r = ai * HALF + wr * 64 + m * 16 + fr;
                bf16_t* rowp = u.O + (size_t)r * u.ldc + wc * 32 + 8 * fq;
                if (r < u.valid) {
#pragma unroll
                    for (int bj = 0; bj < 2; ++bj) {
                        const f32x4 v0 = acc[ai][bj][m][0], v1 = acc[ai][bj][m][1];
                        u32x4 w;
                        w.x = cvt_pk_bf16(v0[0], v0[1]); w.y = cvt_pk_bf16(v0[2], v0[3]); w.z = cvt_pk_bf16(v1[0], v1[1]); w.w = cvt_pk_bf16(v1[2], v1[3]);
                        *(u32x4*)(rowp + bj * HALF) = w;
                    }
                }
            }
    }
};

template <bool GATHER, class Epi, class Sched>
DI void gemm_phase(char* lds_generic, const int K, const Sched& S, const Epi& E, const int tid) {
    PG8_LAS unsigned char* lds = (PG8_LAS unsigned char*)lds_generic;
    const int wid = __builtin_amdgcn_readfirstlane(tid >> 6), lane = tid & 63, wr = wid >> 2, wc = wid & 3, fr = lane & 15, fq = lane >> 4;
    const int nt = K / BK;
    unsigned voffA[2], voffB[2];
#pragma unroll
    for (int i = 0; i < 2; ++i) {
        int R, C;
        stage_rc(tid * 16 + i * 8192, R, C);
        const int Rb = (R & ~31) + perm32(R & 31);
        voffA[i] = (unsigned)(R * K + C) * 2u;
        voffB[i] = (unsigned)(Rb * K + C) * 2u;
    }
    const size_t kstep = (size_t)(BK * 2);
    const size_t hstep = (size_t)HALF * K * 2;
    const unsigned ldsw = (unsigned)wid * 1024u;
    const int aoff = lds_byte(wr * 64 + fr, fq * 8), boff = lds_byte(wc * 32 + fr, fq * 8);
#define PG8_SA(b, h) (((b) * 2 + (h)) * HTB)
#define PG8_SB(b, h) ((4 + (b) * 2 + (h)) * HTB)
#define PG8_STAGE(bufoff, gbase, voff) do { _Pragma("unroll") for (int _i = 0; _i < 2; ++_i) \
        __builtin_amdgcn_global_load_lds((const unsigned*)((const char*)(gbase) + (voff)[_i]), (PG8_LAS unsigned*)(lds + (bufoff) + ldsw + _i * 8192), 16, 0, 0); } while (0)
#define PG8_STAGE_A(bufoff, uu, ubase, h, kb) do { _Pragma("unroll") for (int _i = 0; _i < 2; ++_i) { \
        const char* _p = GATHER ? (uu).ga[h][_i] + (kb) : (ubase) + (size_t)(h) * hstep + (kb) + voffA[_i]; \
        __builtin_amdgcn_global_load_lds((const unsigned*)_p, (PG8_LAS unsigned*)(lds + (bufoff) + ldsw + _i * 8192), 16, 0, 0); } } while (0)
#define PG8_LDA(dst, b, h) do { _Pragma("unroll") for (int m = 0; m < 4; ++m) _Pragma("unroll") for (int k = 0; k < 2; ++k) dst[m][k] = *(const PG8_LAS bf16x8*)(lds + PG8_SA(b, h) + aoff + m * 2048 + k * 1024); } while (0)
#define PG8_LDB(dst, b, h) do { _Pragma("unroll") for (int n = 0; n < 2; ++n) _Pragma("unroll") for (int k = 0; k < 2; ++k) dst[n][k] = *(const PG8_LAS bf16x8*)(lds + PG8_SB(b, h) + boff + n * 2048 + k * 1024); } while (0)
#define PG8_MMA(ai, bj, At, Bt) do { __builtin_amdgcn_s_setprio(1); _Pragma("unroll") for (int m = 0; m < 4; ++m) _Pragma("unroll") for (int n = 0; n < 2; ++n) _Pragma("unroll") for (int k = 0; k < 2; ++k) \
        acc[ai][bj][m][n] = __builtin_amdgcn_mfma_f32_16x16x32_bf16(Bt[n][k], At[m][k], acc[ai][bj][m][n], 0, 0, 0); __builtin_amdgcn_s_setprio(0); } while (0)
#define PG8_WAIT_V(n) asm volatile("s_waitcnt vmcnt(" #n ")" ::: "memory")
#define PG8_WAIT_L(n) asm volatile("s_waitcnt lgkmcnt(" #n ")" ::: "memory")
#define PG8_BAR __builtin_amdgcn_s_barrier()
#define PG8_SCHED __builtin_amdgcn_sched_barrier(0)
    GUnit cur, nxt;
    int ui = 0;
    if (!S.next(0, cur)) return;
    f32x4 acc[2][2][4][2];
#pragma unroll
    for (int a = 0; a < 2; ++a)
#pragma unroll
        for (int b = 0; b < 2; ++b)
#pragma unroll
            for (int m = 0; m < 4; ++m)
#pragma unroll
                for (int n = 0; n < 2; ++n) acc[a][b][m][n] = (f32x4){0.f, 0.f, 0.f, 0.f};
    bf16x8 At[4][2], B0[2][2], B1[2][2];
    PG8_STAGE(PG8_SB(0, 0), cur.B, voffB); PG8_STAGE_A(PG8_SA(0, 0), cur, cur.A, 0, 0); PG8_STAGE(PG8_SB(0, 1), cur.B1, voffB); PG8_STAGE_A(PG8_SA(0, 1), cur, cur.A, 1, 0);
    if (wr == 1) PG8_BAR;
    PG8_WAIT_V(4); PG8_BAR;
    PG8_STAGE(PG8_SB(1, 0), cur.B + kstep, voffB); PG8_STAGE_A(PG8_SA(1, 0), cur, cur.A, 0, kstep); PG8_STAGE(PG8_SB(1, 1), cur.B1 + kstep, voffB);
    PG8_WAIT_V(6); PG8_BAR;
    for (;;) {
        const bool has_next = S.next(ui + 1, nxt);
        if (!has_next) {
            nxt.A = cur.A; nxt.B = cur.B; nxt.B1 = cur.B1;
            if (GATHER) { nxt.ga[0][0] = cur.ga[0][0]; nxt.ga[0][1] = cur.ga[0][1]; nxt.ga[1][0] = cur.ga[1][0]; nxt.ga[1][1] = cur.ga[1][1]; }
        }
        for (int t = 0; t < nt; t += 2) {
            const bool last = (t == nt - 2);
            const size_t k2 = last ? (size_t)0 : (size_t)(t + 2) * kstep;
            const size_t k1 = (size_t)(t + 1) * kstep, k3 = k2 + kstep;
            struct { const char* A; const char* B; const char* B1; const char* ga[2][2]; } w2;
            w2.A = last ? nxt.A : cur.A; w2.B = last ? nxt.B : cur.B; w2.B1 = last ? nxt.B1 : cur.B1;
            if (GATHER) {
                w2.ga[0][0] = last ? nxt.ga[0][0] : cur.ga[0][0]; w2.ga[0][1] = last ? nxt.ga[0][1] : cur.ga[0][1];
                w2.ga[1][0] = last ? nxt.ga[1][0] : cur.ga[1][0]; w2.ga[1][1] = last ? nxt.ga[1][1] : cur.ga[1][1];
            }
            PG8_LDB(B0, 0, 0); PG8_SCHED; PG8_LDA(At, 0, 0); PG8_STAGE_A(PG8_SA(1, 1), cur, cur.A, 1, k1);
            PG8_WAIT_L(8); PG8_BAR; PG8_WAIT_L(0); PG8_MMA(0, 0, At, B0); PG8_BAR; PG8_SCHED;
            PG8_LDB(B1, 0, 1); PG8_STAGE(PG8_SB(0, 0), w2.B + k2, voffB);
            PG8_BAR; PG8_WAIT_L(0); PG8_MMA(0, 1, At, B1); PG8_BAR;
            PG8_LDA(At, 0, 1); PG8_STAGE_A(PG8_SA(0, 0), w2, w2.A, 0, k2);
            PG8_BAR; PG8_WAIT_L(0); PG8_MMA(1, 0, At, B0); PG8_BAR; PG8_SCHED;
            PG8_STAGE(PG8_SB(0, 1), w2.B1 + k2, voffB);
            PG8_WAIT_V(6); PG8_BAR; PG8_MMA(1, 1, At, B1); PG8_BAR;
            PG8_LDB(B0, 1, 0); PG8_SCHED; PG8_LDA(At, 1, 0); PG8_STAGE_A(PG8_SA(0, 1), w2, w2.A, 1, k2);
            PG8_WAIT_L(8); PG8_BAR; PG8_WAIT_L(0); PG8_MMA(0, 0, At, B0); PG8_BAR; PG8_SCHED;
            PG8_LDB(B1, 1, 1); PG8_STAGE(PG8_SB(1, 0), w2.B + k3, voffB);
            PG8_BAR; PG8_WAIT_L(0); PG8_MMA(0, 1, At, B1); PG8_BAR;
            PG8_LDA(At, 1, 1); PG8_STAGE_A(PG8_SA(1, 0), w2, w2.A, 0, k3);
            PG8_BAR; PG8_WAIT_L(0); PG8_MMA(1, 0, At, B0); PG8_BAR; PG8_SCHED;
            PG8_STAGE(PG8_SB(1, 1), w2.B1 + k3, voffB);
            PG8_WAIT_V(6); PG8_BAR; PG8_MMA(1, 1, At, B1); PG8_BAR;
        }
        E(acc, cur, wr, wc, fr, fq, lds_generic);
        if (!has_next) break;
#pragma unroll
        for (int a = 0; a < 2; ++a)
#pragma unroll
            for (int b = 0; b < 2; ++b)
#pragma unroll
                for (int m = 0; m < 4; ++m)
#pragma unroll
                    for (int n = 0; n < 2; ++n) acc[a][b][m][n] = (f32x4){0.f, 0.f, 0.f, 0.f};
        cur.A = nxt.A; cur.B = nxt.B; cur.B1 = nxt.B1; cur.O = nxt.O; cur.ldc = nxt.ldc; cur.valid = nxt.valid; cur.aux = nxt.aux;
        if (GATHER) { cur.ga[0][0] = nxt.ga[0][0]; cur.ga[0][1] = nxt.ga[0][1]; cur.ga[1][0] = nxt.ga[1][0]; cur.ga[1][1] = nxt.ga[1][1]; }
        ++ui;
    }
    PG8_WAIT_V(0);
    if (wr == 0) PG8_BAR;
    PG8_BAR;
#undef PG8_SA
#undef PG8_SB
#undef PG8_STAGE
#undef PG8_STAGE_A
#undef PG8_LDA
#undef PG8_LDB
#undef PG8_MMA
#undef PG8_WAIT_V
#undef PG8_WAIT_L
#undef PG8_BAR
#undef PG8_SCHED
}
}

struct GPtr { const bf16_t* a[4]; const bf16_t* b[2]; };
#define GC_LOAD(SI, kt_)                                                                                 \
    do {                                                                                                  \
        const int ko_ = (kt_) * 64;                                                                       \
        S[SI][0] = *(const u32x4*)(g.a[0] + ko_); S[SI][1] = *(const u32x4*)(g.a[1] + ko_);               \
        S[SI][2] = *(const u32x4*)(g.a[2] + ko_); S[SI][3] = *(const u32x4*)(g.a[3] + ko_);               \
        S[SI][4] = *(const u32x4*)(g.b[0] + ko_); S[SI][5] = *(const u32x4*)(g.b[1] + ko_);               \
    } while (0)
#define GC_STORE(SI, st_)                                                                                 \
    do {                                                                                                  \
        char* s2_ = lds + (st_) * STAGE_BYTES;                                                            \
        *(u32x4*)(s2_ + a_w) = S[SI][0]; *(u32x4*)(s2_ + a_w + 64 * LROW) = S[SI][1];                      \
        *(u32x4*)(s2_ + a_w + 128 * LROW) = S[SI][2]; *(u32x4*)(s2_ + a_w + 192 * LROW) = S[SI][3];        \
        *(u32x4*)(s2_ + b_w) = S[SI][4]; *(u32x4*)(s2_ + b_w + 64 * LROW) = S[SI][5];                      \
    } while (0)
#define GC_BODY(kt_, SL, SS)                                                                              \
    do {                                                                                                  \
        if ((kt_) + 3 < nk) GC_LOAD(SL, (kt_) + 3);                                                       \
        const char* s_ = lds + ((kt_) & 1) * STAGE_BYTES;                                                 \
        _Pragma("unroll") for (int ks = 0; ks < 4; ++ks) {                                                \
            const bf16x8 fa0 = *(const bf16x8*)(s_ + a_r + ks * 32);                                      \
            const bf16x8 fa1 = *(const bf16x8*)(s_ + a_r + 32 * LROW + ks * 32);                          \
            const bf16x8 fb0 = *(const bf16x8*)(s_ + b_r + ks * 32);                                      \
            const bf16x8 fb1 = *(const bf16x8*)(s_ + b_r + 32 * LROW + ks * 32);                          \
            if (SWAP) {                                                                                   \
                acc[0][0] = MFMA32(fb0, fa0, acc[0][0]); acc[0][1] = MFMA32(fb1, fa0, acc[0][1]);         \
                acc[1][0] = MFMA32(fb0, fa1, acc[1][0]); acc[1][1] = MFMA32(fb1, fa1, acc[1][1]);         \
            } else {                                                                                      \
                acc[0][0] = MFMA32(fa0, fb0, acc[0][0]); acc[0][1] = MFMA32(fa0, fb1, acc[0][1]);         \
                acc[1][0] = MFMA32(fa1, fb0, acc[1][0]); acc[1][1] = MFMA32(fa1, fb1, acc[1][1]);         \
            }                                                                                             \
        }                                                                                                 \
        if ((kt_) + 1 < nk) GC_STORE(SS, ((kt_) + 1) & 1);                                                \
        __syncthreads();                                                                                  \
    } while (0)

DI void gemm_issue(u32x4 (&S)[3][6], const GPtr& g) {
    GC_LOAD(0, 0);
    GC_LOAD(1, 1);
    GC_LOAD(2, 2);
}
template <bool SWAP>
DI void gemm_run(f32x16 (&acc)[2][2], u32x4 (&S)[3][6], const GPtr& g, int nk, char* lds, int tid) {
    const int lrow = tid >> 3, lchunk = tid & 7;
    const unsigned a_w = lrow * LROW + lchunk * 16;
    const unsigned b_w = A_STAGE + lrow * LROW + lchunk * 16;
    const int lane = tid & 63, w = tid >> 6, wm = w >> 1, wn = w & 1, r = lane & 31, h = lane >> 5;
    const unsigned a_r = (wm * 64 + r) * LROW + h * 16;
    const unsigned b_r = A_STAGE + (wn * 64 + r) * LROW + h * 16;
#pragma unroll
    for (int i = 0; i < 2; ++i)
#pragma unroll
        for (int j = 0; j < 2; ++j)
#pragma unroll
            for (int e = 0; e < 16; ++e) acc[i][j][e] = 0.f;
    __syncthreads();
    GC_STORE(0, 0);
    __syncthreads();
    for (int kt = 0; kt < nk; kt += 3) {
        GC_BODY(kt, 0, 1);
        if (kt + 1 < nk) GC_BODY(kt + 1, 1, 2);
        if (kt + 2 < nk) GC_BODY(kt + 2, 2, 0);
    }
}

#define ET_ROW 272
#define ETS_ROW 528
DI void acc_to_lds_tok(const f32x16 (&acc)[2][2], char* lds, int wm, int wn, int r, int h) {
#pragma unroll
    for (int i = 0; i < 2; ++i)
#pragma unroll
        for (int j = 0; j < 2; ++j)
#pragma unroll
            for (int g = 0; g < 4; ++g)
                *(uint2*)(lds + (wm * 64 + i * 32 + r) * ET_ROW + (wn * 64 + j * 32 + 8 * g + 4 * h) * 2) =
                    make_uint2(pack2(acc[i][j][4 * g], acc[i][j][4 * g + 1]), pack2(acc[i][j][4 * g + 2], acc[i][j][4 * g + 3]));
}
DI void acc_to_lds_chan(const f32x16 (&acc)[2][2], char* lds, int wm, int wn, int r, int h) {
#pragma unroll
    for (int i = 0; i < 2; ++i)
#pragma unroll
        for (int j = 0; j < 2; ++j)
#pragma unroll
            for (int g = 0; g < 4; ++g)
                *(uint2*)(lds + (wn * 64 + j * 32 + r) * ETS_ROW + (wm * 64 + i * 32 + 8 * g + 4 * h) * 2) =
                    make_uint2(pack2(acc[i][j][4 * g], acc[i][j][4 * g + 1]), pack2(acc[i][j][4 * g + 2], acc[i][j][4 * g + 3]));
}
DI void lds_to_rows(char* lds, bf16_t* dst, int ld, int valid, int tid) {
#pragma unroll
    for (int i = 0; i < 8; ++i) {
        const int q = tid + NTHR * i, row = q >> 4, ch = q & 15;
        if (row < valid) *(uint4*)(dst + (size_t)row * ld + ch * 8) = *(const uint4*)(lds + row * ET_ROW + ch * 16);
    }
}

struct P1Sched {
    const char* h1; const char* wt; bf16_t* pa; bf16_t* pu; bf16_t* pht; int x, j, nj;
    DI bool next(int i, pg8::GUnit& u) const {
        const int k = j + i * nj;
        if (k >= 82) return false;
        u.valid = 256; u.aux = 0;
        if (k < 32) {
            const int pm = (k >> 2) * 8 + x, pn = k & 3;
            u.A = h1 + (size_t)pm * 256 * 2048;
            u.B = wt + (size_t)pn * 256 * 2048;
            u.B1 = u.B + (size_t)128 * 2048;
            u.O = ((pn < 2) ? pa + pn * 256 : pu + (pn - 2) * 256) + (size_t)pm * 256 * 512;
            u.ldc = 512;
        } else if (k < 34) {
            const int pn = k - 32;
            u.A = h1 + (size_t)(NL_ + x * 256) * 2048;
            u.B = wt + (size_t)(512 + pn * 256) * 2048;
            u.B1 = u.B + (size_t)128 * 2048;
            u.O = pu + (size_t)(NL_ + x * 256) * 512 + pn * 256;
            u.ldc = 512;
        } else {
            const int k2 = k - 34, tt = (k2 / 6) * 8 + x, pm = k2 % 6;
            u.A = wt + (size_t)(1024 + pm * 256) * 2048;
            u.B = h1 + (size_t)tt * 256 * 2048;
            u.B1 = u.B + (size_t)128 * 2048;
            u.O = pht + (size_t)pm * 256 * NL_ + tt * 256;
            u.ldc = NL_;
        }
        return true;
    }
};
DI void phase1(const Params& P, char* lds, int tid) {
    char* ws = P.ws;
    P1Sched S{ws + OFF_H1, ws + OFF_WIN_T, (bf16_t*)(ws + OFF_PA), (bf16_t*)(ws + OFF_PU), (bf16_t*)(ws + OFF_PHT),
              (int)(blockIdx.x & 7), (int)(blockIdx.x >> 3), (int)(gridDim.x >> 3)};
    pg8::EpiStore E;
    pg8::gemm_phase<false>(lds, 1024, S, E, tid);
}

DI int crow(int e, int h) { return (e & 3) + 8 * (e >> 2) + 4 * h; }

DI void taps_item(const Params& P, int it, char* lds, int tid) {
    const int lane = tid & 63, w = __builtin_amdgcn_readfirstlane(tid >> 6), r = lane & 31, h = lane >> 5;
    const int col0 = it * 32;
    const int dir = col0 >> 10, o = (col0 >> 9) & 1;
    const float* w3 = P.in[22];
    const float* b3 = P.in[23];
    const bf16_t* HB = (const bf16_t*)(P.ws + OFF_HDN2);
    bf16_t* RALL = (bf16_t*)(P.ws + OFF_RALL);
    float* red = (float*)lds;
    __syncthreads();
    bf16x8 fa[4];
#pragma unroll
    for (int ks = 0; ks < 4; ++ks)
#pragma unroll
        for (int j = 0; j < 8; ++j) fa[ks][j] = (short)f2bf(w3[(size_t)(16 * ks + 8 * h + j) * 2048 + col0 + r]);
    float s[16];
#pragma unroll
    for (int e = 0; e < 16; ++e) s[e] = 0.f;
    const float mind = -3.0701134573253945f, maxd = -15.350567286626973f;
    for (int q = 0; q < 8; ++q) {
        const int t0 = (w * 8 + q) * 32, t = t0 + r;
        f32x16 acc;
#pragma unroll
        for (int e = 0; e < 16; ++e) acc[e] = 0.f;
#pragma unroll
        for (int ks = 0; ks < 4; ++ks) {
            bf16x8 fb = *(const bf16x8*)(HB + (size_t)t * 64 + 16 * ks + 8 * h);
            acc = MFMA32(fa[ks], fb, acc);
        }
        const float tt = (float)t / 2047.f;
        const bool valid = !(dir == 1 && t == 0);
#pragma unroll
        for (int e = 0; e < 16; ++e) {
            const int col = col0 + crow(e, h);
            const int c = col & 511;
            const float delta = fabsf(mind + (float)c * ((maxd - mind) / 511.f));
            const float val = (acc[e] + b3[col]) * __expf(-tt * delta);
            if (valid) s[e] += fabsf(val);
            *(bf16_t*)(lds + 4096 + crow(e, h) * 4112 + (dir ? t : 2048 - t) * 2) = f2bf(valid ? val : 0.f);
        }
    }
#pragma unroll
    for (int e = 0; e < 16; ++e) {
        float v = s[e];
        v += shx(v, 16, lane); v += shx(v, 8, lane); v += shx(v, 4, lane); v += shx(v, 2, lane); v += shx(v, 1, lane);
        if (r == 0) red[w * 32 + crow(e, h)] = v;
    }
    if (dir == 0 && tid < 32) *(bf16_t*)(lds + 4096 + tid * 4112) = 0;
    __syncthreads();
    if (tid < 32) {
        float v = 0.f;
#pragma unroll
        for (int ww = 0; ww < 8; ++ww) v += red[ww * 32 + tid];
        const int c = (col0 + tid) & 511;
        ((float*)(P.ws + OFF_NRM2))[(dir * 2 + o) * 512 + c] = v;
        bf16_t* R = RALL + (size_t)(c * 2 + o) * 4104;
        const bf16_t* img = (const bf16_t*)(lds + 4096 + tid * 4112);
        if (dir == 0) {
            R[2048] = img[2048];
            unsigned z = 0u;
            asm volatile("" : "+v"(z));
            *(uint4*)(R + 4096) = make_uint4(z, z, z, z);
        } else {
#pragma unroll
            for (int k = 1; k < 8; ++k) R[2048 + k] = img[k];
        }
    }
    for (int q = tid; q < 32 * 256; q += NTHR) {
        const int cl = q >> 8, k = q & 255;
        if (dir == 1 && k == 0) continue;
        const int c = (col0 + cl) & 511;
        *(uint4*)(RALL + (size_t)(c * 2 + o) * 4104 + (dir ? 2048 : 0) + 8 * k) = *(const uint4*)(lds + 4096 + cl * 4112 + 16 * k);
    }
}

#define HY_G 0
#define HY_GSTRIDE 8448
#define HY_GOFF(sh) ((0x8D518D50u >> (4 * (sh))) & 15u)
#define HY_U 67584
#define HY_UROW 6160
#define HY_PAD 15
#define HY_GATE (HY_U + 8 * HY_UROW)

DI void conv32(const bf16_t* src, int J, float w0, float w1, float w2, uint4 (&o)[4]) {
    const uint4* p = (const uint4*)(src + 32 * J);
    const uint4 q0 = p[0], q1 = p[1], q2 = p[2], q3 = p[3];
    const float prev = (J > 0) ? bf2f(src[32 * J - 1]) : 0.f;
    const float next = (J < 63) ? bf2f(src[32 * J + 32]) : 0.f;
    const unsigned wv[16] = {q0.x, q0.y, q0.z, q0.w, q1.x, q1.y, q1.z, q1.w, q2.x, q2.y, q2.z, q2.w, q3.x, q3.y, q3.z, q3.w};
    float x[34];
    x[0] = prev;
#pragma unroll
    for (int i = 0; i < 16; ++i) {
        x[1 + 2 * i] = __uint_as_float(wv[i] << 16);
        x[2 + 2 * i] = __uint_as_float(wv[i] & 0xffff0000u);
    }
    x[33] = next;
    unsigned y[16];
#pragma unroll
    for (int i = 0; i < 16; ++i) {
        const float a = w0 * x[2 * i] + w1 * x[2 * i + 1] + w2 * x[2 * i + 2];
        const float b = w0 * x[2 * i + 1] + w1 * x[2 * i + 2] + w2 * x[2 * i + 3];
        y[i] = pack2(a, b);
    }
    o[0] = make_uint4(y[0], y[1], y[2], y[3]);
    o[1] = make_uint4(y[4], y[5], y[6], y[7]);
    o[2] = make_uint4(y[8], y[9], y[10], y[11]);
    o[3] = make_uint4(y[12], y[13], y[14], y[15]);
}

DI void hyena_item(const Params& P, int c, char* lds, int tid) {
    const bf16_t* PHT = (const bf16_t*)(P.ws + OFF_PHT);
    const bf16_t* RALL = (const bf16_t*)(P.ws + OFF_RALL) + (size_t)c * 2 * 4104;
    const float* NRM2 = (const float*)(P.ws + OFF_NRM2);
    bf16_t* YBT = (bf16_t*)(P.ws + OFF_YBT);
    const float* cw = P.in[15];
    const int lane = tid & 63;
    const int w = __builtin_amdgcn_readfirstlane(tid >> 6);
    const int g = w & 3, par = w >> 2;
    const int h = lane >> 5, i_ = lane & 31;
    const int lb = tid >> 6, lJ = tid & 63;
    __syncthreads();
    for (int q = tid; q < 8 * 2 * 60; q += NTHR) {
        const int b = q / 120, rem = q % 120, side = rem / 60, k = rem % 60;
        *(uint4*)(lds + HY_U + b * HY_UROW + (side ? (HY_PAD + 64) * 64 : 0) + k * 16) = make_uint4(0u, 0u, 0u, 0u);
    }
    {
        uint4 o[4];
        conv32(PHT + (size_t)c * NL_ + lb * S_, lJ, cw[c], cw[1536 + c], cw[3072 + c], o);
        uint4* d = (uint4*)(lds + HY_U + lb * HY_UROW + (HY_PAD + lJ) * 64);
        d[0] = o[0]; d[1] = o[1]; d[2] = o[2]; d[3] = o[3];
        conv32(PHT + (size_t)(512 + c) * NL_ + lb * S_, lJ, cw[512 + c], cw[1536 + 512 + c], cw[3072 + 512 + c], o);
        uint4* e = (uint4*)(lds + HY_GATE + lb * 4096 + lJ * 64);
        e[0] = o[0]; e[1] = o[1]; e[2] = o[2]; e[3] = o[3];
    }
    const int sh_ = (-i_) & 7;
    const int a_base = HY_G + sh_ * HY_GSTRIDE + (int)HY_GOFF(sh_) * 16 + (2048 - i_ + 8 * h - sh_) * 2;
    const int batch = i_ >> 2, blk = i_ & 3;
    const int b_base = HY_U + batch * HY_UROW + ((HY_PAD + blk) * 32 + 8 * h) * 2;
    for (int o_ = 0; o_ < 2; ++o_) {
        __syncthreads();
        if (o_ == 1) {
            uint4 o[4];
            conv32(PHT + (size_t)(1024 + c) * NL_ + lb * S_, lJ, cw[1024 + c], cw[1536 + 1024 + c], cw[3072 + 1024 + c], o);
            uint4* e = (uint4*)(lds + HY_GATE + lb * 4096 + lJ * 64);
            e[0] = o[0]; e[1] = o[1]; e[2] = o[2]; e[3] = o[3];
        }
        {
            const uint4* Rg = (const uint4*)(RALL + (size_t)o_ * 4104);
            const uint4 lo = Rg[tid], hi = Rg[tid + 1];
            const unsigned wv[8] = {lo.x, lo.y, lo.z, lo.w, hi.x, hi.y, hi.z, hi.w};
#pragma unroll
            for (int sh = 0; sh < 8; ++sh) {
                const int s2 = sh >> 1;
                uint4 ov;
                if (sh & 1) {
                    ov.x = (wv[s2] >> 16) | (wv[s2 + 1] << 16);
                    ov.y = (wv[s2 + 1] >> 16) | (wv[s2 + 2] << 16);
                    ov.z = (wv[s2 + 2] >> 16) | (wv[s2 + 3] << 16);
                    ov.w = (wv[s2 + 3] >> 16) | (wv[s2 + 4] << 16);
                } else {
                    ov = make_uint4(wv[s2], wv[s2 + 1], wv[s2 + 2], wv[s2 + 3]);
                }
                *(uint4*)(lds + HY_G + sh * HY_GSTRIDE + (int)HY_GOFF(sh) * 16 + tid * 16) = ov;
            }
        }
        __syncthreads();
        f32x16 acc[4];
#pragma unroll
        for (int tt = 0; tt < 4; ++tt)
#pragma unroll
            for (int e = 0; e < 16; ++e) acc[tt][e] = 0.f;
#pragma unroll 1
        for (int rr = 0; rr < 2; ++rr) {
            int D = 16 * g - 63 + 2 * par + rr;
            bf16x8 wb0[4], wb1[4];
#pragma unroll
            for (int tt = 0; tt < 4; ++tt) {
                wb0[tt] = *(const bf16x8*)(lds + b_base + ((4 * (4 * g + tt) - D) * 64));
                wb1[tt] = *(const bf16x8*)(lds + b_base + ((4 * (4 * g + tt) - D) * 64 + 32));
            }
#pragma unroll 4
            for (; D <= 16 * g + 15; D += 4) {
                const bf16x8 fa0 = *(const bf16x8*)(lds + a_base + (-64 * D));
                const bf16x8 fa1 = *(const bf16x8*)(lds + a_base + (-64 * D + 32));
                bf16x8 n0 = wb0[0], n1 = wb1[0];
                if (D + 4 <= 16 * g + 15) {
                    n0 = *(const bf16x8*)(lds + b_base + ((16 * g - D - 4) * 64));
                    n1 = *(const bf16x8*)(lds + b_base + ((16 * g - D - 4) * 64 + 32));
                }
#pragma unroll
                for (int tt = 0; tt < 4; ++tt) acc[tt] = MFMA32(fa0, wb0[tt], acc[tt]);
#pragma unroll
                for (int tt = 0; tt < 4; ++tt) acc[tt] = MFMA32(fa1, wb1[tt], acc[tt]);
                wb0[3] = wb0[2]; wb0[2] = wb0[1]; wb0[1] = wb0[0]; wb0[0] = n0;
                wb1[3] = wb1[2]; wb1[2] = wb1[1]; wb1[1] = wb1[0]; wb1[0] = n1;
            }
        }
        __syncthreads();
        float* scr = (float*)(lds + HY_G);
        if (par == 1) {
#pragma unroll
            for (int tt = 0; tt < 4; ++tt)
#pragma unroll
                for (int e = 0; e < 16; ++e) scr[((g * 4 + tt) * 16 + e) * 64 + lane] = acc[tt][e];
        }
        __syncthreads();
        if (par == 0) {
            const float inv = 1.f / (NRM2[(0 * 2 + o_) * 512 + c] + NRM2[(1 * 2 + o_) * 512 + c]);
            const float bias = P.in[24][o_ * 512 + c];
#pragma unroll
            for (int tt = 0; tt < 4; ++tt) {
                const int I = 4 * (4 * g + tt) + blk;
#pragma unroll
                for (int q = 0; q < 4; ++q) {
                    const int i0 = 8 * q + 4 * h;
                    char* up = lds + HY_U + batch * HY_UROW + ((HY_PAD + I) * 32 + i0) * 2;
                    const uint2 uu = *(const uint2*)up;
                    const uint2 gg = *(const uint2*)(lds + HY_GATE + batch * 4096 + (32 * I + i0) * 2);
                    float rr[4];
#pragma unroll
                    for (int e = 0; e < 4; ++e) {
                        const float a = acc[tt][4 * q + e] + scr[((g * 4 + tt) * 16 + 4 * q + e) * 64 + lane];
                        const unsigned uw = (e < 2) ? uu.x : uu.y, gw = (e < 2) ? gg.x : gg.y;
                        const float uf = (e & 1) ? __uint_as_float(uw & 0xffff0000u) : __uint_as_float(uw << 16);
                        const float gf = (e & 1) ? __uint_as_float(gw & 0xffff0000u) : __uint_as_float(gw << 16);
                        rr[e] = gf * (a * inv + uf * bias);
                    }
                    uint2 ov;
                    ov.x = pack2(rr[0], rr[1]);
                    ov.y = pack2(rr[2], rr[3]);
                    *(uint2*)up = ov;
                }
            }
        }
    }
    __syncthreads();
    {
        const uint4* sp = (const uint4*)(lds + HY_U + lb * HY_UROW + (HY_PAD + lJ) * 64);
        uint4* gp = (uint4*)(YBT + (size_t)c * NL_ + lb * S_ + lJ * 32);
        gp[0] = sp[0]; gp[1] = sp[1]; gp[2] = sp[2]; gp[3] = sp[3];
    }
}

#define RN_V 0
#define RN_W 36864
#define RN_AGG 55296
#define RN_CARRY 59392

DI void rnn_item(const Params& P, int it, char* lds, int tid) {
    const int b = it >> 4, hd = (it >> 1) & 7, dir = it & 1;
    const bf16_t* PU = (const bf16_t*)(P.ws + OFF_PU);
    const bf16_t* WR = (const bf16_t*)(P.ws + OFF_WRNN_T);
    bf16_t* HS = (bf16_t*)(P.ws + OFF_HS) + (size_t)dir * NL_ * 512;
    const int lane = tid & 63, w = __builtin_amdgcn_readfirstlane(tid >> 6), r = lane & 31, h = lane >> 5;
    float* AGG = (float*)(lds + RN_AGG);
    float* CARRY = (float*)(lds + RN_CARRY);
    __syncthreads();
    for (int q = tid; q < 1024; q += NTHR) {
        const int n = q >> 3, ch = q & 7;
        *(uint4*)(lds + RN_W + n * LROW + ch * 16) = *(const uint4*)(WR + (size_t)(hd * 256 + dir * 128 + n) * 64 + ch * 8);
    }
    if (tid < 64) CARRY[tid] = 0.f;
    float ba[2], bx[2], sp[2];
#pragma unroll
    for (int jh = 0; jh < 2; ++jh) {
        const int ch = hd * 64 + jh * 32 + r;
        ba[jh] = P.in[11][dir * 512 + ch];
        bx[jh] = P.in[13][dir * 512 + ch];
        sp[jh] = log1pf(expf(-P.in[14][dir * 512 + ch]));
    }
    const int cc = tid & 7, tg = tid >> 3;
    for (int ci = 0; ci < 9; ++ci) {
        const bool isctx = (ci == 0);
        const int n = isctx ? CT_ : S_;
        const int tbase = isctx ? 0 : (dir ? (8 - ci) * 256 : (ci - 1) * 256);
        const bf16_t* src = (isctx ? PU + (size_t)(NL_ + b * CT_) * 512 : PU + (size_t)(b * S_) * 512) + hd * 64 + cc * 8;
        const int tlo = dir ? (tbase + 255 - 4 * tg - 3) : (tbase + 4 * tg);
        {
            float cwv[4][8], cbv[8];
            {
                const float4* cb4 = (const float4*)(P.in[9] + hd * 64 + cc * 8);
                const float4 c0 = cb4[0], c1 = cb4[1];
                cbv[0] = c0.x; cbv[1] = c0.y; cbv[2] = c0.z; cbv[3] = c0.w; cbv[4] = c1.x; cbv[5] = c1.y; cbv[6] = c1.z; cbv[7] = c1.w;
#pragma unroll
                for (int m = 0; m < 4; ++m) {
                    const float4* cw4 = (const float4*)(P.in[8] + m * 512 + hd * 64 + cc * 8);
                    const float4 d0 = cw4[0], d1 = cw4[1];
                    cwv[m][0] = d0.x; cwv[m][1] = d0.y; cwv[m][2] = d0.z; cwv[m][3] = d0.w;
                    cwv[m][4] = d1.x; cwv[m][5] = d1.y; cwv[m][6] = d1.z; cwv[m][7] = d1.w;
                }
            }
            float x[7][8];
#pragma unroll
            for (int m = 0; m < 7; ++m) {
                const int t = tlo - 2 + m;
                uint4 q = make_uint4(0u, 0u, 0u, 0u);
                if (t >= 0 && t < n) q = *(const uint4*)(src + (size_t)t * 512);
                x[m][0] = __uint_as_float(q.x << 16); x[m][1] = __uint_as_float(q.x & 0xffff0000u);
                x[m][2] = __uint_as_float(q.y << 16); x[m][3] = __uint_as_float(q.y & 0xffff0000u);
                x[m][4] = __uint_as_float(q.z << 16); x[m][5] = __uint_as_float(q.z & 0xffff0000u);
                x[m][6] = __uint_as_float(q.w << 16); x[m][7] = __uint_as_float(q.w & 0xffff0000u);
            }
#pragma unroll
            for (int k = 0; k < 4; ++k) {
                float v[8];
#pragma unroll
                for (int j = 0; j < 8; ++j)
                    v[j] = cbv[j] + cwv[0][j] * x[k][j] + cwv[1][j] * x[k + 1][j] + cwv[2][j] * x[k + 2][j] + cwv[3][j] * x[k + 3][j];
                const int rho = dir ? (4 * tg + 3 - k) : (4 * tg + k);
                *(uint4*)(lds + RN_V + rho * LROW + cc * 16) = make_uint4(pack2(v[0], v[1]), pack2(v[2], v[3]), pack2(v[4], v[5]), pack2(v[6], v[7]));
            }
        }
        __syncthreads();
        f32x16 acc[4];
#pragma unroll
        for (int nt = 0; nt < 4; ++nt)
#pragma unroll
            for (int e = 0; e < 16; ++e) acc[nt][e] = 0.f;
#pragma unroll
        for (int ks = 0; ks < 4; ++ks) {
            const bf16x8 fa = *(const bf16x8*)(lds + RN_V + (32 * w + r) * LROW + ks * 32 + h * 16);
#pragma unroll
            for (int nt = 0; nt < 4; ++nt) {
                const bf16x8 fb = *(const bf16x8*)(lds + RN_W + (32 * nt + r) * LROW + ks * 32 + h * 16);
                acc[nt] = MFMA32(fa, fb, acc[nt]);
            }
        }
        float av[2][16], bv[2][16];
#pragma unroll
        for (int jh = 0; jh < 2; ++jh)
#pragma unroll
            for (int e = 0; e < 16; ++e) {
                const int rho = 32 * w + crow(e, h);
                const float vv = bf2f(*(const bf16_t*)(lds + RN_V + rho * LROW + (jh * 32 + r) * 2));
                const float ra = acc[jh][e] + ba[jh], ri = acc[2 + jh][e] + bx[jh];
                const float rg = __builtin_amdgcn_rcpf(1.f + __expf(-ra));
                const float ig = __builtin_amdgcn_rcpf(1.f + __expf(-ri));
                const float la = -8.f * rg * sp[jh];
                const float x2 = 2.f * la;
                const float em = -x2 * (1.f + x2 * (0.5f + x2 * (0.16666667f + x2 * (0.041666668f + x2 * (0.0083333338f + x2 * 0.0013888889f)))));
                av[jh][e] = __expf(la);
                bv[jh][e] = __builtin_amdgcn_sqrtf(fmaxf(em, 0.f)) * ig * vv;
            }
        float s0A[2][4], s0B[2][4], PA_[2][4], PB_[2][4], WA[2], WB[2];
#pragma unroll
        for (int jh = 0; jh < 2; ++jh) {
#pragma unroll
            for (int q = 0; q < 4; ++q) {
                const float A = av[jh][4 * q] * av[jh][4 * q + 1] * av[jh][4 * q + 2] * av[jh][4 * q + 3];
                float x = bv[jh][4 * q];
                x = av[jh][4 * q + 1] * x + bv[jh][4 * q + 1];
                x = av[jh][4 * q + 2] * x + bv[jh][4 * q + 2];
                x = av[jh][4 * q + 3] * x + bv[jh][4 * q + 3];
                const float oA = shx(A, 32, lane), oB = shx(x, 32, lane);
                s0A[jh][q] = h ? oA : A;
                s0B[jh][q] = h ? oB : x;
                const float s1A = h ? A : oA, s1B = h ? x : oB;
                PA_[jh][q] = s1A * s0A[jh][q];
                PB_[jh][q] = s1A * s0B[jh][q] + s1B;
            }
            WA[jh] = PA_[jh][0] * PA_[jh][1] * PA_[jh][2] * PA_[jh][3];
            float x = PB_[jh][0];
            x = PA_[jh][1] * x + PB_[jh][1];
            x = PA_[jh][2] * x + PB_[jh][2];
            x = PA_[jh][3] * x + PB_[jh][3];
            WB[jh] = x;
            if (h == 0) {
                AGG[(w * 64 + jh * 32 + r) * 2] = WA[jh];
                AGG[(w * 64 + jh * 32 + r) * 2 + 1] = WB[jh];
            }
        }
        __syncthreads();
        float cout_[2];
        char* hvp = lds + RN_V + (32 * w + 4 * h) * LROW + r * 2;
#pragma unroll
        for (int jh = 0; jh < 2; ++jh) {
            const int j = jh * 32 + r;
            float cin = CARRY[j];
            for (int w2 = 0; w2 < w; ++w2) cin = AGG[(w2 * 64 + j) * 2] * cin + AGG[(w2 * 64 + j) * 2 + 1];
            cout_[jh] = WA[jh] * cin + WB[jh];
            float C = cin;
#pragma unroll
            for (int q = 0; q < 4; ++q) {
                const float c1 = s0A[jh][q] * C + s0B[jh][q];
                float x = h ? c1 : C;
#pragma unroll
                for (int e4 = 0; e4 < 4; ++e4) {
                    x = av[jh][4 * q + e4] * x + bv[jh][4 * q + e4];
                    if (!isctx) *(bf16_t*)(hvp + (e4 + 8 * q) * LROW + jh * 64) = f2bf(x);
                }
                C = PA_[jh][q] * C + PB_[jh][q];
            }
        }
        __syncthreads();
        if (w == 7 && h == 0) {
            CARRY[r] = cout_[0];
            CARRY[32 + r] = cout_[1];
        }
        if (!isctx) {
            const int rho = tid >> 1, hf2 = tid & 1;
            const int t = dir ? (tbase + 255 - rho) : (tbase + rho);
            const uint4* sp = (const uint4*)(lds + RN_V + rho * LROW + hf2 * 64);
            uint4* gp = (uint4*)(HS + (size_t)(b * S_ + t) * 512 + hd * 64 + hf2 * 32);
            const uint4 v0 = sp[0], v1 = sp[1], v2 = sp[2], v3 = sp[3];
            gp[0] = v0; gp[1] = v1; gp[2] = v2; gp[3] = v3;
            __syncthreads();
        }
    }
}

#define P2_RNN 128
#define P2_HY 512
DI void phase2(const Params& P, char* lds, int tid, volatile unsigned* misc, int pass) {
    unsigned* qctr = (unsigned*)(P.ws + OFF_CTL) + QUEUE_WORD + pass;
    for (;;) {
        __syncthreads();
        if (tid == 0) misc[8] = atomicAdd(qctr, 1u);
        __syncthreads();
        const int it = __builtin_amdgcn_readfirstlane((int)misc[8]);
        if (it >= P2_RNN + P2_HY) break;
        int tq = tid;
        asm volatile("" : "+v"(tq));
#ifdef PROBE_P2
        if (pass == 1 && ((PROBE_P2 == 1) != (it < P2_RNN))) continue;
#endif
        if (it < P2_RNN) rnn_item(P, it, lds, tq);
        else hyena_item(P, it - P2_RNN, lds, tq);
    }
}

#define P3_A 0
#define P3_AROW 2064
#define P3_LG 132096
#define P3_SC 148480
#define P3_RED 149760
#define CNT_WORD 4160

DI float gelu_tanh(float x) {
    const float u = 0.7978845608028654f * (x + 0.044715f * x * x * x);
    const float t = 1.f - 2.f * __builtin_amdgcn_rcpf(1.f + __expf(2.f * u));
    return 0.5f * x * (1.f + t);
}
DI float bflo(unsigned v) { return __uint_as_float(v << 16); }
DI float bfhi(unsigned v) { return __uint_as_float(v & 0xffff0000u); }

DI void p2b_item(const Params& P, int it, char* lds, int tid) {
    const int tok0 = it * 64;
    const bf16_t* PA = (const bf16_t*)(P.ws + OFF_PA);
    const bf16_t* HF = (const bf16_t*)(P.ws + OFF_HS);
    const bf16_t* HB = HF + (size_t)NL_ * 512;
    const bf16_t* YBT = (const bf16_t*)(P.ws + OFF_YBT);
    bf16_t* YN = (bf16_t*)(P.ws + OFF_YN);
    float* sc = (float*)(lds + P3_SC);
    float* red = (float*)(lds + P3_RED);
    const int lane = tid & 63, w = __builtin_amdgcn_readfirstlane(tid >> 6);
    __syncthreads();
#pragma unroll 2
    for (int i = 0; i < 8; ++i) {
        const int tok = w + 8 * i, c8 = lane;
        const size_t g = (size_t)(tok0 + tok) * 512 + c8 * 8;
        const uint4 pa = *(const uint4*)(PA + g), hf = *(const uint4*)(HF + g), hb = *(const uint4*)(HB + g);
        const unsigned pw[4] = {pa.x, pa.y, pa.z, pa.w}, fw[4] = {hf.x, hf.y, hf.z, hf.w}, bw[4] = {hb.x, hb.y, hb.z, hb.w};
        unsigned ow[4];
        float ss = 0.f;
#pragma unroll
        for (int k = 0; k < 4; ++k) {
            const float y0 = gelu_tanh(bflo(pw[k])) * (bflo(fw[k]) + bflo(bw[k]));
            const float y1 = gelu_tanh(bfhi(pw[k])) * (bfhi(fw[k]) + bfhi(bw[k]));
            ss += y0 * y0 + y1 * y1;
            ow[k] = pack2(y0, y1);
        }
        *(uint4*)(lds + P3_A + tok * P3_AROW + c8 * 16) = make_uint4(ow[0], ow[1], ow[2], ow[3]);
#pragma unroll
        for (int o = 32; o > 0; o >>= 1) ss += shx(ss, o, lane);
        if (lane == 0) sc[tok] = ss;
    }
    {
        float sb[8];
#pragma unroll
        for (int e = 0; e < 8; ++e) sb[e] = 0.f;
        const int j = tid & 7;
#pragma unroll 2
        for (int pass = 0; pass < 8; ++pass) {
            const int c = pass * 64 + (tid >> 3);
            const uint4 v = *(const uint4*)(YBT + (size_t)c * NL_ + tok0 + 8 * j);
            const unsigned vw[4] = {v.x, v.y, v.z, v.w};
#pragma unroll
            for (int k = 0; k < 4; ++k) {
                const float f0 = bflo(vw[k]), f1 = bfhi(vw[k]);
                sb[2 * k] += f0 * f0;
                sb[2 * k + 1] += f1 * f1;
                *(bf16_t*)(lds + P3_A + (8 * j + 2 * k) * P3_AROW + (512 + c) * 2) = (bf16_t)(vw[k] & 0xffffu);
                *(bf16_t*)(lds + P3_A + (8 * j + 2 * k + 1) * P3_AROW + (512 + c) * 2) = (bf16_t)(vw[k] >> 16);
            }
        }
#pragma unroll
        for (int e = 0; e < 8; ++e) {
            float v = sb[e];
            v += shx(v, 8, lane); v += shx(v, 16, lane); v += shx(v, 32, lane);
            if (lane < 8) red[w * 64 + 8 * j + e] = v;
        }
    }
    __syncthreads();
    if (tid < 64) {
        float ssb = 0.f;
#pragma unroll
        for (int ww = 0; ww < 8; ++ww) ssb += red[ww * 64 + tid];
        sc[128 + tid] = rsqrtf(sc[tid] * (1.f / 512.f) + 1e-6f);
        sc[192 + tid] = rsqrtf(ssb * (1.f / 512.f) + 1e-6f);
    }
    __syncthreads();
#pragma unroll 4
    for (int i = 0; i < 16; ++i) {
        const int q = tid + NTHR * i, row = q >> 7, c16 = q & 127;
        const uint4 v = *(const uint4*)(lds + P3_A + row * P3_AROW + c16 * 16);
        const float scl = sc[(c16 < 64 ? 128 : 192) + row];
        uint4 o;
        o.x = pack2(bflo(v.x) * scl, bfhi(v.x) * scl);
        o.y = pack2(bflo(v.y) * scl, bfhi(v.y) * scl);
        o.z = pack2(bflo(v.z) * scl, bfhi(v.z) * scl);
        o.w = pack2(bflo(v.w) * scl, bfhi(v.w) * scl);
        *(uint4*)(YN + (size_t)(tok0 + row) * 1024 + c16 * 8) = o;
    }
}
DI void phase2b(const Params& P, char* lds, int tid) {
    for (int it = blockIdx.x; it < NL_ / 64; it += gridDim.x) p2b_item(P, it, lds, tid);
}

struct P3Sched {
    const char* yn; const char* wt; bf16_t* y; int x, j, nj;
    DI bool next(int i, pg8::GUnit& u) const {
        const int k = j + i * nj;
        if (k >= 32) return false;
        const int pm = (k >> 2) * 8 + x, pn = k & 3;
        u.A = yn + (size_t)pm * 256 * 2048;
        u.B = wt + (size_t)pn * 256 * 2048;
        u.B1 = u.B + (size_t)128 * 2048;
        u.O = y + (size_t)pm * 256 * 1024 + pn * 256;
        u.ldc = 1024; u.valid = 256; u.aux = 0;
        return true;
    }
};
DI void phase3(const Params& P, char* lds, int tid) {
    char* ws = P.ws;
    P3Sched S{ws + OFF_YN, ws + OFF_WOUT_T, (bf16_t*)(ws + OFF_Y), (int)(blockIdx.x & 7), (int)(blockIdx.x >> 3), (int)(gridDim.x >> 3)};
    pg8::EpiStore E;
    pg8::gemm_phase<false>(lds, 1024, S, E, tid);
}

DI void p3b_item(const Params& P, int it, char* lds, int tid, int pass) {
    const int tok0 = it * 64, b = tok0 >> 11;
    const bf16_t* WRT = (const bf16_t*)(P.ws + OFF_WR_T);
    bf16_t* H2 = (bf16_t*)(P.ws + OFF_H2);
    const float* mod = (const float*)(P.ws + OFF_MOD) + b * 6144;
    float* LG = (float*)(lds + P3_LG);
    const int lane = tid & 63, w = __builtin_amdgcn_readfirstlane(tid >> 6), r = lane & 31, h = lane >> 5;
    __syncthreads();
    const bf16_t* Y = (const bf16_t*)(P.ws + OFF_Y);
    const float* pe = (const float*)(P.ws + OFF_PE);
#pragma unroll 1
    for (int rb = 0; rb < 8; rb += 4) {
        float4 xv[4][4];
#pragma unroll
        for (int q = 0; q < 4; ++q) {
            const int tok = tok0 + w * 8 + rb + q, t = tok & 2047;
#pragma unroll
            for (int i2 = 0; i2 < 2; ++i2) {
                const int d = i2 * 512 + lane * 8;
                const float4 xa = *(const float4*)(P.in[0] + (size_t)tok * 1024 + d), xb = *(const float4*)(P.in[0] + (size_t)tok * 1024 + d + 4);
                const uint4 yv = *(const uint4*)(Y + (size_t)tok * 1024 + d);
                const float* pp = i2 ? pe + (t & 63) * 512 + lane * 8 : pe + (t >> 6) * 512 + lane * 8;
                const float4 pa = *(const float4*)pp, pb = *(const float4*)(pp + 4);
                const float4 ga = *(const float4*)(mod + 2048 + d), gb = *(const float4*)(mod + 2048 + d + 4);
                float4 oa, ob;
                oa.x = xa.x + pa.x + ga.x * bflo(yv.x); oa.y = xa.y + pa.y + ga.y * bfhi(yv.x);
                oa.z = xa.z + pa.z + ga.z * bflo(yv.y); oa.w = xa.w + pa.w + ga.w * bfhi(yv.y);
                ob.x = xb.x + pb.x + gb.x * bflo(yv.z); ob.y = xb.y + pb.y + gb.y * bfhi(yv.z);
                ob.z = xb.z + pb.z + gb.z * bflo(yv.w); ob.w = xb.w + pb.w + gb.w * bfhi(yv.w);
                *(float4*)(P.out + (size_t)tok * 1024 + d) = oa;
                *(float4*)(P.out + (size_t)tok * 1024 + d + 4) = ob;
                xv[q][2 * i2] = oa;
                xv[q][2 * i2 + 1] = ob;
            }
        }
        float ss[4];
#pragma unroll
        for (int q = 0; q < 4; ++q) {
            ss[q] = 0.f;
#pragma unroll
            for (int i = 0; i < 4; ++i) ss[q] += xv[q][i].x * xv[q][i].x + xv[q][i].y * xv[q][i].y + xv[q][i].z * xv[q][i].z + xv[q][i].w * xv[q][i].w;
        }
#pragma unroll
        for (int o = 32; o > 0; o >>= 1)
#pragma unroll
            for (int q = 0; q < 4; ++q) ss[q] += shx(ss[q], o, lane);
#pragma unroll
        for (int i2 = 0; i2 < 2; ++i2) {
            const int d = i2 * 512 + lane * 8;
            float gm[8], shf[8];
#pragma unroll
            for (int hh = 0; hh < 2; ++hh) {
                const float4 gn = *(const float4*)(P.in[28] + d + 4 * hh), s2v = *(const float4*)(mod + 4096 + d + 4 * hh), shv = *(const float4*)(mod + 3072 + d + 4 * hh);
                gm[4 * hh + 0] = gn.x * (1.f + s2v.x); gm[4 * hh + 1] = gn.y * (1.f + s2v.y); gm[4 * hh + 2] = gn.z * (1.f + s2v.z); gm[4 * hh + 3] = gn.w * (1.f + s2v.w);
                shf[4 * hh + 0] = shv.x; shf[4 * hh + 1] = shv.y; shf[4 * hh + 2] = shv.z; shf[4 * hh + 3] = shv.w;
            }
#pragma unroll
            for (int q = 0; q < 4; ++q) {
                const int row = w * 8 + rb + q;
                const float rs = rsqrtf(ss[q] * (1.f / 1024.f) + 1e-6f);
                const float4 a = xv[q][2 * i2], bq = xv[q][2 * i2 + 1];
                uint4 pk;
                pk.x = pack2(a.x * rs * gm[0] + shf[0], a.y * rs * gm[1] + shf[1]);
                pk.y = pack2(a.z * rs * gm[2] + shf[2], a.w * rs * gm[3] + shf[3]);
                pk.z = pack2(bq.x * rs * gm[4] + shf[4], bq.y * rs * gm[5] + shf[5]);
                pk.w = pack2(bq.z * rs * gm[6] + shf[6], bq.w * rs * gm[7] + shf[7]);
                *(uint4*)(H2 + (size_t)(tok0 + row) * 1024 + d) = pk;
                *(uint4*)(lds + P3_A + row * P3_AROW + d * 2) = pk;
            }
        }
    }
    __syncthreads();
    if (w < 4) {
        const int mi = w >> 1, ni = w & 1;
        f32x16 lg;
#pragma unroll
        for (int e = 0; e < 16; ++e) lg[e] = 0.f;
        const bf16_t* wr = WRT + (size_t)(32 * ni + r) * 1024 + 8 * h;
        const char* ar = lds + P3_A + (32 * mi + r) * P3_AROW + 16 * h;
#pragma unroll 8
        for (int ks = 0; ks < 64; ++ks) {
            const bf16x8 fa = *(const bf16x8*)(ar + ks * 32);
            const bf16x8 fbb = *(const bf16x8*)(wr + ks * 16);
            lg = MFMA32(fa, fbb, lg);
        }
        const int nn = 32 * ni + r;
        const float bias = (nn < 4) ? P.in[30][nn] : ((nn < 36) ? P.in[32][nn - 4] : 0.f);
#pragma unroll
        for (int e = 0; e < 16; ++e) LG[(32 * mi + crow(e, h)) * 64 + nn] = lg[e] + bias;
    }
    __syncthreads();
    int* lcnt = (int*)(lds + P3_RED);
    int* lbase = lcnt + 32;
    if (tid < 32) lcnt[tid] = 0;
    __syncthreads();
    int ex0 = 0, ex1 = 0, r0 = 0, r1 = 0;
    float w0 = 0.f, w1 = 0.f;
    if (tid < 64 && pass == 0) {
        const float* l = LG + tid * 64;
        int gi = 0;
        float gmx = l[0];
        for (int j = 1; j < 4; ++j) if (l[j] > gmx) { gmx = l[j]; gi = j; }
        float gs = 0.f;
        for (int j = 0; j < 4; ++j) gs += __expf(l[j] - gmx);
        const float gp = 1.f / gs;
        const float* el = l + 4 + gi * 8;
        int e0 = 0;
        float m0 = el[0];
        for (int j = 1; j < 8; ++j) if (el[j] > m0) { m0 = el[j]; e0 = j; }
        int e1 = 0;
        float m1 = -1e30f;
        for (int j = 0; j < 8; ++j) if (j != e0 && el[j] > m1) { m1 = el[j]; e1 = j; }
        const float p1 = __expf(m1 - m0);
        w0 = gp / (1.f + p1);
        w1 = gp * p1 / (1.f + p1);
        ex0 = gi * 8 + e0;
        ex1 = gi * 8 + e1;
        r0 = atomicAdd(&lcnt[ex0], 1);
        r1 = atomicAdd(&lcnt[ex1], 1);
    }
    __syncthreads();
    if (tid < 32 && pass == 0) {
        const int c = lcnt[tid];
        unsigned* cnt = (unsigned*)(P.ws + OFF_CTL) + CNT_WORD;
        lbase[tid] = (c > 0) ? (int)atomicAdd(&cnt[tid * 64], (unsigned)c) : 0;
    }
    __syncthreads();
    if (tid < 64 && pass == 0) {
        const int tok = tok0 + tid;
        unsigned* LIST = (unsigned*)(P.ws + OFF_LIST);
        unsigned* TS = (unsigned*)(P.ws + OFF_TOKSLOT);
        float* EW = (float*)(P.ws + OFF_EW);
        const unsigned p0 = (unsigned)(lbase[ex0] + r0), p1i = (unsigned)(lbase[ex1] + r1);
        LIST[ex0 * 16384 + p0] = tok * 2;
        TS[tok * 2] = ((unsigned)ex0 << 16) | p0;
        EW[tok * 2] = w0;
        LIST[ex1 * 16384 + p1i] = tok * 2 + 1;
        TS[tok * 2 + 1] = ((unsigned)ex1 << 16) | p1i;
        EW[tok * 2 + 1] = w1;
    }
}
DI void phase3b(const Params& P, char* lds, int tid, int pass) {
    for (int it = blockIdx.x; it < NL_ / 64; it += gridDim.x) p3b_item(P, it, lds, tid, pass);
}

#define MISC_TB 16
#define MISC_SB 56
#define MISC_CNT 96
DI void moe_tables(const Params& P, volatile unsigned* misc, int tid) {
    __syncthreads();
    if (tid == 0) {
        unsigned* cnt = (unsigned*)(P.ws + OFF_CTL) + CNT_WORD;
        unsigned t = 0, sb = 0;
        for (int e = 0; e < 32; ++e) {
            const unsigned c = __hip_atomic_load(&cnt[e * 64], __ATOMIC_RELAXED, __HIP_MEMORY_SCOPE_AGENT);
            misc[MISC_TB + e] = t;
            misc[MISC_SB + e] = sb;
            misc[MISC_CNT + e] = c;
            t += (c + 255u) >> 8;
            sb += c;
        }
        misc[MISC_TB + 32] = t;
    }
    __syncthreads();
}

struct MoeTile { int e, mt, ntile, valid, pos0; };
DI int moe_label_items(volatile unsigned* misc, int x) {
    int n = 0;
#pragma unroll
    for (int q = 0; q < 4; ++q) n += (int)((misc[MISC_CNT + x + 8 * q] + 255u) >> 8);
    return n * 8;
}
DI MoeTile moe_tile(volatile unsigned* misc, int x, int k) {
    MoeTile t;
    int mtg = k >> 3;
    t.ntile = k & 7;
    int e = x;
    bool more = true;
#pragma unroll
    for (int q = 0; q < 3; ++q) {
        const int tiles = (int)((misc[MISC_CNT + e] + 255u) >> 8);
        if (more && mtg >= tiles) { mtg -= tiles; e += 8; } else more = false;
    }
    t.e = e;
    t.mt = mtg;
    t.valid = min(256, (int)misc[MISC_CNT + e] - mtg * 256);
    t.pos0 = (int)misc[MISC_SB + e] + mtg * 256;
    return t;
}
struct EpiAct {
    DI void operator()(const pg8::f32x4r (&acc)[2][2][4][2], const pg8::GUnit& u, int wr, int wc, int fr, int fq, char* lds) const {
        asm volatile("" : "+v"(fr), "+v"(fq));
#pragma unroll
        for (int ai = 0; ai < 2; ++ai)
#pragma unroll
            for (int m = 0; m < 4; ++m) {
                const int r = ai * 128 + wr * 64 + m * 16 + fr;
                if (r < u.valid) {
                    float a[8];
#pragma unroll
                    for (int n = 0; n < 2; ++n)
#pragma unroll
                        for (int k = 0; k < 4; ++k) {
                            const float gt = acc[ai][0][m][n][k], up = acc[ai][1][m][n][k];
                            a[4 * n + k] = gt * __builtin_amdgcn_rcpf(1.f + __expf(-gt)) * up;
                        }
                    u32x4 w;
                    w.x = pg8::cvt_pk_bf16(a[0], a[1]); w.y = pg8::cvt_pk_bf16(a[2], a[3]); w.z = pg8::cvt_pk_bf16(a[4], a[5]); w.w = pg8::cvt_pk_bf16(a[6], a[7]);
                    *(u32x4*)(u.O + (size_t)r * u.ldc + wc * 32 + 8 * fq) = w;
                }
            }
    }
};
struct P4Sched {
    const char* h2; const char* wg; const char* wu; bf16_t* act; const unsigned* list; int x, j, nj, total;
    int c0, c1, c2, c3, b0, b1, b2, b3;
    int r0, cb0, r1, cb1;
    DI bool next(int i, pg8::GUnit& u) const {
        const int k = j + i * nj;
        if (k >= total) return false;
        int mtg = k >> 2;
        const int nu = k & 3;
        const int t0 = (c0 + 255) >> 8, t1 = (c1 + 255) >> 8, t2 = (c2 + 255) >> 8;
        int q = 0, c = c0, b = b0;
        if (mtg >= t0) {
            mtg -= t0; q = 1; c = c1; b = b1;
            if (mtg >= t1) {
                mtg -= t1; q = 2; c = c2; b = b2;
                if (mtg >= t2) { mtg -= t2; q = 3; c = c3; b = b3; }
            }
        }
        const int e = x + 8 * q, pos0 = b + mtg * 256;
        u.A = h2;
        u.B = wg + (size_t)(e * 512 + nu * 128) * 2048;
        u.B1 = wu + (size_t)(e * 512 + nu * 128) * 2048;
        u.O = act + (size_t)pos0 * 512 + nu * 128;
        u.ldc = 512;
        u.valid = min(256, c - mtg * 256);
        u.aux = pos0;
        const unsigned* lp = list + e * 16384 + mtg * 256;
        const int vm = u.valid - 1;
        u.ga[0][0] = h2 + (size_t)(lp[min(r0, vm)] >> 1) * 2048 + cb0;
        u.ga[0][1] = h2 + (size_t)(lp[min(r1, vm)] >> 1) * 2048 + cb1;
        u.ga[1][0] = h2 + (size_t)(lp[min(128 + r0, vm)] >> 1) * 2048 + cb0;
        u.ga[1][1] = h2 + (size_t)(lp[min(128 + r1, vm)] >> 1) * 2048 + cb1;
        return true;
    }
};
DI void phase4(const Params& P, char* lds, int tid, volatile unsigned* misc) {
    moe_tables(P, misc, tid);
    {
        const int p = blockIdx.x * 128 + tid;
        if (tid < 128 && p < 2 * NL_) {
            int e = 0;
            for (int q = 1; q < 32; ++q) e = ((int)misc[MISC_SB + q] <= p) ? q : e;
            const unsigned slot = ((const unsigned*)(P.ws + OFF_LIST))[e * 16384 + (p - (int)misc[MISC_SB + e])];
            ((float*)(P.ws + OFF_EWS))[p] = ((const float*)(P.ws + OFF_EW))[slot];
        }
    }
    char* ws = P.ws;
    const int x = (int)(blockIdx.x & 7);
    const int c0 = __builtin_amdgcn_readfirstlane((int)misc[MISC_CNT + x]), c1 = __builtin_amdgcn_readfirstlane((int)misc[MISC_CNT + x + 8]);
    const int c2 = __builtin_amdgcn_readfirstlane((int)misc[MISC_CNT + x + 16]), c3 = __builtin_amdgcn_readfirstlane((int)misc[MISC_CNT + x + 24]);
    const int b0 = __builtin_amdgcn_readfirstlane((int)misc[MISC_SB + x]), b1 = __builtin_amdgcn_readfirstlane((int)misc[MISC_SB + x + 8]);
    const int b2 = __builtin_amdgcn_readfirstlane((int)misc[MISC_SB + x + 16]), b3 = __builtin_amdgcn_readfirstlane((int)misc[MISC_SB + x + 24]);
    const int total = 4 * (((c0 + 255) >> 8) + ((c1 + 255) >> 8) + ((c2 + 255) >> 8) + ((c3 + 255) >> 8));
    int r0, cc0, r1, cc1;
    pg8::stage_piece(tid, 0, r0, cc0);
    pg8::stage_piece(tid, 1, r1, cc1);
    const P4Sched S{ws + OFF_H2, ws + OFF_WG_T, ws + OFF_WU_T, (bf16_t*)(ws + OFF_ACT), (const unsigned*)(ws + OFF_LIST), x, (int)(blockIdx.x >> 3), (int)(gridDim.x >> 3), total,
                    c0, c1, c2, c3, b0, b1, b2, b3, r0, cc0 * 2, r1, cc1 * 2};
    const EpiAct E;
    pg8::gemm_phase<true>(lds, 1024, S, E, tid);
}

struct EpiDown {
    const float* ews;
    DI void operator()(const pg8::f32x4r (&acc)[2][2][4][2], const pg8::GUnit& u, int wr, int wc, int fr, int fq, char* lds) const {
        asm volatile("" : "+v"(fr), "+v"(fq));
#pragma unroll
        for (int ai = 0; ai < 2; ++ai)
#pragma unroll
            for (int m = 0; m < 4; ++m) {
                const int r = ai * 128 + wr * 64 + m * 16 + fr;
                if (r < u.valid) {
                    const float wv = ews[u.aux + r];
                    bf16_t* rowp = u.O + (size_t)r * u.ldc + wc * 32 + 8 * fq;
#pragma unroll
                    for (int bj = 0; bj < 2; ++bj) {
                        const pg8::f32x4r v0 = acc[ai][bj][m][0] * wv, v1 = acc[ai][bj][m][1] * wv;
                        u32x4 w;
                        w.x = pg8::cvt_pk_bf16(v0[0], v0[1]); w.y = pg8::cvt_pk_bf16(v0[2], v0[3]); w.z = pg8::cvt_pk_bf16(v1[0], v1[1]); w.w = pg8::cvt_pk_bf16(v1[2], v1[3]);
                        *(u32x4*)(rowp + bj * 128) = w;
                    }
                }
                asm volatile("" ::: "memory");
            }
    }
};
struct P5Sched {
    const char* act; const char* wd; bf16_t* slot; int x, j, nj, total;
    int c0, c1, c2, c3, b0, b1, b2, b3;
    DI bool next(int i, pg8::GUnit& u) const {
        const int k = j + i * nj;
        if (k >= total) return false;
        int mtg = k >> 2;
        const int pn = k & 3;
        const int t0 = (c0 + 255) >> 8, t1 = (c1 + 255) >> 8, t2 = (c2 + 255) >> 8;
        int q = 0, c = c0, b = b0;
        if (mtg >= t0) {
            mtg -= t0; q = 1; c = c1; b = b1;
            if (mtg >= t1) {
                mtg -= t1; q = 2; c = c2; b = b2;
                if (mtg >= t2) { mtg -= t2; q = 3; c = c3; b = b3; }
            }
        }
        const int e = x + 8 * q, pos0 = b + mtg * 256;
        u.A = act + (size_t)pos0 * 1024;
        u.B = wd + (size_t)(e * 1024 + pn * 256) * 1024;
        u.B1 = u.B + (size_t)128 * 1024;
        u.O = slot + (size_t)pos0 * 1024 + pn * 256;
        u.ldc = 1024;
        u.valid = min(256, c - mtg * 256);
        u.aux = pos0;
        return true;
    }
};
DI void phase5(const Params& P, char* lds, int tid, volatile unsigned* misc) {
    char* ws = P.ws;
    const int x = (int)(blockIdx.x & 7);
    const int c0 = __builtin_amdgcn_readfirstlane((int)misc[MISC_CNT + x]), c1 = __builtin_amdgcn_readfirstlane((int)misc[MISC_CNT + x + 8]);
    const int c2 = __builtin_amdgcn_readfirstlane((int)misc[MISC_CNT + x + 16]), c3 = __builtin_amdgcn_readfirstlane((int)misc[MISC_CNT + x + 24]);
    const int b0 = __builtin_amdgcn_readfirstlane((int)misc[MISC_SB + x]), b1 = __builtin_amdgcn_readfirstlane((int)misc[MISC_SB + x + 8]);
    const int b2 = __builtin_amdgcn_readfirstlane((int)misc[MISC_SB + x + 16]), b3 = __builtin_amdgcn_readfirstlane((int)misc[MISC_SB + x + 24]);
    const int total = 4 * (((c0 + 255) >> 8) + ((c1 + 255) >> 8) + ((c2 + 255) >> 8) + ((c3 + 255) >> 8));
    const P5Sched S{ws + OFF_ACT, ws + OFF_WD_T, (bf16_t*)(ws + OFF_SLOT), x, (int)(blockIdx.x >> 3), (int)(gridDim.x >> 3), total, c0, c1, c2, c3, b0, b1, b2, b3};
    const EpiDown E{(const float*)(ws + OFF_EWS)};
    pg8::gemm_phase<false>(lds, 512, S, E, tid);
}

DI void phase6(const Params& P, int tid, volatile unsigned* misc, bool dummy) {
    const bf16_t* SLOT = (const bf16_t*)(P.ws + OFF_SLOT);
    const unsigned* TS = (const unsigned*)(P.ws + OFF_TOKSLOT);
    const float* modb = (const float*)(P.ws + OFF_MOD);
    const int lane = tid & 63, w = tid >> 6;
    for (int it = blockIdx.x; it < NL_ / 8; it += gridDim.x) {
        const int tok = it * 8 + w;
        const float* g2 = modb + (tok >> 11) * 6144 + 5120;
        const unsigned t0 = TS[tok * 2], t1 = TS[tok * 2 + 1];
        const bf16_t* s0 = SLOT + (size_t)(misc[MISC_SB + (t0 >> 16)] + (t0 & 0xffffu)) * 1024;
        const bf16_t* s1 = SLOT + (size_t)(misc[MISC_SB + (t1 >> 16)] + (t1 & 0xffffu)) * 1024;
        float* xo = P.out + (size_t)tok * 1024;
        float* xw = dummy ? (float*)(P.ws + OFF_H1) + (size_t)tok * 1024 : xo;
        float v[16];
        float ss = 0.f;
#pragma unroll
        for (int i = 0; i < 4; ++i) {
            const int d = i * 256 + lane * 4;
            const float4 xv = *(const float4*)(xo + d);
            const float4 gv = *(const float4*)(g2 + d);
            const uint2 a = *(const uint2*)(s0 + d), bq = *(const uint2*)(s1 + d);
            v[i * 4 + 0] = xv.x + gv.x * (bflo(a.x) + bflo(bq.x));
            v[i * 4 + 1] = xv.y + gv.y * (bfhi(a.x) + bfhi(bq.x));
            v[i * 4 + 2] = xv.z + gv.z * (bflo(a.y) + bflo(bq.y));
            v[i * 4 + 3] = xv.w + gv.w * (bfhi(a.y) + bfhi(bq.y));
            ss += v[i * 4] * v[i * 4] + v[i * 4 + 1] * v[i * 4 + 1] + v[i * 4 + 2] * v[i * 4 + 2] + v[i * 4 + 3] * v[i * 4 + 3];
        }
#pragma unroll
        for (int o = 32; o > 0; o >>= 1) ss += shx(ss, o, lane);
        const float rstd = rsqrtf(ss * (1.f / 1024.f) + 1e-6f);
#pragma unroll
        for (int i = 0; i < 4; ++i) {
            const int d = i * 256 + lane * 4;
            const float4 fg = *(const float4*)(P.in[36] + d);
            float4 o;
            o.x = v[i * 4 + 0] * rstd * fg.x; o.y = v[i * 4 + 1] * rstd * fg.y;
            o.z = v[i * 4 + 2] * rstd * fg.z; o.w = v[i * 4 + 3] * rstd * fg.w;
            *(float4*)(xw + d) = o;
        }
    }
}

#define NPHASE 10
DI void run_phase(const Params& P, int ph, int pass, int npass, char* lds, int tq, volatile unsigned* misc) {
    if (ph == 0) phase0a(P, lds, tq);
    else if (ph == 1) phase0b(P, lds, tq);
    else if (ph == 2) phase1(P, lds, tq);
    else if (ph == 3) phase2(P, lds, tq, misc, pass);
    else if (ph == 4) phase2b(P, lds, tq);
    else if (ph == 5) phase3(P, lds, tq);
    else if (ph == 6) phase3b(P, lds, tq, pass);
    else if (ph == 7) phase4(P, lds, tq, misc);
    else if (ph == 8) phase5(P, lds, tq, misc);
    else if (ph == 9) phase6(P, tq, misc, pass + 1 < npass);
}
__global__ void __launch_bounds__(NTHR, 2) mk_fwd(Params P, int ph_lo, int ph_hi, int rep_mask) {
    extern __shared__ __attribute__((aligned(16))) char lds[];
    const int tid = threadIdx.x;
    volatile unsigned* misc = (volatile unsigned*)(lds + LDS_MISC);
    if (tid < 256) misc[tid] = 0u;
    __syncthreads();
    XcdBarrier bar = xcd_barrier_post((unsigned*)(P.ws + OFF_CTL), misc);
#ifdef PROBE_PH
    unsigned long long pt0 = 0ull, pdt = 0ull;
#define MK_PROBE_BEGIN(k) if ((k) == PROBE_PH) pt0 = __builtin_amdgcn_s_memrealtime();
#define MK_PROBE_END(k) if ((k) == PROBE_PH) pdt = __builtin_amdgcn_s_memrealtime() - pt0;
#define MK_BAR_ALWAYS 1
#else
#define MK_PROBE_BEGIN(k)
#define MK_PROBE_END(k)
#define MK_BAR_ALWAYS 0
#endif
#define MK_PHASE(k)                                                                                           \
    if (ph_lo <= (k) && (k) < ph_hi) {                                                                        \
        const int npass = ((rep_mask >> (k)) & 1) ? 2 : 1;     \
        MK_PROBE_BEGIN(k)                                                                                     \
        for (int pass = 0; pass < npass; ++pass) {                                                            \
            int tq = tid;                                                                                     \
            asm volatile("" : "+v"(tq));                                                                      \
            run_phase(P, (k), pass, npass, lds, tq, misc);                                                    \
            if (MK_BAR_ALWAYS || pass + 1 < npass || (k) + 1 < ph_hi) xcd_barrier(bar);                        \
        }                                                                                                     \
        MK_PROBE_END(k)                                                                                       \
    }
    MK_PHASE(0) MK_PHASE(1) MK_PHASE(2) MK_PHASE(3) MK_PHASE(4) MK_PHASE(5) MK_PHASE(6) MK_PHASE(7) MK_PHASE(8) MK_PHASE(9)
#ifdef EXTRA_BARRIERS
    for (int q = 0; q < EXTRA_BARRIERS; ++q) xcd_barrier(bar);
#endif
#ifdef PROBE_PH
    if (blockIdx.x == 0) {
        const unsigned long long tend = __builtin_amdgcn_s_memrealtime() + 4ull * pdt;
        while (__builtin_amdgcn_s_memrealtime() < tend) __builtin_amdgcn_s_sleep(20);
    }
#endif
}

extern "C" void kernel_launch(void* const* d_in, const int* in_sizes, int n_in, void* d_out, int out_size, void* d_ws,
                              size_t ws_size, hipStream_t stream) {
    static int grid = 0;
    if (grid == 0) {
        int dev = 0, cus = 0, per_cu = 0;
        hipGetDevice(&dev);
        hipDeviceGetAttribute(&cus, hipDeviceAttributeMultiprocessorCount, dev);
        hipFuncSetAttribute((const void*)mk_fwd, hipFuncAttributeMaxDynamicSharedMemorySize, LDS_BYTES);
        hipOccupancyMaxActiveBlocksPerMultiprocessor(&per_cu, (const void*)mk_fwd, NTHR, LDS_BYTES);
        (void)hipGetLastError();
        grid = (per_cu >= 1 && ws_size >= WS_END && n_in == 37 && (cus % 8) == 0) ? cus : -1;
        if (grid < 0) fprintf(stderr, "kernel_launch: refusing to launch (per_cu %d, ws %zu, n_in %d)\n", per_cu, ws_size, n_in);
    }
    if (grid < 0) return;
    Params P{};
    for (int i = 0; i < 37; ++i) P.in[i] = (const float*)d_in[i];
    P.out = (float*)d_out;
    P.ws = (char*)d_ws;
    char* ws = (char*)d_ws;

    hipMemsetAsync(ws + OFF_CTL, 0, CTL_BYTES, stream);
    hipLaunchKernelGGL(mk_fwd, dim3(grid), dim3(NTHR), LDS_BYTES, stream, P, 0, NPHASE, REP_MASK);
}
```

```cpp
#include <hip/hip_runtime.h>
#include <math.h>
#include <stdint.h>
#include <stdio.h>

#define B_ 8
#define S_ 2048
#define D_ 1024
#define CT_ 256
#define NL_ (B_ * S_)
#define NC_ (B_ * CT_)
#define DIN_ 2560
#define NTHR 512
#ifndef REP_MASK
#define REP_MASK 0
#endif

typedef unsigned short bf16_t;
typedef __attribute__((ext_vector_type(8))) short bf16x8;
typedef __attribute__((ext_vector_type(16))) float f32x16;
typedef __attribute__((ext_vector_type(4))) float f32x4;
typedef __attribute__((ext_vector_type(4))) unsigned u32x4;
#define DI __device__ __forceinline__
#define MFMA32(a, b, c) __builtin_amdgcn_mfma_f32_32x32x16_bf16((a), (b), (c), 0, 0, 0)

DI bf16_t f2bf(float x) {
    unsigned u = __float_as_uint(x);
    u += 0x7fffu + ((u >> 16) & 1u);
    return (bf16_t)(u >> 16);
}
DI float bf2f(bf16_t v) { return __uint_as_float(((unsigned)v) << 16); }
DI unsigned pack2(float lo, float hi) { return (unsigned)f2bf(lo) | ((unsigned)f2bf(hi) << 16); }
DI float sigmoidf_(float x) { return 1.f / (1.f + expf(-x)); }
DI float shx(float v, int mask, int lane) { return __int_as_float(__builtin_amdgcn_ds_bpermute((lane ^ mask) << 2, __float_as_int(v))); }

#define OFF_CTL 0ull
#define CTL_BYTES 65536ull
#define OFF_MOD (OFF_CTL + CTL_BYTES)
#define OFF_PE (OFF_MOD + 262144ull)
#define OFF_HDN2 (OFF_PE + 131072ull)
#define OFF_NRM2 (OFF_HDN2 + 262144ull)
#define OFF_RALL (OFF_NRM2 + 8192ull)
#define OFF_WIN_T (OFF_RALL + 8404992ull)
#define OFF_WOUT_T (OFF_WIN_T + 5242880ull)
#define OFF_WRNN_T (OFF_WOUT_T + 2097152ull)
#define OFF_WR_T (OFF_WRNN_T + 262144ull)
#define OFF_WG_T (OFF_WR_T + 131072ull)
#define OFF_WU_T (OFF_WG_T + 33554432ull)
#define OFF_WD_T (OFF_WU_T + 33554432ull)
#define OFF_PHT (OFF_WD_T + 33554432ull)
#define OFF_PA (OFF_PHT + 50331648ull)
#define OFF_PU (OFF_PA + 16777216ull)
#define OFF_H1 (OFF_PU + 18874368ull)
#define OFF_HS (OFF_H1 + 37748736ull)
#define OFF_YBT (OFF_HS + 33554432ull)
#define OFF_H2 OFF_H1
#define OFF_YN (OFF_H1 + 0ull)
#define OFF_ACT OFF_HS
#define OFF_Y OFF_HS
#define OFF_SLOT OFF_PHT
#define OFF_LIST (OFF_YBT + 16777216ull)
#define OFF_TOKSLOT (OFF_LIST + 2097152ull)
#define OFF_EW (OFF_TOKSLOT + 131072ull)
#define OFF_EWS (OFF_EW + 131072ull)
#define WS_END (OFF_EWS + 131072ull)
#define QUEUE_WORD 4096

struct Params {
    const float* in[37];
    float* out;
    char* ws;
};

#define XB_TMO 128
#define XB_XCNT(j) (256 + 64 * (j))
#define XB_XSUB(j) (1280 + 64 * (j))
#define XB_XGEN(j) (2304 + 64 * (j))
#define XB_TOP 3328
#define XB_TOPGEN 3392
#define XCD_BAR_WORDS 3456
#define XB_SPIN_CAP (1u << 18)

DI unsigned xb_ld(unsigned* p) { return __hip_atomic_load(p, __ATOMIC_RELAXED, __HIP_MEMORY_SCOPE_AGENT); }
DI unsigned xb_add(unsigned* p, unsigned v) { return __hip_atomic_fetch_add(p, v, __ATOMIC_RELAXED, __HIP_MEMORY_SCOPE_AGENT); }
DI unsigned xb_xcc_id() { return (unsigned)__builtin_amdgcn_s_getreg((3 << 11) | 20) & 0xFu; }
#define XB_SPIN(cond, bar)                                                         \
    do {                                                                           \
        unsigned _sp = 0;                                                          \
        while (cond) {                                                             \
            __builtin_amdgcn_s_sleep(1);                                           \
            if ((++_sp & 255u) == 0u) {                                            \
                if (xb_ld(&(bar)[XB_TMO])) break;                                  \
                if (_sp > XB_SPIN_CAP) { atomicAdd(&(bar)[XB_TMO], 1u); break; }   \
            }                                                                      \
        }                                                                          \
    } while (0)

struct XcdBarrier {
    unsigned* bar;
    unsigned x;
    volatile unsigned* st;
};
DI XcdBarrier xcd_barrier_post(unsigned* bar, volatile unsigned* st) {
    XcdBarrier b;
    b.bar = bar;
    b.x = xb_xcc_id();
    b.st = st;
    if (threadIdx.x == 0) (void)xb_add(&bar[XB_XCNT(b.x)], 1u);
    return b;
}
DI void xcd_barrier_complete(unsigned* bar, unsigned x, unsigned& nloc, unsigned& nx) {
    const unsigned G = gridDim.x * gridDim.y * gridDim.z;
    unsigned sum, cnt, mine, sp = 0u;
    for (;;) {
        sum = 0u; cnt = 0u; mine = 0u;
#pragma unroll
        for (unsigned j = 0; j < 16; ++j) {
            const unsigned c = xb_ld(&bar[XB_XCNT(j)]);
            sum += c;
            cnt += (c > 0u) ? 1u : 0u;
            mine = (j == x) ? c : mine;
        }
        if (sum == G) break;
        __builtin_amdgcn_s_sleep(1);
        if ((++sp & 255u) == 0u) {
            if (xb_ld(&bar[XB_TMO])) break;
            if (sp > XB_SPIN_CAP) { atomicAdd(&bar[XB_TMO], 1u); break; }
        }
    }
    nloc = mine > 0u ? mine : 1u;
    nx = cnt > 0u ? cnt : 1u;
}
DI void xcd_barrier(const XcdBarrier& b) {
    asm volatile("s_waitcnt vmcnt(0)" ::: "memory");
    __syncthreads();
    if (threadIdx.x == 0) {
        unsigned* bar = b.bar;
        __builtin_amdgcn_s_waitcnt(0);
        unsigned nloc = b.st[0], nx = b.st[1];
        if (nloc == 0u) {
            xcd_barrier_complete(bar, b.x, nloc, nx);
            b.st[0] = nloc;
            b.st[1] = nx;
        }
        const unsigned old = xb_add(&bar[XB_XSUB(b.x)], 1u);
        const unsigned gen = old / nloc;
        if (old + 1u == (gen + 1u) * nloc) {
            __builtin_amdgcn_fence(__ATOMIC_RELEASE, "agent");
            asm volatile("s_waitcnt vmcnt(0)" ::: "memory");
            const unsigned og = xb_add(&bar[XB_TOP], 1u);
            const unsigned tg = og / nx;
            if (og + 1u == (tg + 1u) * nx) xb_add(&bar[XB_TOPGEN], 1u);
            else XB_SPIN(xb_ld(&bar[XB_TOPGEN]) == tg, bar);
            __builtin_amdgcn_fence(__ATOMIC_ACQUIRE, "agent");
            xb_add(&bar[XB_XGEN(b.x)], 1u);
            asm volatile("s_waitcnt vmcnt(0)" ::: "memory");
        } else {
            XB_SPIN(xb_ld(&bar[XB_XGEN(b.x)]) == gen, bar);
            __builtin_amdgcn_fence(__ATOMIC_ACQUIRE, "agent");
            asm volatile("s_waitcnt vmcnt(0)" ::: "memory");
        }
    }
    __syncthreads();
}

#define LDS_BYTES 163840
#define LDS_MISC (LDS_BYTES - 1024)
#define LROW 144
#define A_STAGE (256 * LROW)
#define B_STAGE (128 * LROW)
#define STAGE_BYTES (A_STAGE + B_STAGE)

DI void conv_tile(const float* src, int ld_src, bf16_t* dst, int ld_dst, const float* rowscale, float* l, int tid) {
    __syncthreads();
    {
        int r = tid >> 3, c0 = (tid & 7) * 8;
        const float4* s = (const float4*)(src + (size_t)r * ld_src + c0);
        float4 v0 = s[0], v1 = s[1];
        float sc = rowscale ? rowscale[r] : 1.f;
        float* d = l + r * 65 + c0;
        d[0] = v0.x * sc; d[1] = v0.y * sc; d[2] = v0.z * sc; d[3] = v0.w * sc;
        d[4] = v1.x * sc; d[5] = v1.y * sc; d[6] = v1.z * sc; d[7] = v1.w * sc;
    }
    __syncthreads();
    {
        int n = tid >> 3, k0 = (tid & 7) * 8;
        uint4 o;
        o.x = pack2(l[(k0 + 0) * 65 + n], l[(k0 + 1) * 65 + n]);
        o.y = pack2(l[(k0 + 2) * 65 + n], l[(k0 + 3) * 65 + n]);
        o.z = pack2(l[(k0 + 4) * 65 + n], l[(k0 + 5) * 65 + n]);
        o.w = pack2(l[(k0 + 6) * 65 + n], l[(k0 + 7) * 65 + n]);
        *(uint4*)(dst + (size_t)n * ld_dst + k0) = o;
    }
}

#define NCONV_RNN 32
DI void conv_item(const Params& P, int it, char* lds, int tid) {
    float* l = (float*)lds;
    const int hh = it & 7, gate = (it >> 3) & 1, dir = it >> 4;
    const float* src = (gate ? P.in[12] : P.in[10]) + (size_t)(dir * 8 + hh) * 4096;
    conv_tile(src, 64, (bf16_t*)(P.ws + OFF_WRNN_T) + (size_t)(hh * 256 + (dir * 2 + gate) * 64) * 64, 64, nullptr, l, tid);
}

#define NG_WIN 160
#define NG_WOUT 64
#define NG_EXP 1024
#define NG_TOTAL (NG_WIN + NG_WOUT + 3 * NG_EXP)
#define CV_LD 257
struct ConvDesc { const float* src; bf16_t* dst; const float* rs; int ld_src, ld_dst; };
DI ConvDesc conv_desc(const Params& P, int g) {
    ConvDesc d;
    d.rs = nullptr;
    if (g < NG_WIN) {
        const int kt = g / 10, ng = g % 10;
        d.src = P.in[7] + (size_t)kt * 64 * DIN_ + ng * 256; d.ld_src = DIN_;
        d.dst = (bf16_t*)(P.ws + OFF_WIN_T) + (size_t)ng * 256 * 1024 + kt * 64; d.ld_dst = 1024;
    } else if (g < NG_WIN + NG_WOUT) {
        g -= NG_WIN;
        const int kt = g >> 2, ng = g & 3;
        d.src = P.in[27] + (size_t)kt * 64 * 1024 + ng * 256; d.ld_src = 1024;
        d.dst = (bf16_t*)(P.ws + OFF_WOUT_T) + (size_t)ng * 256 * 1024 + kt * 64; d.ld_dst = 1024;
        d.rs = (kt < 8) ? P.in[25] + kt * 64 : P.in[26] + (kt - 8) * 64;
    } else {
        g -= NG_WIN + NG_WOUT;
        const int which = g >> 10, rem0 = g & 1023, e = rem0 >> 5, rem = rem0 & 31;
        if (which < 2) {
            const int kt = rem >> 1, ng = rem & 1;
            d.src = P.in[33 + which] + (size_t)e * 1024 * 512 + (size_t)kt * 64 * 512 + ng * 256; d.ld_src = 512;
            d.dst = (bf16_t*)(P.ws + (which ? OFF_WU_T : OFF_WG_T)) + (size_t)(e * 512 + ng * 256) * 1024 + kt * 64; d.ld_dst = 1024;
        } else {
            const int kt = rem >> 2, ng = rem & 3;
            d.src = P.in[35] + (size_t)e * 512 * 1024 + (size_t)kt * 64 * 1024 + ng * 256; d.ld_src = 1024;
            d.dst = (bf16_t*)(P.ws + OFF_WD_T) + (size_t)(e * 1024 + ng * 256) * 512 + kt * 64; d.ld_dst = 512;
        }
    }
    return d;
}
DI void conv_load(const ConvDesc& d, float4 (&r)[8], int tid) {
#pragma unroll
    for (int i = 0; i < 8; ++i) {
        const int q = tid + NTHR * i;
        r[i] = *(const float4*)(d.src + (size_t)(q >> 6) * d.ld_src + (q & 63) * 4);
    }
}
DI void conv_groups(const Params& P, int g0, int g1, int stride, char* lds, int tid) {
    float* l = (float*)lds;
    float4 r[8];
    int g = g0;
    ConvDesc d;
    if (g < g1) { d = conv_desc(P, g); conv_load(d, r, tid); }
    while (g < g1) {
        __syncthreads();
#pragma unroll
        for (int i = 0; i < 8; ++i) {
            const int q = tid + NTHR * i, row = q >> 6, c = (q & 63) * 4;
            const float sc = d.rs ? d.rs[row] : 1.f;
            float* p = l + row * CV_LD + c;
            p[0] = r[i].x * sc; p[1] = r[i].y * sc; p[2] = r[i].z * sc; p[3] = r[i].w * sc;
        }
        const ConvDesc dc = d;
        const int gn = g + stride;
        if (gn < g1) { d = conv_desc(P, gn); conv_load(d, r, tid); }
        __syncthreads();
#pragma unroll
        for (int i = 0; i < 4; ++i) {
            const int q = tid + NTHR * i, n = q >> 3, k0 = (q & 7) * 8;
            const float* p = l + k0 * CV_LD + n;
            uint4 o;
            o.x = pack2(p[0], p[CV_LD]);
            o.y = pack2(p[2 * CV_LD], p[3 * CV_LD]);
            o.z = pack2(p[4 * CV_LD], p[5 * CV_LD]);
            o.w = pack2(p[6 * CV_LD], p[7 * CV_LD]);
            *(uint4*)(dc.dst + (size_t)n * dc.ld_dst + k0) = o;
        }
        g = gn;
    }
}

DI void mod_item(const Params& P, int it, char* lds, int tid) {
    float* sl = (float*)lds;
    float* red = sl + 9 * 1024;
    __syncthreads();
    for (int i = tid; i < 9 * 1024; i += NTHR) {
        int r = i >> 10, k = i & 1023;
        float v = (r < 8) ? P.in[1][r * 1024 + k] : P.in[3][k];
        sl[i] = v * __builtin_amdgcn_rcpf(1.f + __expf(-v));
    }
    __syncthreads();
    const int w = tid >> 6, lane = tid & 63, col = lane & 31, kp = lane >> 5;
    const int n0 = it * 32;
    const float* wa = P.in[4] + n0 + col;
    float acc[9];
#pragma unroll
    for (int r = 0; r < 9; ++r) acc[r] = 0.f;
#pragma unroll 1
    for (int i0 = 0; i0 < 64; i0 += 32) {
        float wv[32];
#pragma unroll
        for (int q = 0; q < 32; ++q) wv[q] = wa[(size_t)(w * 128 + 2 * (i0 + q) + kp) * 6144];
#pragma unroll
        for (int q = 0; q < 32; ++q) {
            const int k = w * 128 + 2 * (i0 + q) + kp;
#pragma unroll
            for (int r = 0; r < 9; ++r) acc[r] += sl[r * 1024 + k] * wv[q];
        }
    }
#pragma unroll
    for (int r = 0; r < 9; ++r) {
        acc[r] += shx(acc[r], 32, lane);
        if (kp == 0) red[(w * 9 + r) * 32 + col] = acc[r];
    }
    __syncthreads();
    if (tid < 9 * 32) {
        int r = tid >> 5, c = tid & 31;
        float s = P.in[5][n0 + c];
#pragma unroll
        for (int ww = 0; ww < 8; ++ww) s += red[(ww * 9 + r) * 32 + c];
        ((float*)(P.ws + OFF_MOD))[r * 6144 + n0 + c] = s;
    }
}

DI void pe_item(const Params& P, int it, int tid) {
    int p = it, i = tid & 255;
    float omega = 1.0f / powf(10000.0f, (float)i / 256.0f);
    float ang = (float)p * omega;
    ((float*)(P.ws + OFF_PE))[p * 512 + tid] = (tid < 256) ? sinf(ang) : cosf(ang);
}

DI void hdn_item(const Params& P, int it, char* lds, int tid) {
    const int w = tid >> 6, j = tid & 63;
    float* w1s = (float*)lds;
    float* w2s = w1s + 33 * 64;
    float* zz = w2s + 64 * 64 + w * 128;
    float* h1s = zz + 64;
    __syncthreads();
    for (int i = tid; i < 33 * 64; i += NTHR) w1s[i] = P.in[16][i];
    for (int i = tid; i < 64 * 64; i += NTHR) w2s[i] = P.in[19][i];
    const float b1 = P.in[17][j], f1 = P.in[18][j], b2 = P.in[20][j], f2 = P.in[21][j];
    __syncthreads();
    for (int q = 0; q < 8; ++q) {
        const int t = it * 64 + w * 8 + q;
        if (j < 33) {
            float val;
            if (j == 0) val = (float)t / 2047.f;
            else {
                int bi = (j - 1) & 15;
                float freq = 1e-4f + (float)bi * ((15.f - 1e-4f) / 15.f);
                float ang = (6.283185307179586f * (float)t / 2048.f) * freq;
                val = (j <= 16) ? cosf(ang) : -sinf(ang);
            }
            zz[j] = val;
        }
        float acc = b1;
#pragma unroll 11
        for (int i = 0; i < 33; ++i) acc += zz[i] * w1s[i * 64 + j];
        h1s[j] = sinf(f1 * acc);
        acc = b2;
#pragma unroll 16
        for (int i = 0; i < 64; ++i) acc += h1s[i] * w2s[i * 64 + j];
        ((bf16_t*)(P.ws + OFF_HDN2))[t * 64 + j] = f2bf(sinf(f2 * acc));
    }
}

DI void wr_item(const Params& P, int j, int tid) {
    bf16_t* WRT = (bf16_t*)(P.ws + OFF_WR_T);
    {
        const int k = 16 * j + (tid >> 5), e = tid & 31;
        WRT[(4 + e) * 1024 + k] = f2bf(P.in[31][k * 32 + e]);
    }
    if (tid < 64) {
        const int k = 16 * j + (tid >> 2), n = tid & 3;
        WRT[n * 1024 + k] = f2bf(P.in[29][k * 4 + n]);
    }
    if (tid < 448) WRT[(36 + (tid >> 4)) * 1024 + 16 * j + (tid & 15)] = 0;
}
#define P0A_MOD 192
#define P0A_PE 128
#define P0A_HDN 32
#define P0A_GROUPS 2100
DI void phase0a(const Params& P, char* lds, int tid) {
#ifdef PROBE_P0
    const unsigned long long p0t0 = __builtin_amdgcn_s_memrealtime();
#endif
    const int total = P0A_MOD + P0A_PE + P0A_HDN + NCONV_RNN;
    for (int it = blockIdx.x; it < total; it += gridDim.x) {
        if (it < P0A_MOD) mod_item(P, it, lds, tid);
        else if (it < P0A_MOD + P0A_PE) { if (it - P0A_MOD < 64) pe_item(P, it - P0A_MOD, tid); else wr_item(P, it - P0A_MOD - 64, tid); }
        else if (it < P0A_MOD + P0A_PE + P0A_HDN) hdn_item(P, it - P0A_MOD - P0A_PE, lds, tid);
        else conv_item(P, it - (P0A_MOD + P0A_PE + P0A_HDN), lds, tid);
    }
#ifdef PROBE_P0
    const unsigned long long p0t1 = __builtin_amdgcn_s_memrealtime();
#endif
    conv_groups(P, blockIdx.x, P0A_GROUPS, gridDim.x, lds, tid);
#ifdef PROBE_P0
    if (tid == 0) { volatile unsigned* mm = (volatile unsigned*)(lds + LDS_MISC); mm[203] = (unsigned)(p0t1 - p0t0); mm[204] = (unsigned)(__builtin_amdgcn_s_memrealtime() - p0t1); }
#endif
}

DI void h1_item(const Params& P, int it, int tid) {
    const int w = tid >> 6, lane = tid & 63;
    const int row = it * 8 + w;
    const bool lat = row < NL_;
    const float* src = lat ? P.in[0] + (size_t)row * D_ : P.in[2] + (size_t)(row - NL_) * D_;
    const int b = lat ? (row >> 11) : 8;
    const int t = row & 2047;
    const float* mod = (const float*)(P.ws + OFF_MOD) + b * 6144;
    const float* pe = (const float*)(P.ws + OFF_PE);
    const float* g = P.in[6];
    float v[16];
    float ss = 0.f;
#pragma unroll
    for (int i = 0; i < 2; ++i) {
        const int d = i * 512 + lane * 8;
        float4 x0 = *(const float4*)(src + d), x1 = *(const float4*)(src + d + 4);
        if (lat) {
            const float* pp = (i == 0) ? pe + (t >> 6) * 512 + d : pe + (t & 63) * 512 + (d - 512);
            const float4 p0 = *(const float4*)pp, p1 = *(const float4*)(pp + 4);
            x0.x += p0.x; x0.y += p0.y; x0.z += p0.z; x0.w += p0.w;
            x1.x += p1.x; x1.y += p1.y; x1.z += p1.z; x1.w += p1.w;
        }
        v[i * 8 + 0] = x0.x; v[i * 8 + 1] = x0.y; v[i * 8 + 2] = x0.z; v[i * 8 + 3] = x0.w;
        v[i * 8 + 4] = x1.x; v[i * 8 + 5] = x1.y; v[i * 8 + 6] = x1.z; v[i * 8 + 7] = x1.w;
        ss += x0.x * x0.x + x0.y * x0.y + x0.z * x0.z + x0.w * x0.w + x1.x * x1.x + x1.y * x1.y + x1.z * x1.z + x1.w * x1.w;
    }
#pragma unroll
    for (int o = 32; o > 0; o >>= 1) ss += shx(ss, o, lane);
    const float rstd = rsqrtf(ss * (1.f / 1024.f) + 1e-6f);
    bf16_t* dst = (bf16_t*)(P.ws + OFF_H1) + (size_t)row * D_;
#pragma unroll
    for (int i = 0; i < 2; ++i) {
        const int d = i * 512 + lane * 8;
        float o[8];
#pragma unroll
        for (int hh = 0; hh < 2; ++hh) {
            const float4 gv = *(const float4*)(g + d + 4 * hh), sh = *(const float4*)(mod + d + 4 * hh), sc = *(const float4*)(mod + 1024 + d + 4 * hh);
            o[4 * hh + 0] = v[i * 8 + 4 * hh + 0] * rstd * gv.x * (1.f + sc.x) + sh.x;
            o[4 * hh + 1] = v[i * 8 + 4 * hh + 1] * rstd * gv.y * (1.f + sc.y) + sh.y;
            o[4 * hh + 2] = v[i * 8 + 4 * hh + 2] * rstd * gv.z * (1.f + sc.z) + sh.z;
            o[4 * hh + 3] = v[i * 8 + 4 * hh + 3] * rstd * gv.w * (1.f + sc.w) + sh.w;
        }
        *(uint4*)(dst + d) = make_uint4(pack2(o[0], o[1]), pack2(o[2], o[3]), pack2(o[4], o[5]), pack2(o[6], o[7]));
    }
}
#define P0B_H1 ((NL_ + NC_) / 8)
#define P0B_TAPS 64
DI void taps_item(const Params& P, int it, char* lds, int tid);
DI void phase0b(const Params& P, char* lds, int tid) {
#ifdef PROBE_P0
    const unsigned long long p0t0 = __builtin_amdgcn_s_memrealtime();
#endif
    const int total = P0B_TAPS + P0B_H1;
    for (int it = blockIdx.x; it < total; it += gridDim.x) {
        if (it < P0B_TAPS) taps_item(P, it, lds, tid);
        else h1_item(P, it - P0B_TAPS, tid);
    }
#ifdef PROBE_P0
    const unsigned long long p0t1 = __builtin_amdgcn_s_memrealtime();
#endif
    conv_groups(P, P0A_GROUPS + blockIdx.x, NG_TOTAL, gridDim.x, lds, tid);
#ifdef PROBE_P0
    if (tid == 0) { volatile unsigned* mm = (volatile unsigned*)(lds + LDS_MISC); mm[205] = (unsigned)(p0t1 - p0t0); mm[206] = (unsigned)(__builtin_amdgcn_s_memrealtime() - p0t1); }
#endif
}

namespace pg8 {
typedef f32x4 f32x4r;
#define PG8_LAS __attribute__((address_space(3)))
constexpr int BM = 256, BK = 64, HALF = 128, HTB = HALF * BK * 2, STAGE_BYTES8 = 8 * HTB;
DI int lds_byte(int r, int c) { const int st = (r >> 4) * 2 + (c >> 5), rr = r & 15, cc = c & 31, ob = rr * 64 + cc * 2; return st * 1024 + (ob ^ (((ob >> 9) & 1) << 5)); }
DI void stage_rc(int b, int& R, int& C) { const int st = b / 1024, sb = b % 1024, swz = sb ^ (((sb >> 9) & 1) << 5); R = (st >> 1) * 16 + swz / 64; C = (st & 1) * 32 + (swz % 64) / 2; }
DI int perm32(int rho) { const int n = rho >> 4, i = rho & 15; return 8 * (i >> 2) + 4 * n + (i & 3); }
DI unsigned cvt_pk_bf16(float lo, float hi) { unsigned r; asm volatile("v_cvt_pk_bf16_f32 %0, %1, %2" : "=v"(r) : "v"(lo), "v"(hi)); return r; }

struct GUnit { const char* A; const char* B; const char* B1; bf16_t* O; int ldc, valid, aux; const char* ga[2][2]; };
DI void stage_piece(int tid, int i, int& R, int& C) { stage_rc(tid * 16 + i * 8192, R, C); }

struct EpiStore {
    DI void operator()(const f32x4 (&acc)[2][2][4][2], const GUnit& u, int wr, int wc, int fr, int fq, char* lds) const {
        asm volatile("" : "+v"(fr), "+v"(fq));
#pragma unroll
        for (int ai = 0; ai < 2; ++ai)
#pragma unroll
            for (int m = 0; m < 4; ++m) {
                const int r = ai * HALF + wr * 64 + m * 16 + fr;
                bf16_t* rowp = u.O + (size_t)r * u.ldc + wc * 32 + 8 * fq;
                if (r < u.valid) {
#pragma unroll
                    for (int bj = 0; bj < 2; ++bj) {
                        const f32x4 v0 = acc[ai][bj][m][0], v1 = acc[ai][bj][m][1];
                        u32x4 w;
                        w.x = cvt_pk_bf16(v0[0], v0[1]); w.y = cvt_pk_bf16(v0[2], v0[3]); w.z = cvt_pk_bf16(v1[0], v1[1]); w.w = cvt_pk_bf16(v1[2], v1[3]);
                        *(u32x4*)(rowp + bj * HALF) = w;
                    }
                }
            }
    }
};

template <bool GATHER, class Epi, class Sched>
DI void gemm_phase(char* lds_generic, const int K, const Sched& S, const Epi& E, const int tid) {
    PG8_LAS unsigned char* lds = (PG8_LAS unsigned char*)lds_generic;
    const int wid = __builtin_amdgcn_readfirstlane(tid >> 6), lane = tid & 63, wr = wid >> 2, wc = wid & 3, fr = lane & 15, fq = lane >> 4;
    const int nt = K / BK;
    unsigned voffA[2], voffB[2];
#pragma unroll
    for (int i = 0; i < 2; ++i) {
        int R, C;
        stage_rc(tid * 16 + i * 8192, R, C);
        const int Rb = (R & ~31) + perm32(R & 31);
        voffA[i] = (unsigned)(R * K + C) * 2u;
        voffB[i] = (unsigned)(Rb * K + C) * 2u;
    }
    const size_t kstep = (size_t)(BK * 2);
    const size_t hstep = (size_t)HALF * K * 2;
    const unsigned ldsw = (unsigned)wid * 1024u;
    const int aoff = lds_byte(wr * 64 + fr, fq * 8), boff = lds_byte(wc * 32 + fr, fq * 8);
#define PG8_SA(b, h) (((b) * 2 + (h)) * HTB)
#define PG8_SB(b, h) ((4 + (b) * 2 + (h)) * HTB)
#define PG8_STAGE(bufoff, gbase, voff) do { _Pragma("unroll") for (int _i = 0; _i < 2; ++_i) \
        __builtin_amdgcn_global_load_lds((const unsigned*)((const char*)(gbase) + (voff)[_i]), (PG8_LAS unsigned*)(lds + (bufoff) + ldsw + _i * 8192), 16, 0, 0); } while (0)
#define PG8_STAGE_A(bufoff, uu, ubase, h, kb) do { _Pragma("unroll") for (int _i = 0; _i < 2; ++_i) { \
        const char* _p = GATHER ? (uu).ga[h][_i] + (kb) : (ubase) + (size_t)(h) * hstep + (kb) + voffA[_i]; \
        __builtin_amdgcn_global_load_lds((const unsigned*)_p, (PG8_LAS unsigned*)(lds + (bufoff) + ldsw + _i * 8192), 16, 0, 0); } } while (0)
#define PG8_LDA(dst, b, h) do { _Pragma("unroll") for (int m = 0; m < 4; ++m) _Pragma("unroll") for (int k = 0; k < 2; ++k) dst[m][k] = *(const PG8_LAS bf16x8*)(lds + PG8_SA(b, h) + aoff + m * 2048 + k * 1024); } while (0)
#define PG8_LDB(dst, b, h) do { _Pragma("unroll") for (int n = 0; n < 2; ++n) _Pragma("unroll") for (int k = 0; k < 2; ++k) dst[n][k] = *(const PG8_LAS bf16x8*)(lds + PG8_SB(b, h) + boff + n * 2048 + k * 1024); } while (0)
#define PG8_MMA(ai, bj, At, Bt) do { __builtin_amdgcn_s_setprio(1); _Pragma("unroll") for (int m = 0; m < 4; ++m) _Pragma("unroll") for (int n = 0; n < 2; ++n) _Pragma("unroll") for (int k = 0; k < 2; ++k) \
        acc[ai][bj][m][n] = __builtin_amdgcn_mfma_f32_16x16x32_bf16(Bt[n][k], At[m][k], acc[ai][bj][m][n], 0, 0, 0); __builtin_amdgcn_s_setprio(0); } while (0)
#define PG8_WAIT_V(n) asm volatile("s_waitcnt vmcnt(" #n ")" ::: "memory")
#define PG8_WAIT_L(n) asm volatile("s_waitcnt lgkmcnt(" #n ")" ::: "memory")
#define PG8_BAR __builtin_amdgcn_s_barrier()
#define PG8_SCHED __builtin_amdgcn_sched_barrier(0)
    GUnit cur, nxt;
    int ui = 0;
    if (!S.next(0, cur)) return;
    f32x4 acc[2][2][4][2];
#pragma unroll
    for (int a = 0; a < 2; ++a)
#pragma unroll
        for (int b = 0; b < 2; ++b)
#pragma unroll
            for (int m = 0; m < 4; ++m)
#pragma unroll
                for (int n = 0; n < 2; ++n) acc[a][b][m][n] = (f32x4){0.f, 0.f, 0.f, 0.f};
    bf16x8 At[4][2], B0[2][2], B1[2][2];
    PG8_STAGE(PG8_SB(0, 0), cur.B, voffB); PG8_STAGE_A(PG8_SA(0, 0), cur, cur.A, 0, 0); PG8_STAGE(PG8_SB(0, 1), cur.B1, voffB); PG8_STAGE_A(PG8_SA(0, 1), cur, cur.A, 1, 0);
    if (wr == 1) PG8_BAR;
    PG8_WAIT_V(4); PG8_BAR;
    PG8_STAGE(PG8_SB(1, 0), cur.B + kstep, voffB); PG8_STAGE_A(PG8_SA(1, 0), cur, cur.A, 0, kstep); PG8_STAGE(PG8_SB(1, 1), cur.B1 + kstep, voffB);
    PG8_WAIT_V(6); PG8_BAR;
    for (;;) {
        const bool has_next = S.next(ui + 1, nxt);
        if (!has_next) {
            nxt.A = cur.A; nxt.B = cur.B; nxt.B1 = cur.B1;
            if (GATHER) { nxt.ga[0][0] = cur.ga[0][0]; nxt.ga[0][1] = cur.ga[0][1]; nxt.ga[1][0] = cur.ga[1][0]; nxt.ga[1][1] = cur.ga[1][1]; }
        }
        for (int t = 0; t < nt; t += 2) {
            const bool last = (t == nt - 2);
            const size_t k2 = last ? (size_t)0 : (size_t)(t + 2) * kstep;
            const size_t k1 = (size_t)(t + 1) * kstep, k3 = k2 + kstep;
            struct { const char* A; const char* B; const char* B1; const char* ga[2][2]; } w2;
            w2.A = last ? nxt.A : cur.A; w2.B = last ? nxt.B : cur.B; w2.B1 = last ? nxt.B1 : cur.B1;
            if (GATHER) {
                w2.ga[0][0] = last ? nxt.ga[0][0] : cur.ga[0][0]; w2.ga[0][1] = last ? nxt.ga[0][1] : cur.ga[0][1];
                w2.ga[1][0] = last ? nxt.ga[1][0] : cur.ga[1][0]; w2.ga[1][1] = last ? nxt.ga[1][1] : cur.ga[1][1];
            }
            PG8_LDB(B0, 0, 0); PG8_SCHED; PG8_LDA(At, 0, 0); PG8_STAGE_A(PG8_SA(1, 1), cur, cur.A, 1, k1);
            PG8_WAIT_L(8); PG8_BAR; PG8_WAIT_L(0); PG8_MMA(0, 0, At, B0); PG8_BAR; PG8_SCHED;
            PG8_LDB(B1, 0, 1); PG8_STAGE(PG8_SB(0, 0), w2.B + k2, voffB);
            PG8_BAR; PG8_WAIT_L(0); PG8_MMA(0, 1, At, B1); PG8_BAR;
            PG8_LDA(At, 0, 1); PG8_STAGE_A(PG8_SA(0, 0), w2, w2.A, 0, k2);
            PG8_BAR; PG8_WAIT_L(0); PG8_MMA(1, 0, At, B0); PG8_BAR; PG8_SCHED;
            PG8_STAGE(PG8_SB(0, 1), w2.B1 + k2, voffB);
            PG8_WAIT_V(6); PG8_BAR; PG8_MMA(1, 1, At, B1); PG8_BAR;
            PG8_LDB(B0, 1, 0); PG8_SCHED; PG8_LDA(At, 1, 0); PG8_STAGE_A(PG8_SA(0, 1), w2, w2.A, 1, k2);
            PG8_WAIT_L(8); PG8_BAR; PG8_WAIT_L(0); PG8_MMA(0, 0, At, B0); PG8_BAR; PG8_SCHED;
            PG8_LDB(B1, 1, 1); PG8_STAGE(PG8_SB(1, 0), w2.B + k3, voffB);
            PG8_BAR; PG8_WAIT_L(0); PG8_MMA(0, 1, At, B1); PG8_BAR;
            PG8_LDA(At, 1, 1); PG8_STAGE_A(PG8_SA(1, 0), w2, w2.A, 0, k3);
            PG8_BAR; PG8_WAIT_L(0); PG8_MMA(1, 0, At, B0); PG8_BAR; PG8_SCHED;
            PG8_STAGE(PG8_SB(1, 1), w2.B1 + k3, voffB);
            PG8_WAIT_V(6); PG8_BAR; PG8_MMA(1, 1, At, B1); PG8_BAR;
        }
        E(acc, cur, wr, wc, fr, fq, lds_generic);
        if (!has_next) break;
#pragma unroll
        for (int a = 0; a < 2; ++a)
#pragma unroll
            for (int b = 0; b < 2; ++b)
#pragma unroll
                for (int m = 0; m < 4; ++m)
#pragma unroll
                    for (int n = 0; n < 2; ++n) acc[a][b][m][n] = (f32x4){0.f, 0.f, 0.f, 0.f};
        cur.A = nxt.A; cur.B = nxt.B; cur.B1 = nxt.B1; cur.O = nxt.O; cur.ldc = nxt.ldc; cur.valid = nxt.valid; cur.aux = nxt.aux;
        if (GATHER) { cur.ga[0][0] = nxt.ga[0][0]; cur.ga[0][1] = nxt.ga[0][1]; cur.ga[1][0] = nxt.ga[1][0]; cur.ga[1][1] = nxt.ga[1][1]; }
        ++ui;
    }
    PG8_WAIT_V(0);
    if (wr == 0) PG8_BAR;
    PG8_BAR;
#undef PG8_SA
#undef PG8_SB
#undef PG8_STAGE
#undef PG8_STAGE_A
#undef PG8_LDA
#undef PG8_LDB
#undef PG8_MMA
#undef PG8_WAIT_V
#undef PG8_WAIT_L
#undef PG8_BAR
#undef PG8_SCHED
}
}

struct GPtr { const bf16_t* a[4]; const bf16_t* b[2]; };
#define GC_LOAD(SI, kt_)                                                                                 \
    do {                                                                                                  \
        const int ko_ = (kt_) * 64;                                                                       \
        S[SI][0] = *(const u32x4*)(g.a[0] + ko_); S[SI][1] = *(const u32x4*)(g.a[1] + ko_);               \
        S[SI][2] = *(const u32x4*)(g.a[2] + ko_); S[SI][3] = *(const u32x4*)(g.a[3] + ko_);               \
        S[SI][4] = *(const u32x4*)(g.b[0] + ko_); S[SI][5] = *(const u32x4*)(g.b[1] + ko_);               \
    } while (0)
#define GC_STORE(SI, st_)                                                                                 \
    do {                                                                                                  \
        char* s2_ = lds + (st_) * STAGE_BYTES;                                                            \
        *(u32x4*)(s2_ + a_w) = S[SI][0]; *(u32x4*)(s2_ + a_w + 64 * LROW) = S[SI][1];                      \
        *(u32x4*)(s2_ + a_w + 128 * LROW) = S[SI][2]; *(u32x4*)(s2_ + a_w + 192 * LROW) = S[SI][3];        \
        *(u32x4*)(s2_ + b_w) = S[SI][4]; *(u32x4*)(s2_ + b_w + 64 * LROW) = S[SI][5];                      \
    } while (0)
#define GC_BODY(kt_, SL, SS)                                                                              \
    do {                                                                                                  \
        if ((kt_) + 3 < nk) GC_LOAD(SL, (kt_) + 3);                                                       \
        const char* s_ = lds + ((kt_) & 1) * STAGE_BYTES;                                                 \
        _Pragma("unroll") for (int ks = 0; ks < 4; ++ks) {                                                \
            const bf16x8 fa0 = *(const bf16x8*)(s_ + a_r + ks * 32);                                      \
            const bf16x8 fa1 = *(const bf16x8*)(s_ + a_r + 32 * LROW + ks * 32);                          \
            const bf16x8 fb0 = *(const bf16x8*)(s_ + b_r + ks * 32);                                      \
            const bf16x8 fb1 = *(const bf16x8*)(s_ + b_r + 32 * LROW + ks * 32);                          \
            if (SWAP) {                                                                                   \
                acc[0][0] = MFMA32(fb0, fa0, acc[0][0]); acc[0][1] = MFMA32(fb1, fa0, acc[0][1]);         \
                acc[1][0] = MFMA32(fb0, fa1, acc[1][0]); acc[1][1] = MFMA32(fb1, fa1, acc[1][1]);         \
            } else {                                                                                      \
                acc[0][0] = MFMA32(fa0, fb0, acc[0][0]); acc[0][1] = MFMA32(fa0, fb1, acc[0][1]);         \
                acc[1][0] = MFMA32(fa1, fb0, acc[1][0]); acc[1][1] = MFMA32(fa1, fb1, acc[1][1]);         \
            }                                                                                             \
        }                                                                                                 \
        if ((kt_) + 1 < nk) GC_STORE(SS, ((kt_) + 1) & 1);                                                \
        __syncthreads();                                                                                  \
    } while (0)

DI void gemm_issue(u32x4 (&S)[3][6], const GPtr& g) {
    GC_LOAD(0, 0);
    GC_LOAD(1, 1);
    GC_LOAD(2, 2);
}
template <bool SWAP>
DI void gemm_run(f32x16 (&acc)[2][2], u32x4 (&S)[3][6], const GPtr& g, int nk, char* lds, int tid) {
    const int lrow = tid >> 3, lchunk = tid & 7;
    const unsigned a_w = lrow * LROW + lchunk * 16;
    const unsigned b_w = A_STAGE + lrow * LROW + lchunk * 16;
    const int lane = tid & 63, w = tid >> 6, wm = w >> 1, wn = w & 1, r = lane & 31, h = lane >> 5;
    const unsigned a_r = (wm * 64 + r) * LROW + h * 16;
    const unsigned b_r = A_STAGE + (wn * 64 + r) * LROW + h * 16;
#pragma unroll
    for (int i = 0; i < 2; ++i)
#pragma unroll
        for (int j = 0; j < 2; ++j)
#pragma unroll
            for (int e = 0; e < 16; ++e) acc[i][j][e] = 0.f;
    __syncthreads();
    GC_STORE(0, 0);
    __syncthreads();
    for (int kt = 0; kt < nk; kt += 3) {
        GC_BODY(kt, 0, 1);
        if (kt + 1 < nk) GC_BODY(kt + 1, 1, 2);
        if (kt + 2 < nk) GC_BODY(kt + 2, 2, 0);
    }
}

#define ET_ROW 272
#define ETS_ROW 528
DI void acc_to_lds_tok(const f32x16 (&acc)[2][2], char* lds, int wm, int wn, int r, int h) {
#pragma unroll
    for (int i = 0; i < 2; ++i)
#pragma unroll
        for (int j = 0; j < 2; ++j)
#pragma unroll
            for (int g = 0; g < 4; ++g)
                *(uint2*)(lds + (wm * 64 + i * 32 + r) * ET_ROW + (wn * 64 + j * 32 + 8 * g + 4 * h) * 2) =
                    make_uint2(pack2(acc[i][j][4 * g], acc[i][j][4 * g + 1]), pack2(acc[i][j][4 * g + 2], acc[i][j][4 * g + 3]));
}
DI void acc_to_lds_chan(const f32x16 (&acc)[2][2], char* lds, int wm, int wn, int r, int h) {
#pragma unroll
    for (int i = 0; i < 2; ++i)
#pragma unroll
        for (int j = 0; j < 2; ++j)
#pragma unroll
            for (int g = 0; g < 4; ++g)
                *(uint2*)(lds + (wn * 64 + j * 32 + r) * ETS_ROW + (wm * 64 + i * 32 + 8 * g + 4 * h) * 2) =
                    make_uint2(pack2(acc[i][j][4 * g], acc[i][j][4 * g + 1]), pack2(acc[i][j][4 * g + 2], acc[i][j][4 * g + 3]));
}
DI void lds_to_rows(char* lds, bf16_t* dst, int ld, int valid, int tid) {
#pragma unroll
    for (int i = 0; i < 8; ++i) {
        const int q = tid + NTHR * i, row = q >> 4, ch = q & 15;
        if (row < valid) *(uint4*)(dst + (size_t)row * ld + ch * 8) = *(const uint4*)(lds + row * ET_ROW + ch * 16);
    }
}

struct P1Sched {
    const char* h1; const char* wt; bf16_t* pa; bf16_t* pu; bf16_t* pht; int x, j, nj;
    DI bool next(int i, pg8::GUnit& u) const {
        const int k = j + i * nj;
        if (k >= 82) return false;
        u.valid = 256; u.aux = 0;
        if (k < 32) {
            const int pm = (k >> 2) * 8 + x, pn = k & 3;
            u.A = h1 + (size_t)pm * 256 * 2048;
            u.B = wt + (size_t)pn * 256 * 2048;
            u.B1 = u.B + (size_t)128 * 2048;
            u.O = ((pn < 2) ? pa + pn * 256 : pu + (pn - 2) * 256) + (size_t)pm * 256 * 512;
            u.ldc = 512;
        } else if (k < 34) {
            const int pn = k - 32;
            u.A = h1 + (size_t)(NL_ + x * 256) * 2048;
            u.B = wt + (size_t)(512 + pn * 256) * 2048;
            u.B1 = u.B + (size_t)128 * 2048;
            u.O = pu + (size_t)(NL_ + x * 256) * 512 + pn * 256;
            u.ldc = 512;
        } else {
            const int k2 = k - 34, tt = (k2 / 6) * 8 + x, pm = k2 % 6;
            u.A = wt + (size_t)(1024 + pm * 256) * 2048;
            u.B = h1 + (size_t)tt * 256 * 2048;
            u.B1 = u.B + (size_t)128 * 2048;
            u.O = pht + (size_t)pm * 256 * NL_ + tt * 256;
            u.ldc = NL_;
        }
        return true;
    }
};
DI void phase1(const Params& P, char* lds, int tid) {
    char* ws = P.ws;
    P1Sched S{ws + OFF_H1, ws + OFF_WIN_T, (bf16_t*)(ws + OFF_PA), (bf16_t*)(ws + OFF_PU), (bf16_t*)(ws + OFF_PHT),
              (int)(blockIdx.x & 7), (int)(blockIdx.x >> 3), (int)(gridDim.x >> 3)};
    pg8::EpiStore E;
    pg8::gemm_phase<false>(lds, 1024, S, E, tid);
}

DI int crow(int e, int h) { return (e & 3) + 8 * (e >> 2) + 4 * h; }

DI void taps_item(const Params& P, int it, char* lds, int tid) {
    const int lane = tid & 63, w = __builtin_amdgcn_readfirstlane(tid >> 6), r = lane & 31, h = lane >> 5;
    const int col0 = it * 32;
    const int dir = col0 >> 10, o = (col0 >> 9) & 1;
    const float* w3 = P.in[22];
    const float* b3 = P.in[23];
    const bf16_t* HB = (const bf16_t*)(P.ws + OFF_HDN2);
    bf16_t* RALL = (bf16_t*)(P.ws + OFF_RALL);
    float* red = (float*)lds;
    __syncthreads();
    bf16x8 fa[4];
#pragma unroll
    for (int ks = 0; ks < 4; ++ks)
#pragma unroll
        for (int j = 0; j < 8; ++j) fa[ks][j] = (short)f2bf(w3[(size_t)(16 * ks + 8 * h + j) * 2048 + col0 + r]);
    float s[16];
#pragma unroll
    for (int e = 0; e < 16; ++e) s[e] = 0.f;
    const float mind = -3.0701134573253945f, maxd = -15.350567286626973f;
    for (int q = 0; q < 8; ++q) {
        const int t0 = (w * 8 + q) * 32, t = t0 + r;
        f32x16 acc;
#pragma unroll
        for (int e = 0; e < 16; ++e) acc[e] = 0.f;
#pragma unroll
        for (int ks = 0; ks < 4; ++ks) {
            bf16x8 fb = *(const bf16x8*)(HB + (size_t)t * 64 + 16 * ks + 8 * h);
            acc = MFMA32(fa[ks], fb, acc);
        }
        const float tt = (float)t / 2047.f;
        const bool valid = !(dir == 1 && t == 0);
#pragma unroll
        for (int e = 0; e < 16; ++e) {
            const int col = col0 + crow(e, h);
            const int c = col & 511;
            const float delta = fabsf(mind + (float)c * ((maxd - mind) / 511.f));
            const float val = (acc[e] + b3[col]) * __expf(-tt * delta);
            if (valid) s[e] += fabsf(val);
            *(bf16_t*)(lds + 4096 + crow(e, h) * 4112 + (dir ? t : 2048 - t) * 2) = f2bf(valid ? val : 0.f);
        }
    }
#pragma unroll
    for (int e = 0; e < 16; ++e) {
        float v = s[e];
        v += shx(v, 16, lane); v += shx(v, 8, lane); v += shx(v, 4, lane); v += shx(v, 2, lane); v += shx(v, 1, lane);
        if (r == 0) red[w * 32 + crow(e, h)] = v;
    }
    if (dir == 0 && tid < 32) *(bf16_t*)(lds + 4096 + tid * 4112) = 0;
    __syncthreads();
    if (tid < 32) {
        float v = 0.f;
#pragma unroll
        for (int ww = 0; ww < 8; ++ww) v += red[ww * 32 + tid];
        const int c = (col0 + tid) & 511;
        ((float*)(P.ws + OFF_NRM2))[(dir * 2 + o) * 512 + c] = v;
        bf16_t* R = RALL + (size_t)(c * 2 + o) * 4104;
        const bf16_t* img = (const bf16_t*)(lds + 4096 + tid * 4112);
        if (dir == 0) {
            R[2048] = img[2048];
            unsigned z = 0u;
            asm volatile("" : "+v"(z));
            *(uint4*)(R + 4096) = make_uint4(z, z, z, z);
        } else {
#pragma unroll
            for (int k = 1; k < 8; ++k) R[2048 + k] = img[k];
        }
    }
    for (int q = tid; q < 32 * 256; q += NTHR) {
        const int cl = q >> 8, k = q & 255;
        if (dir == 1 && k == 0) continue;
        const int c = (col0 + cl) & 511;
        *(uint4*)(RALL + (size_t)(c * 2 + o) * 4104 + (dir ? 2048 : 0) + 8 * k) = *(const uint4*)(lds + 4096 + cl * 4112 + 16 * k);
    }
}

#define HY_G 0
#define HY_GSTRIDE 8448
#define HY_GOFF(sh) ((0x8D518D50u >> (4 * (sh))) & 15u)
#define HY_U 67584
#define HY_UROW 6160
#define HY_PAD 15
#define HY_GATE (HY_U + 8 * HY_UROW)

DI void conv32(const bf16_t* src, int J, float w0, float w1, float w2, uint4 (&o)[4]) {
    const uint4* p = (const uint4*)(src + 32 * J);
    const uint4 q0 = p[0], q1 = p[1], q2 = p[2], q3 = p[3];
    const float prev = (J > 0) ? bf2f(src[32 * J - 1]) : 0.f;
    const float next = (J < 63) ? bf2f(src[32 * J + 32]) : 0.f;
    const unsigned wv[16] = {q0.x, q0.y, q0.z, q0.w, q1.x, q1.y, q1.z, q1.w, q2.x, q2.y, q2.z, q2.w, q3.x, q3.y, q3.z, q3.w};
    float x[34];
    x[0] = prev;
#pragma unroll
    for (int i = 0; i < 16; ++i) {
        x[1 + 2 * i] = __uint_as_float(wv[i] << 16);
        x[2 + 2 * i] = __uint_as_float(wv[i] & 0xffff0000u);
    }
    x[33] = next;
    unsigned y[16];
#pragma unroll
    for (int i = 0; i < 16; ++i) {
        const float a = w0 * x[2 * i] + w1 * x[2 * i + 1] + w2 * x[2 * i + 2];
        const float b = w0 * x[2 * i + 1] + w1 * x[2 * i + 2] + w2 * x[2 * i + 3];
        y[i] = pack2(a, b);
    }
    o[0] = make_uint4(y[0], y[1], y[2], y[3]);
    o[1] = make_uint4(y[4], y[5], y[6], y[7]);
    o[2] = make_uint4(y[8], y[9], y[10], y[11]);
    o[3] = make_uint4(y[12], y[13], y[14], y[15]);
}

DI void hyena_item(const Params& P, int c, char* lds, int tid) {
#ifdef PROBE_HY
    const unsigned long long hy_it0 = __builtin_amdgcn_s_memrealtime();
#endif
    const bf16_t* PHT = (const bf16_t*)(P.ws + OFF_PHT);
    const bf16_t* RALL = (const bf16_t*)(P.ws + OFF_RALL) + (size_t)c * 2 * 4104;
    const float* NRM2 = (const float*)(P.ws + OFF_NRM2);
    bf16_t* YBT = (bf16_t*)(P.ws + OFF_YBT);
    const float* cw = P.in[15];
    const int lane = tid & 63;
    const int w = __builtin_amdgcn_readfirstlane(tid >> 6);
    const int g = w & 3, par = w >> 2;
    const int h = lane >> 5, i_ = lane & 31;
    const int lb = tid >> 6, lJ = tid & 63;
    __syncthreads();
    for (int q = tid; q < 8 * 2 * 60; q += NTHR) {
        const int b = q / 120, rem = q % 120, side = rem / 60, k = rem % 60;
        *(uint4*)(lds + HY_U + b * HY_UROW + (side ? (HY_PAD + 64) * 64 : 0) + k * 16) = make_uint4(0u, 0u, 0u, 0u);
    }
    {
        uint4 o[4];
        conv32(PHT + (size_t)c * NL_ + lb * S_, lJ, cw[c], cw[1536 + c], cw[3072 + c], o);
        uint4* d = (uint4*)(lds + HY_U + lb * HY_UROW + (HY_PAD + lJ) * 64);
        d[0] = o[0]; d[1] = o[1]; d[2] = o[2]; d[3] = o[3];
        conv32(PHT + (size_t)(512 + c) * NL_ + lb * S_, lJ, cw[512 + c], cw[1536 + 512 + c], cw[3072 + 512 + c], o);
        uint4* e = (uint4*)(lds + HY_GATE + lb * 4096 + lJ * 64);
        e[0] = o[0]; e[1] = o[1]; e[2] = o[2]; e[3] = o[3];
    }
    const int sh_ = (-i_) & 7;
    const int a_base = HY_G + sh_ * HY_GSTRIDE + (int)HY_GOFF(sh_) * 16 + (2048 - i_ + 8 * h - sh_) * 2;
    const int batch = i_ >> 2, blk = i_ & 3;
    const int b_base = HY_U + batch * HY_UROW + ((HY_PAD + blk) * 32 + 8 * h) * 2;
    for (int o_ = 0; o_ < 2; ++o_) {
        __syncthreads();
        if (o_ == 1) {
            uint4 o[4];
            conv32(PHT + (size_t)(1024 + c) * NL_ + lb * S_, lJ, cw[1024 + c], cw[1536 + 1024 + c], cw[3072 + 1024 + c], o);
            uint4* e = (uint4*)(lds + HY_GATE + lb * 4096 + lJ * 64);
            e[0] = o[0]; e[1] = o[1]; e[2] = o[2]; e[3] = o[3];
        }
        {
            const uint4* Rg = (const uint4*)(RALL + (size_t)o_ * 4104);
            const uint4 lo = Rg[tid], hi = Rg[tid + 1];
            const unsigned wv[8] = {lo.x, lo.y, lo.z, lo.w, hi.x, hi.y, hi.z, hi.w};
#pragma unroll
            for (int sh = 0; sh < 8; ++sh) {
                const int s2 = sh >> 1;
                uint4 ov;
                if (sh & 1) {
                    ov.x = (wv[s2] >> 16) | (wv[s2 + 1] << 16);
                    ov.y = (wv[s2 + 1] >> 16) | (wv[s2 + 2] << 16);
                    ov.z = (wv[s2 + 2] >> 16) | (wv[s2 + 3] << 16);
                    ov.w = (wv[s2 + 3] >> 16) | (wv[s2 + 4] << 16);
                } else {
                    ov = make_uint4(wv[s2], wv[s2 + 1], wv[s2 + 2], wv[s2 + 3]);
                }
                *(uint4*)(lds + HY_G + sh * HY_GSTRIDE + (int)HY_GOFF(sh) * 16 + tid * 16) = ov;
            }
        }
        __syncthreads();
        f32x16 acc[4];
#pragma unroll
        for (int tt = 0; tt < 4; ++tt)
#pragma unroll
            for (int e = 0; e < 16; ++e) acc[tt][e] = 0.f;
#ifdef PROBE_HY
        unsigned long long hy_t0 = __builtin_amdgcn_s_memrealtime();
#endif
#pragma unroll 2
        for (int D = 16 * g - 63 + par; D <= 16 * g + 15; D += 2) {
#pragma unroll
            for (int ks = 0; ks < 2; ++ks) {
                const bf16x8 fa = *(const bf16x8*)(lds + a_base + (-64 * D + 32 * ks));
#pragma unroll
                for (int tt = 0; tt < 4; ++tt) {
                    const bf16x8 fb = *(const bf16x8*)(lds + b_base + ((4 * (4 * g + tt) - D) * 64 + 32 * ks));
                    acc[tt] = MFMA32(fa, fb, acc[tt]);
                }
            }
        }
        __syncthreads();
#ifdef PROBE_HY
        if (tid == 0) { volatile unsigned* mm = (volatile unsigned*)(lds + LDS_MISC); mm[200] += (unsigned)(__builtin_amdgcn_s_memrealtime() - hy_t0); mm[201] += 1u; }
#endif
        float* scr = (float*)(lds + HY_G);
        if (par == 1) {
#pragma unroll
            for (int tt = 0; tt < 4; ++tt)
#pragma unroll
                for (int e = 0; e < 16; ++e) scr[((g * 4 + tt) * 16 + e) * 64 + lane] = acc[tt][e];
        }
        __syncthreads();
        if (par == 0) {
            const float inv = 1.f / (NRM2[(0 * 2 + o_) * 512 + c] + NRM2[(1 * 2 + o_) * 512 + c]);
            const float bias = P.in[24][o_ * 512 + c];
#pragma unroll
            for (int tt = 0; tt < 4; ++tt) {
                const int I = 4 * (4 * g + tt) + blk;
#pragma unroll
                for (int q = 0; q < 4; ++q) {
                    const int i0 = 8 * q + 4 * h;
                    char* up = lds + HY_U + batch * HY_UROW + ((HY_PAD + I) * 32 + i0) * 2;
                    const uint2 uu = *(const uint2*)up;
                    const uint2 gg = *(const uint2*)(lds + HY_GATE + batch * 4096 + (32 * I + i0) * 2);
                    float rr[4];
#pragma unroll
                    for (int e = 0; e < 4; ++e) {
                        const float a = acc[tt][4 * q + e] + scr[((g * 4 + tt) * 16 + 4 * q + e) * 64 + lane];
                        const unsigned uw = (e < 2) ? uu.x : uu.y, gw = (e < 2) ? gg.x : gg.y;
                        const float uf = (e & 1) ? __uint_as_float(uw & 0xffff0000u) : __uint_as_float(uw << 16);
                        const float gf = (e & 1) ? __uint_as_float(gw & 0xffff0000u) : __uint_as_float(gw << 16);
                        rr[e] = gf * (a * inv + uf * bias);
                    }
                    uint2 ov;
                    ov.x = pack2(rr[0], rr[1]);
                    ov.y = pack2(rr[2], rr[3]);
                    *(uint2*)up = ov;
                }
            }
        }
    }
    __syncthreads();
    {
        const uint4* sp = (const uint4*)(lds + HY_U + lb * HY_UROW + (HY_PAD + lJ) * 64);
        uint4* gp = (uint4*)(YBT + (size_t)c * NL_ + lb * S_ + lJ * 32);
        gp[0] = sp[0]; gp[1] = sp[1]; gp[2] = sp[2]; gp[3] = sp[3];
    }
#ifdef PROBE_HY
    if (tid == 0) { volatile unsigned* mm = (volatile unsigned*)(lds + LDS_MISC); mm[202] += (unsigned)(__builtin_amdgcn_s_memrealtime() - hy_it0); }
#endif
}

#define RN_V 0
#define RN_W 36864
#define RN_AGG 55296
#define RN_CARRY 59392

DI void rnn_item(const Params& P, int it, char* lds, int tid) {
    const int b = it >> 4, hd = (it >> 1) & 7, dir = it & 1;
    const bf16_t* PU = (const bf16_t*)(P.ws + OFF_PU);
    const bf16_t* WR = (const bf16_t*)(P.ws + OFF_WRNN_T);
    bf16_t* HS = (bf16_t*)(P.ws + OFF_HS) + (size_t)dir * NL_ * 512;
    const int lane = tid & 63, w = __builtin_amdgcn_readfirstlane(tid >> 6), r = lane & 31, h = lane >> 5;
    float* AGG = (float*)(lds + RN_AGG);
    float* CARRY = (float*)(lds + RN_CARRY);
    __syncthreads();
    for (int q = tid; q < 1024; q += NTHR) {
        const int n = q >> 3, ch = q & 7;
        *(uint4*)(lds + RN_W + n * LROW + ch * 16) = *(const uint4*)(WR + (size_t)(hd * 256 + dir * 128 + n) * 64 + ch * 8);
    }
    if (tid < 64) CARRY[tid] = 0.f;
    float ba[2], bx[2], sp[2];
#pragma unroll
    for (int jh = 0; jh < 2; ++jh) {
        const int ch = hd * 64 + jh * 32 + r;
        ba[jh] = P.in[11][dir * 512 + ch];
        bx[jh] = P.in[13][dir * 512 + ch];
        sp[jh] = log1pf(expf(-P.in[14][dir * 512 + ch]));
    }
    const int cc = tid & 7, tg = tid >> 3;
    for (int ci = 0; ci < 9; ++ci) {
        const bool isctx = (ci == 0);
        const int n = isctx ? CT_ : S_;
        const int tbase = isctx ? 0 : (dir ? (8 - ci) * 256 : (ci - 1) * 256);
        const bf16_t* src = (isctx ? PU + (size_t)(NL_ + b * CT_) * 512 : PU + (size_t)(b * S_) * 512) + hd * 64 + cc * 8;
        const int tlo = dir ? (tbase + 255 - 4 * tg - 3) : (tbase + 4 * tg);
        {
            float cwv[4][8], cbv[8];
            {
                const float4* cb4 = (const float4*)(P.in[9] + hd * 64 + cc * 8);
                const float4 c0 = cb4[0], c1 = cb4[1];
                cbv[0] = c0.x; cbv[1] = c0.y; cbv[2] = c0.z; cbv[3] = c0.w; cbv[4] = c1.x; cbv[5] = c1.y; cbv[6] = c1.z; cbv[7] = c1.w;
#pragma unroll
                for (int m = 0; m < 4; ++m) {
                    const float4* cw4 = (const float4*)(P.in[8] + m * 512 + hd * 64 + cc * 8);
                    const float4 d0 = cw4[0], d1 = cw4[1];
                    cwv[m][0] = d0.x; cwv[m][1] = d0.y; cwv[m][2] = d0.z; cwv[m][3] = d0.w;
                    cwv[m][4] = d1.x; cwv[m][5] = d1.y; cwv[m][6] = d1.z; cwv[m][7] = d1.w;
                }
            }
            float x[7][8];
#pragma unroll
            for (int m = 0; m < 7; ++m) {
                const int t = tlo - 2 + m;
                uint4 q = make_uint4(0u, 0u, 0u, 0u);
                if (t >= 0 && t < n) q = *(const uint4*)(src + (size_t)t * 512);
                x[m][0] = __uint_as_float(q.x << 16); x[m][1] = __uint_as_float(q.x & 0xffff0000u);
                x[m][2] = __uint_as_float(q.y << 16); x[m][3] = __uint_as_float(q.y & 0xffff0000u);
                x[m][4] = __uint_as_float(q.z << 16); x[m][5] = __uint_as_float(q.z & 0xffff0000u);
                x[m][6] = __uint_as_float(q.w << 16); x[m][7] = __uint_as_float(q.w & 0xffff0000u);
            }
#pragma unroll
            for (int k = 0; k < 4; ++k) {
                float v[8];
#pragma unroll
                for (int j = 0; j < 8; ++j)
                    v[j] = cbv[j] + cwv[0][j] * x[k][j] + cwv[1][j] * x[k + 1][j] + cwv[2][j] * x[k + 2][j] + cwv[3][j] * x[k + 3][j];
                const int rho = dir ? (4 * tg + 3 - k) : (4 * tg + k);
                *(uint4*)(lds + RN_V + rho * LROW + cc * 16) = make_uint4(pack2(v[0], v[1]), pack2(v[2], v[3]), pack2(v[4], v[5]), pack2(v[6], v[7]));
            }
        }
        __syncthreads();
        f32x16 acc[4];
#pragma unroll
        for (int nt = 0; nt < 4; ++nt)
#pragma unroll
            for (int e = 0; e < 16; ++e) acc[nt][e] = 0.f;
#pragma unroll
        for (int ks = 0; ks < 4; ++ks) {
            const bf16x8 fa = *(const bf16x8*)(lds + RN_V + (32 * w + r) * LROW + ks * 32 + h * 16);
#pragma unroll
            for (int nt = 0; nt < 4; ++nt) {
                const bf16x8 fb = *(const bf16x8*)(lds + RN_W + (32 * nt + r) * LROW + ks * 32 + h * 16);
                acc[nt] = MFMA32(fa, fb, acc[nt]);
            }
        }
        float av[2][16], bv[2][16];
#pragma unroll
        for (int jh = 0; jh < 2; ++jh)
#pragma unroll
            for (int e = 0; e < 16; ++e) {
                const int rho = 32 * w + crow(e, h);
                const float vv = bf2f(*(const bf16_t*)(lds + RN_V + rho * LROW + (jh * 32 + r) * 2));
                const float ra = acc[jh][e] + ba[jh], ri = acc[2 + jh][e] + bx[jh];
                const float rg = __builtin_amdgcn_rcpf(1.f + __expf(-ra));
                const float ig = __builtin_amdgcn_rcpf(1.f + __expf(-ri));
                const float la = -8.f * rg * sp[jh];
                const float x2 = 2.f * la;
                const float em = -x2 * (1.f + x2 * (0.5f + x2 * (0.16666667f + x2 * (0.041666668f + x2 * (0.0083333338f + x2 * 0.0013888889f)))));
                av[jh][e] = __expf(la);
                bv[jh][e] = __builtin_amdgcn_sqrtf(fmaxf(em, 0.f)) * ig * vv;
            }
        float s0A[2][4], s0B[2][4], PA_[2][4], PB_[2][4], WA[2], WB[2];
#pragma unroll
        for (int jh = 0; jh < 2; ++jh) {
#pragma unroll
            for (int q = 0; q < 4; ++q) {
                const float A = av[jh][4 * q] * av[jh][4 * q + 1] * av[jh][4 * q + 2] * av[jh][4 * q + 3];
                float x = bv[jh][4 * q];
                x = av[jh][4 * q + 1] * x + bv[jh][4 * q + 1];
                x = av[jh][4 * q + 2] * x + bv[jh][4 * q + 2];
                x = av[jh][4 * q + 3] * x + bv[jh][4 * q + 3];
                const float oA = shx(A, 32, lane), oB = shx(x, 32, lane);
                s0A[jh][q] = h ? oA : A;
                s0B[jh][q] = h ? oB : x;
                const float s1A = h ? A : oA, s1B = h ? x : oB;
                PA_[jh][q] = s1A * s0A[jh][q];
                PB_[jh][q] = s1A * s0B[jh][q] + s1B;
            }
            WA[jh] = PA_[jh][0] * PA_[jh][1] * PA_[jh][2] * PA_[jh][3];
            float x = PB_[jh][0];
            x = PA_[jh][1] * x + PB_[jh][1];
            x = PA_[jh][2] * x + PB_[jh][2];
            x = PA_[jh][3] * x + PB_[jh][3];
            WB[jh] = x;
            if (h == 0) {
                AGG[(w * 64 + jh * 32 + r) * 2] = WA[jh];
                AGG[(w * 64 + jh * 32 + r) * 2 + 1] = WB[jh];
            }
        }
        __syncthreads();
        float cout_[2];
        char* hvp = lds + RN_V + (32 * w + 4 * h) * LROW + r * 2;
#pragma unroll
        for (int jh = 0; jh < 2; ++jh) {
            const int j = jh * 32 + r;
            float cin = CARRY[j];
            for (int w2 = 0; w2 < w; ++w2) cin = AGG[(w2 * 64 + j) * 2] * cin + AGG[(w2 * 64 + j) * 2 + 1];
            cout_[jh] = WA[jh] * cin + WB[jh];
            float C = cin;
#pragma unroll
            for (int q = 0; q < 4; ++q) {
                const float c1 = s0A[jh][q] * C + s0B[jh][q];
                float x = h ? c1 : C;
#pragma unroll
                for (int e4 = 0; e4 < 4; ++e4) {
                    x = av[jh][4 * q + e4] * x + bv[jh][4 * q + e4];
                    if (!isctx) *(bf16_t*)(hvp + (e4 + 8 * q) * LROW + jh * 64) = f2bf(x);
                }
                C = PA_[jh][q] * C + PB_[jh][q];
            }
        }
        __syncthreads();
        if (w == 7 && h == 0) {
            CARRY[r] = cout_[0];
            CARRY[32 + r] = cout_[1];
        }
        if (!isctx) {
            const int rho = tid >> 1, hf2 = tid & 1;
            const int t = dir ? (tbase + 255 - rho) : (tbase + rho);
            const uint4* sp = (const uint4*)(lds + RN_V + rho * LROW + hf2 * 64);
            uint4* gp = (uint4*)(HS + (size_t)(b * S_ + t) * 512 + hd * 64 + hf2 * 32);
            const uint4 v0 = sp[0], v1 = sp[1], v2 = sp[2], v3 = sp[3];
            gp[0] = v0; gp[1] = v1; gp[2] = v2; gp[3] = v3;
            __syncthreads();
        }
    }
}

#define P2_RNN 128
#define P2_HY 512
DI void phase2(const Params& P, char* lds, int tid, volatile unsigned* misc, int pass) {
    unsigned* qctr = (unsigned*)(P.ws + OFF_CTL) + QUEUE_WORD + pass;
    for (;;) {
        __syncthreads();
        if (tid == 0) misc[8] = atomicAdd(qctr, 1u);
        __syncthreads();
        const int it = __builtin_amdgcn_readfirstlane((int)misc[8]);
        if (it >= P2_RNN + P2_HY) break;
        int tq = tid;
        asm volatile("" : "+v"(tq));
#ifdef PROBE_P2
        if (pass == 1 && ((PROBE_P2 == 1) != (it < P2_RNN))) continue;
#endif
        if (it < P2_RNN) rnn_item(P, it, lds, tq);
        else hyena_item(P, it - P2_RNN, lds, tq);
    }
}

#define P3_A 0
#define P3_AROW 2064
#define P3_LG 132096
#define P3_SC 148480
#define P3_RED 149760
#define CNT_WORD 4160

DI float gelu_tanh(float x) {
    const float u = 0.7978845608028654f * (x + 0.044715f * x * x * x);
    const float t = 1.f - 2.f * __builtin_amdgcn_rcpf(1.f + __expf(2.f * u));
    return 0.5f * x * (1.f + t);
}
DI float bflo(unsigned v) { return __uint_as_float(v << 16); }
DI float bfhi(unsigned v) { return __uint_as_float(v & 0xffff0000u); }

DI void p2b_item(const Params& P, int it, char* lds, int tid) {
    const int tok0 = it * 64;
    const bf16_t* PA = (const bf16_t*)(P.ws + OFF_PA);
    const bf16_t* HF = (const bf16_t*)(P.ws + OFF_HS);
    const bf16_t* HB = HF + (size_t)NL_ * 512;
    const bf16_t* YBT = (const bf16_t*)(P.ws + OFF_YBT);
    bf16_t* YN = (bf16_t*)(P.ws + OFF_YN);
    float* sc = (float*)(lds + P3_SC);
    float* red = (float*)(lds + P3_RED);
    const int lane = tid & 63, w = __builtin_amdgcn_readfirstlane(tid >> 6);
    __syncthreads();
#pragma unroll 2
    for (int i = 0; i < 8; ++i) {
        const int tok = w + 8 * i, c8 = lane;
        const size_t g = (size_t)(tok0 + tok) * 512 + c8 * 8;
        const uint4 pa = *(const uint4*)(PA + g), hf = *(const uint4*)(HF + g), hb = *(const uint4*)(HB + g);
        const unsigned pw[4] = {pa.x, pa.y, pa.z, pa.w}, fw[4] = {hf.x, hf.y, hf.z, hf.w}, bw[4] = {hb.x, hb.y, hb.z, hb.w};
        unsigned ow[4];
        float ss = 0.f;
#pragma unroll
        for (int k = 0; k < 4; ++k) {
            const float y0 = gelu_tanh(bflo(pw[k])) * (bflo(fw[k]) + bflo(bw[k]));
            const float y1 = gelu_tanh(bfhi(pw[k])) * (bfhi(fw[k]) + bfhi(bw[k]));
            ss += y0 * y0 + y1 * y1;
            ow[k] = pack2(y0, y1);
        }
        *(uint4*)(lds + P3_A + tok * P3_AROW + c8 * 16) = make_uint4(ow[0], ow[1], ow[2], ow[3]);
#pragma unroll
        for (int o = 32; o > 0; o >>= 1) ss += shx(ss, o, lane);
        if (lane == 0) sc[tok] = ss;
    }
    {
        float sb[8];
#pragma unroll
        for (int e = 0; e < 8; ++e) sb[e] = 0.f;
        const int j = tid & 7;
#pragma unroll 2
        for (int pass = 0; pass < 8; ++pass) {
            const int c = pass * 64 + (tid >> 3);
            const uint4 v = *(const uint4*)(YBT + (size_t)c * NL_ + tok0 + 8 * j);
            const unsigned vw[4] = {v.x, v.y, v.z, v.w};
#pragma unroll
            for (int k = 0; k < 4; ++k) {
                const float f0 = bflo(vw[k]), f1 = bfhi(vw[k]);
                sb[2 * k] += f0 * f0;
                sb[2 * k + 1] += f1 * f1;
                *(bf16_t*)(lds + P3_A + (8 * j + 2 * k) * P3_AROW + (512 + c) * 2) = (bf16_t)(vw[k] & 0xffffu);
                *(bf16_t*)(lds + P3_A + (8 * j + 2 * k + 1) * P3_AROW + (512 + c) * 2) = (bf16_t)(vw[k] >> 16);
            }
        }
#pragma unroll
        for (int e = 0; e < 8; ++e) {
            float v = sb[e];
            v += shx(v, 8, lane); v += shx(v, 16, lane); v += shx(v, 32, lane);
            if (lane < 8) red[w * 64 + 8 * j + e] = v;
        }
    }
    __syncthreads();
    if (tid < 64) {
        float ssb = 0.f;
#pragma unroll
        for (int ww = 0; ww < 8; ++ww) ssb += red[ww * 64 + tid];
        sc[128 + tid] = rsqrtf(sc[tid] * (1.f / 512.f) + 1e-6f);
        sc[192 + tid] = rsqrtf(ssb * (1.f / 512.f) + 1e-6f);
    }
    __syncthreads();
#pragma unroll 4
    for (int i = 0; i < 16; ++i) {
        const int q = tid + NTHR * i, row = q >> 7, c16 = q & 127;
        const uint4 v = *(const uint4*)(lds + P3_A + row * P3_AROW + c16 * 16);
        const float scl = sc[(c16 < 64 ? 128 : 192) + row];
        uint4 o;
        o.x = pack2(bflo(v.x) * scl, bfhi(v.x) * scl);
        o.y = pack2(bflo(v.y) * scl, bfhi(v.y) * scl);
        o.z = pack2(bflo(v.z) * scl, bfhi(v.z) * scl);
        o.w = pack2(bflo(v.w) * scl, bfhi(v.w) * scl);
        *(uint4*)(YN + (size_t)(tok0 + row) * 1024 + c16 * 8) = o;
    }
}
DI void phase2b(const Params& P, char* lds, int tid) {
    for (int it = blockIdx.x; it < NL_ / 64; it += gridDim.x) p2b_item(P, it, lds, tid);
}

struct P3Sched {
    const char* yn; const char* wt; bf16_t* y; int x, j, nj;
    DI bool next(int i, pg8::GUnit& u) const {
        const int k = j + i * nj;
        if (k >= 32) return false;
        const int pm = (k >> 2) * 8 + x, pn = k & 3;
        u.A = yn + (size_t)pm * 256 * 2048;
        u.B = wt + (size_t)pn * 256 * 2048;
        u.B1 = u.B + (size_t)128 * 2048;
        u.O = y + (size_t)pm * 256 * 1024 + pn * 256;
        u.ldc = 1024; u.valid = 256; u.aux = 0;
        return true;
    }
};
DI void phase3(const Params& P, char* lds, int tid) {
    char* ws = P.ws;
    P3Sched S{ws + OFF_YN, ws + OFF_WOUT_T, (bf16_t*)(ws + OFF_Y), (int)(blockIdx.x & 7), (int)(blockIdx.x >> 3), (int)(gridDim.x >> 3)};
    pg8::EpiStore E;
    pg8::gemm_phase<false>(lds, 1024, S, E, tid);
}

DI void p3b_item(const Params& P, int it, char* lds, int tid, int pass) {
    const int tok0 = it * 64, b = tok0 >> 11;
    const bf16_t* WRT = (const bf16_t*)(P.ws + OFF_WR_T);
    bf16_t* H2 = (bf16_t*)(P.ws + OFF_H2);
    const float* mod = (const float*)(P.ws + OFF_MOD) + b * 6144;
    float* LG = (float*)(lds + P3_LG);
    const int lane = tid & 63, w = __builtin_amdgcn_readfirstlane(tid >> 6), r = lane & 31, h = lane >> 5;
    __syncthreads();
    const bf16_t* Y = (const bf16_t*)(P.ws + OFF_Y);
    const float* pe = (const float*)(P.ws + OFF_PE);
#pragma unroll 1
    for (int rb = 0; rb < 8; rb += 4) {
        float4 xv[4][4];
#pragma unroll
        for (int q = 0; q < 4; ++q) {
            const int tok = tok0 + w * 8 + rb + q, t = tok & 2047;
#pragma unroll
            for (int i2 = 0; i2 < 2; ++i2) {
                const int d = i2 * 512 + lane * 8;
                const float4 xa = *(const float4*)(P.in[0] + (size_t)tok * 1024 + d), xb = *(const float4*)(P.in[0] + (size_t)tok * 1024 + d + 4);
                const uint4 yv = *(const uint4*)(Y + (size_t)tok * 1024 + d);
                const float* pp = i2 ? pe + (t & 63) * 512 + lane * 8 : pe + (t >> 6) * 512 + lane * 8;
                const float4 pa = *(const float4*)pp, pb = *(const float4*)(pp + 4);
                const float4 ga = *(const float4*)(mod + 2048 + d), gb = *(const float4*)(mod + 2048 + d + 4);
                float4 oa, ob;
                oa.x = xa.x + pa.x + ga.x * bflo(yv.x); oa.y = xa.y + pa.y + ga.y * bfhi(yv.x);
                oa.z = xa.z + pa.z + ga.z * bflo(yv.y); oa.w = xa.w + pa.w + ga.w * bfhi(yv.y);
                ob.x = xb.x + pb.x + gb.x * bflo(yv.z); ob.y = xb.y + pb.y + gb.y * bfhi(yv.z);
                ob.z = xb.z + pb.z + gb.z * bflo(yv.w); ob.w = xb.w + pb.w + gb.w * bfhi(yv.w);
                *(float4*)(P.out + (size_t)tok * 1024 + d) = oa;
                *(float4*)(P.out + (size_t)tok * 1024 + d + 4) = ob;
                xv[q][2 * i2] = oa;
                xv[q][2 * i2 + 1] = ob;
            }
        }
        float ss[4];
#pragma unroll
        for (int q = 0; q < 4; ++q) {
            ss[q] = 0.f;
#pragma unroll
            for (int i = 0; i < 4; ++i) ss[q] += xv[q][i].x * xv[q][i].x + xv[q][i].y * xv[q][i].y + xv[q][i].z * xv[q][i].z + xv[q][i].w * xv[q][i].w;
        }
#pragma unroll
        for (int o = 32; o > 0; o >>= 1)
#pragma unroll
            for (int q = 0; q < 4; ++q) ss[q] += shx(ss[q], o, lane);
#pragma unroll
        for (int i2 = 0; i2 < 2; ++i2) {
            const int d = i2 * 512 + lane * 8;
            float gm[8], shf[8];
#pragma unroll
            for (int hh = 0; hh < 2; ++hh) {
                const float4 gn = *(const float4*)(P.in[28] + d + 4 * hh), s2v = *(const float4*)(mod + 4096 + d + 4 * hh), shv = *(const float4*)(mod + 3072 + d + 4 * hh);
                gm[4 * hh + 0] = gn.x * (1.f + s2v.x); gm[4 * hh + 1] = gn.y * (1.f + s2v.y); gm[4 * hh + 2] = gn.z * (1.f + s2v.z); gm[4 * hh + 3] = gn.w * (1.f + s2v.w);
                shf[4 * hh + 0] = shv.x; shf[4 * hh + 1] = shv.y; shf[4 * hh + 2] = shv.z; shf[4 * hh + 3] = shv.w;
            }
#pragma unroll
            for (int q = 0; q < 4; ++q) {
                const int row = w * 8 + rb + q;
                const float rs = rsqrtf(ss[q] * (1.f / 1024.f) + 1e-6f);
                const float4 a = xv[q][2 * i2], bq = xv[q][2 * i2 + 1];
                uint4 pk;
                pk.x = pack2(a.x * rs * gm[0] + shf[0], a.y * rs * gm[1] + shf[1]);
                pk.y = pack2(a.z * rs * gm[2] + shf[2], a.w * rs * gm[3] + shf[3]);
                pk.z = pack2(bq.x * rs * gm[4] + shf[4], bq.y * rs * gm[5] + shf[5]);
                pk.w = pack2(bq.z * rs * gm[6] + shf[6], bq.w * rs * gm[7] + shf[7]);
                *(uint4*)(H2 + (size_t)(tok0 + row) * 1024 + d) = pk;
                *(uint4*)(lds + P3_A + row * P3_AROW + d * 2) = pk;
            }
        }
    }
    __syncthreads();
    if (w < 4) {
        const int mi = w >> 1, ni = w & 1;
        f32x16 lg;
#pragma unroll
        for (int e = 0; e < 16; ++e) lg[e] = 0.f;
        const bf16_t* wr = WRT + (size_t)(32 * ni + r) * 1024 + 8 * h;
        const char* ar = lds + P3_A + (32 * mi + r) * P3_AROW + 16 * h;
#pragma unroll 8
        for (int ks = 0; ks < 64; ++ks) {
            const bf16x8 fa = *(const bf16x8*)(ar + ks * 32);
            const bf16x8 fbb = *(const bf16x8*)(wr + ks * 16);
            lg = MFMA32(fa, fbb, lg);
        }
        const int nn = 32 * ni + r;
        const float bias = (nn < 4) ? P.in[30][nn] : ((nn < 36) ? P.in[32][nn - 4] : 0.f);
#pragma unroll
        for (int e = 0; e < 16; ++e) LG[(32 * mi + crow(e, h)) * 64 + nn] = lg[e] + bias;
    }
    __syncthreads();
    int* lcnt = (int*)(lds + P3_RED);
    int* lbase = lcnt + 32;
    if (tid < 32) lcnt[tid] = 0;
    __syncthreads();
    int ex0 = 0, ex1 = 0, r0 = 0, r1 = 0;
    float w0 = 0.f, w1 = 0.f;
    if (tid < 64 && pass == 0) {
        const float* l = LG + tid * 64;
        int gi = 0;
        float gmx = l[0];
        for (int j = 1; j < 4; ++j) if (l[j] > gmx) { gmx = l[j]; gi = j; }
        float gs = 0.f;
        for (int j = 0; j < 4; ++j) gs += __expf(l[j] - gmx);
        const float gp = 1.f / gs;
        const float* el = l + 4 + gi * 8;
        int e0 = 0;
        float m0 = el[0];
        for (int j = 1; j < 8; ++j) if (el[j] > m0) { m0 = el[j]; e0 = j; }
        int e1 = 0;
        float m1 = -1e30f;
        for (int j = 0; j < 8; ++j) if (j != e0 && el[j] > m1) { m1 = el[j]; e1 = j; }
        const float p1 = __expf(m1 - m0);
        w0 = gp / (1.f + p1);
        w1 = gp * p1 / (1.f + p1);
        ex0 = gi * 8 + e0;
        ex1 = gi * 8 + e1;
        r0 = atomicAdd(&lcnt[ex0], 1);
        r1 = atomicAdd(&lcnt[ex1], 1);
    }
    __syncthreads();
    if (tid < 32 && pass == 0) {
        const int c = lcnt[tid];
        unsigned* cnt = (unsigned*)(P.ws + OFF_CTL) + CNT_WORD;
        lbase[tid] = (c > 0) ? (int)atomicAdd(&cnt[tid * 64], (unsigned)c) : 0;
    }
    __syncthreads();
    if (tid < 64 && pass == 0) {
        const int tok = tok0 + tid;
        unsigned* LIST = (unsigned*)(P.ws + OFF_LIST);
        unsigned* TS = (unsigned*)(P.ws + OFF_TOKSLOT);
        float* EW = (float*)(P.ws + OFF_EW);
        const unsigned p0 = (unsigned)(lbase[ex0] + r0), p1i = (unsigned)(lbase[ex1] + r1);
        LIST[ex0 * 16384 + p0] = tok * 2;
        TS[tok * 2] = ((unsigned)ex0 << 16) | p0;
        EW[tok * 2] = w0;
        LIST[ex1 * 16384 + p1i] = tok * 2 + 1;
        TS[tok * 2 + 1] = ((unsigned)ex1 << 16) | p1i;
        EW[tok * 2 + 1] = w1;
    }
}
DI void phase3b(const Params& P, char* lds, int tid, int pass) {
    for (int it = blockIdx.x; it < NL_ / 64; it += gridDim.x) p3b_item(P, it, lds, tid, pass);
}

#define MISC_TB 16
#define MISC_SB 56
#define MISC_CNT 96
DI void moe_tables(const Params& P, volatile unsigned* misc, int tid) {
    __syncthreads();
    if (tid == 0) {
        unsigned* cnt = (unsigned*)(P.ws + OFF_CTL) + CNT_WORD;
        unsigned t = 0, sb = 0;
        for (int e = 0; e < 32; ++e) {
            const unsigned c = __hip_atomic_load(&cnt[e * 64], __ATOMIC_RELAXED, __HIP_MEMORY_SCOPE_AGENT);
            misc[MISC_TB + e] = t;
            misc[MISC_SB + e] = sb;
            misc[MISC_CNT + e] = c;
            t += (c + 255u) >> 8;
            sb += c;
        }
        misc[MISC_TB + 32] = t;
    }
    __syncthreads();
}

struct MoeTile { int e, mt, ntile, valid, pos0; };
DI int moe_label_items(volatile unsigned* misc, int x) {
    int n = 0;
#pragma unroll
    for (int q = 0; q < 4; ++q) n += (int)((misc[MISC_CNT + x + 8 * q] + 255u) >> 8);
    return n * 8;
}
DI MoeTile moe_tile(volatile unsigned* misc, int x, int k) {
    MoeTile t;
    int mtg = k >> 3;
    t.ntile = k & 7;
    int e = x;
    bool more = true;
#pragma unroll
    for (int q = 0; q < 3; ++q) {
        const int tiles = (int)((misc[MISC_CNT + e] + 255u) >> 8);
        if (more && mtg >= tiles) { mtg -= tiles; e += 8; } else more = false;
    }
    t.e = e;
    t.mt = mtg;
    t.valid = min(256, (int)misc[MISC_CNT + e] - mtg * 256);
    t.pos0 = (int)misc[MISC_SB + e] + mtg * 256;
    return t;
}
struct EpiAct {
    DI void operator()(const pg8::f32x4r (&acc)[2][2][4][2], const pg8::GUnit& u, int wr, int wc, int fr, int fq, char* lds) const {
        asm volatile("" : "+v"(fr), "+v"(fq));
#pragma unroll
        for (int ai = 0; ai < 2; ++ai)
#pragma unroll
            for (int m = 0; m < 4; ++m) {
                const int r = ai * 128 + wr * 64 + m * 16 + fr;
                if (r < u.valid) {
                    float a[8];
#pragma unroll
                    for (int n = 0; n < 2; ++n)
#pragma unroll
                        for (int k = 0; k < 4; ++k) {
                            const float gt = acc[ai][0][m][n][k], up = acc[ai][1][m][n][k];
                            a[4 * n + k] = gt * __builtin_amdgcn_rcpf(1.f + __expf(-gt)) * up;
                        }
                    u32x4 w;
                    w.x = pg8::cvt_pk_bf16(a[0], a[1]); w.y = pg8::cvt_pk_bf16(a[2], a[3]); w.z = pg8::cvt_pk_bf16(a[4], a[5]); w.w = pg8::cvt_pk_bf16(a[6], a[7]);
                    *(u32x4*)(u.O + (size_t)r * u.ldc + wc * 32 + 8 * fq) = w;
                }
            }
    }
};
struct P4Sched {
    const char* h2; const char* wg; const char* wu; bf16_t* act; const unsigned* list; int x, j, nj, total;
    int c0, c1, c2, c3, b0, b1, b2, b3;
    int r0, cb0, r1, cb1;
    DI bool next(int i, pg8::GUnit& u) const {
        const int k = j + i * nj;
        if (k >= total) return false;
        int mtg = k >> 2;
        const int nu = k & 3;
        const int t0 = (c0 + 255) >> 8, t1 = (c1 + 255) >> 8, t2 = (c2 + 255) >> 8;
        int q = 0, c = c0, b = b0;
        if (mtg >= t0) {
            mtg -= t0; q = 1; c = c1; b = b1;
            if (mtg >= t1) {
                mtg -= t1; q = 2; c = c2; b = b2;
                if (mtg >= t2) { mtg -= t2; q = 3; c = c3; b = b3; }
            }
        }
        const int e = x + 8 * q, pos0 = b + mtg * 256;
        u.A = h2;
        u.B = wg + (size_t)(e * 512 + nu * 128) * 2048;
        u.B1 = wu + (size_t)(e * 512 + nu * 128) * 2048;
        u.O = act + (size_t)pos0 * 512 + nu * 128;
        u.ldc = 512;
        u.valid = min(256, c - mtg * 256);
        u.aux = pos0;
        const unsigned* lp = list + e * 16384 + mtg * 256;
        const int vm = u.valid - 1;
        u.ga[0][0] = h2 + (size_t)(lp[min(r0, vm)] >> 1) * 2048 + cb0;
        u.ga[0][1] = h2 + (size_t)(lp[min(r1, vm)] >> 1) * 2048 + cb1;
        u.ga[1][0] = h2 + (size_t)(lp[min(128 + r0, vm)] >> 1) * 2048 + cb0;
        u.ga[1][1] = h2 + (size_t)(lp[min(128 + r1, vm)] >> 1) * 2048 + cb1;
        return true;
    }
};
DI void phase4(const Params& P, char* lds, int tid, volatile unsigned* misc) {
    moe_tables(P, misc, tid);
    {
        const int p = blockIdx.x * 128 + tid;
        if (tid < 128 && p < 2 * NL_) {
            int e = 0;
            for (int q = 1; q < 32; ++q) e = ((int)misc[MISC_SB + q] <= p) ? q : e;
            const unsigned slot = ((const unsigned*)(P.ws + OFF_LIST))[e * 16384 + (p - (int)misc[MISC_SB + e])];
            ((float*)(P.ws + OFF_EWS))[p] = ((const float*)(P.ws + OFF_EW))[slot];
        }
    }
    char* ws = P.ws;
    const int x = (int)(blockIdx.x & 7);
    const int c0 = __builtin_amdgcn_readfirstlane((int)misc[MISC_CNT + x]), c1 = __builtin_amdgcn_readfirstlane((int)misc[MISC_CNT + x + 8]);
    const int c2 = __builtin_amdgcn_readfirstlane((int)misc[MISC_CNT + x + 16]), c3 = __builtin_amdgcn_readfirstlane((int)misc[MISC_CNT + x + 24]);
    const int b0 = __builtin_amdgcn_readfirstlane((int)misc[MISC_SB + x]), b1 = __builtin_amdgcn_readfirstlane((int)misc[MISC_SB + x + 8]);
    const int b2 = __builtin_amdgcn_readfirstlane((int)misc[MISC_SB + x + 16]), b3 = __builtin_amdgcn_readfirstlane((int)misc[MISC_SB + x + 24]);
    const int total = 4 * (((c0 + 255) >> 8) + ((c1 + 255) >> 8) + ((c2 + 255) >> 8) + ((c3 + 255) >> 8));
    int r0, cc0, r1, cc1;
    pg8::stage_piece(tid, 0, r0, cc0);
    pg8::stage_piece(tid, 1, r1, cc1);
    const P4Sched S{ws + OFF_H2, ws + OFF_WG_T, ws + OFF_WU_T, (bf16_t*)(ws + OFF_ACT), (const unsigned*)(ws + OFF_LIST), x, (int)(blockIdx.x >> 3), (int)(gridDim.x >> 3), total,
                    c0, c1, c2, c3, b0, b1, b2, b3, r0, cc0 * 2, r1, cc1 * 2};
    const EpiAct E;
    pg8::gemm_phase<true>(lds, 1024, S, E, tid);
}

struct EpiDown {
    const float* ews;
    DI void operator()(const pg8::f32x4r (&acc)[2][2][4][2], const pg8::GUnit& u, int wr, int wc, int fr, int fq, char* lds) const {
        asm volatile("" : "+v"(fr), "+v"(fq));
#pragma unroll
        for (int ai = 0; ai < 2; ++ai)
#pragma unroll
            for (int m = 0; m < 4; ++m) {
                const int r = ai * 128 + wr * 64 + m * 16 + fr;
                if (r < u.valid) {
                    const float wv = ews[u.aux + r];
                    bf16_t* rowp = u.O + (size_t)r * u.ldc + wc * 32 + 8 * fq;
#pragma unroll
                    for (int bj = 0; bj < 2; ++bj) {
                        const pg8::f32x4r v0 = acc[ai][bj][m][0] * wv, v1 = acc[ai][bj][m][1] * wv;
                        u32x4 w;
                        w.x = pg8::cvt_pk_bf16(v0[0], v0[1]); w.y = pg8::cvt_pk_bf16(v0[2], v0[3]); w.z = pg8::cvt_pk_bf16(v1[0], v1[1]); w.w = pg8::cvt_pk_bf16(v1[2], v1[3]);
                        *(u32x4*)(rowp + bj * 128) = w;
                    }
                }
                asm volatile("" ::: "memory");
            }
    }
};
struct P5Sched {
    const char* act; const char* wd; bf16_t* slot; int x, j, nj, total;
    int c0, c1, c2, c3, b0, b1, b2, b3;
    DI bool next(int i, pg8::GUnit& u) const {
        const int k = j + i * nj;
        if (k >= total) return false;
        int mtg = k >> 2;
        const int pn = k & 3;
        const int t0 = (c0 + 255) >> 8, t1 = (c1 + 255) >> 8, t2 = (c2 + 255) >> 8;
        int q = 0, c = c0, b = b0;
        if (mtg >= t0) {
            mtg -= t0; q = 1; c = c1; b = b1;
            if (mtg >= t1) {
                mtg -= t1; q = 2; c = c2; b = b2;
                if (mtg >= t2) { mtg -= t2; q = 3; c = c3; b = b3; }
            }
        }
        const int e = x + 8 * q, pos0 = b + mtg * 256;
        u.A = act + (size_t)pos0 * 1024;
        u.B = wd + (size_t)(e * 1024 + pn * 256) * 1024;
        u.B1 = u.B + (size_t)128 * 1024;
        u.O = slot + (size_t)pos0 * 1024 + pn * 256;
        u.ldc = 1024;
        u.valid = min(256, c - mtg * 256);
        u.aux = pos0;
        return true;
    }
};
DI void phase5(const Params& P, char* lds, int tid, volatile unsigned* misc) {
    char* ws = P.ws;
    const int x = (int)(blockIdx.x & 7);
    const int c0 = __builtin_amdgcn_readfirstlane((int)misc[MISC_CNT + x]), c1 = __builtin_amdgcn_readfirstlane((int)misc[MISC_CNT + x + 8]);
    const int c2 = __builtin_amdgcn_readfirstlane((int)misc[MISC_CNT + x + 16]), c3 = __builtin_amdgcn_readfirstlane((int)misc[MISC_CNT + x + 24]);
    const int b0 = __builtin_amdgcn_readfirstlane((int)misc[MISC_SB + x]), b1 = __builtin_amdgcn_readfirstlane((int)misc[MISC_SB + x + 8]);
    const int b2 = __builtin_amdgcn_readfirstlane((int)misc[MISC_SB + x + 16]), b3 = __builtin_amdgcn_readfirstlane((int)misc[MISC_SB + x + 24]);
    const int total = 4 * (((c0 + 255) >> 8) + ((c1 + 255) >> 8) + ((c2 + 255) >> 8) + ((c3 + 255) >> 8));
    const P5Sched S{ws + OFF_ACT, ws + OFF_WD_T, (bf16_t*)(ws + OFF_SLOT), x, (int)(blockIdx.x >> 3), (int)(gridDim.x >> 3), total, c0, c1, c2, c3, b0, b1, b2, b3};
    const EpiDown E{(const float*)(ws + OFF_EWS)};
    pg8::gemm_phase<false>(lds, 512, S, E, tid);
}

DI void phase6(const Params& P, int tid, volatile unsigned* misc, bool dummy) {
    const bf16_t* SLOT = (const bf16_t*)(P.ws + OFF_SLOT);
    const unsigned* TS = (const unsigned*)(P.ws + OFF_TOKSLOT);
    const float* modb = (const float*)(P.ws + OFF_MOD);
    const int lane = tid & 63, w = tid >> 6;
    for (int it = blockIdx.x; it < NL_ / 8; it += gridDim.x) {
        const int tok = it * 8 + w;
        const float* g2 = modb + (tok >> 11) * 6144 + 5120;
        const unsigned t0 = TS[tok * 2], t1 = TS[tok * 2 + 1];
        const bf16_t* s0 = SLOT + (size_t)(misc[MISC_SB + (t0 >> 16)] + (t0 & 0xffffu)) * 1024;
        const bf16_t* s1 = SLOT + (size_t)(misc[MISC_SB + (t1 >> 16)] + (t1 & 0xffffu)) * 1024;
        float* xo = P.out + (size_t)tok * 1024;
        float* xw = dummy ? (float*)(P.ws + OFF_H1) + (size_t)tok * 1024 : xo;
        float v[16];
        float ss = 0.f;
#pragma unroll
        for (int i = 0; i < 4; ++i) {
            const int d = i * 256 + lane * 4;
            const float4 xv = *(const float4*)(xo + d);
            const float4 gv = *(const float4*)(g2 + d);
            const uint2 a = *(const uint2*)(s0 + d), bq = *(const uint2*)(s1 + d);
            v[i * 4 + 0] = xv.x + gv.x * (bflo(a.x) + bflo(bq.x));
            v[i * 4 + 1] = xv.y + gv.y * (bfhi(a.x) + bfhi(bq.x));
            v[i * 4 + 2] = xv.z + gv.z * (bflo(a.y) + bflo(bq.y));
            v[i * 4 + 3] = xv.w + gv.w * (bfhi(a.y) + bfhi(bq.y));
            ss += v[i * 4] * v[i * 4] + v[i * 4 + 1] * v[i * 4 + 1] + v[i * 4 + 2] * v[i * 4 + 2] + v[i * 4 + 3] * v[i * 4 + 3];
        }
#pragma unroll
        for (int o = 32; o > 0; o >>= 1) ss += shx(ss, o, lane);
        const float rstd = rsqrtf(ss * (1.f / 1024.f) + 1e-6f);
#pragma unroll
        for (int i = 0; i < 4; ++i) {
            const int d = i * 256 + lane * 4;
            const float4 fg = *(const float4*)(P.in[36] + d);
            float4 o;
            o.x = v[i * 4 + 0] * rstd * fg.x; o.y = v[i * 4 + 1] * rstd * fg.y;
            o.z = v[i * 4 + 2] * rstd * fg.z; o.w = v[i * 4 + 3] * rstd * fg.w;
            *(float4*)(xw + d) = o;
        }
    }
}

#define NPHASE 10
DI void run_phase(const Params& P, int ph, int pass, int npass, char* lds, int tq, volatile unsigned* misc) {
    if (ph == 0) phase0a(P, lds, tq);
    else if (ph == 1) phase0b(P, lds, tq);
    else if (ph == 2) phase1(P, lds, tq);
    else if (ph == 3) phase2(P, lds, tq, misc, pass);
    else if (ph == 4) phase2b(P, lds, tq);
    else if (ph == 5) phase3(P, lds, tq);
    else if (ph == 6) phase3b(P, lds, tq, pass);
    else if (ph == 7) phase4(P, lds, tq, misc);
    else if (ph == 8) phase5(P, lds, tq, misc);
    else if (ph == 9) phase6(P, tq, misc, pass + 1 < npass);
}
__global__ void __launch_bounds__(NTHR, 2) mk_fwd(Params P, int ph_lo, int ph_hi, int rep_mask) {
    extern __shared__ __attribute__((aligned(16))) char lds[];
    const int tid = threadIdx.x;
    volatile unsigned* misc = (volatile unsigned*)(lds + LDS_MISC);
    if (tid < 256) misc[tid] = 0u;
    __syncthreads();
    XcdBarrier bar = xcd_barrier_post((unsigned*)(P.ws + OFF_CTL), misc);
#ifdef PROBE_PH
    unsigned long long pt0 = 0ull, pdt = 0ull;
#define MK_PROBE_BEGIN(k) if ((k) == PROBE_PH) pt0 = __builtin_amdgcn_s_memrealtime();
#define MK_PROBE_END(k) if ((k) == PROBE_PH) pdt = __builtin_amdgcn_s_memrealtime() - pt0;
#define MK_BAR_ALWAYS 1
#else
#define MK_PROBE_BEGIN(k)
#define MK_PROBE_END(k)
#define MK_BAR_ALWAYS 0
#endif
#define MK_PHASE(k)                                                                                           \
    if (ph_lo <= (k) && (k) < ph_hi) {                                                                        \
        const int npass = ((rep_mask >> (k)) & 1) ? 2 : 1;     \
        MK_PROBE_BEGIN(k)                                                                                     \
        for (int pass = 0; pass < npass; ++pass) {                                                            \
            int tq = tid;                                                                                     \
            asm volatile("" : "+v"(tq));                                                                      \
            run_phase(P, (k), pass, npass, lds, tq, misc);                                                    \
            if (MK_BAR_ALWAYS || pass + 1 < npass || (k) + 1 < ph_hi) xcd_barrier(bar);                        \
        }                                                                                                     \
        MK_PROBE_END(k)                                                                                       \
    }
    MK_PHASE(0) MK_PHASE(1) MK_PHASE(2) MK_PHASE(3) MK_PHASE(4) MK_PHASE(5) MK_PHASE(6) MK_PHASE(7) MK_PHASE(8) MK_PHASE(9)
#ifdef EXTRA_BARRIERS
    for (int q = 0; q < EXTRA_BARRIERS; ++q) xcd_barrier(bar);
#endif
#ifdef PROBE_P0
    if (blockIdx.x == PROBE_BLK) {
        const unsigned long long tend = __builtin_amdgcn_s_memrealtime() + 4ull * misc[PROBE_P0];
        while (__builtin_amdgcn_s_memrealtime() < tend) __builtin_amdgcn_s_sleep(20);
    }
#endif
#ifdef PROBE_HY
    if (blockIdx.x == 0) {
        const unsigned long long tend = __builtin_amdgcn_s_memrealtime() + (PROBE_HY > 0 ? (unsigned long long)PROBE_HY * misc[200] : (PROBE_HY == 0 ? (unsigned long long)misc[201] * 2000ull : (unsigned long long)misc[202]));
        while (__builtin_amdgcn_s_memrealtime() < tend) __builtin_amdgcn_s_sleep(20);
    }
#endif
#ifdef PROBE_PH
    if (blockIdx.x == 0) {
        const unsigned long long tend = __builtin_amdgcn_s_memrealtime() + 4ull * pdt;
        while (__builtin_amdgcn_s_memrealtime() < tend) __builtin_amdgcn_s_sleep(20);
    }
#endif
}

extern "C" void kernel_launch(void* const* d_in, const int* in_sizes, int n_in, void* d_out, int out_size, void* d_ws,
                              size_t ws_size, hipStream_t stream) {
    static int grid = 0;
    if (grid == 0) {
        int dev = 0, cus = 0, per_cu = 0;
        hipGetDevice(&dev);
        hipDeviceGetAttribute(&cus, hipDeviceAttributeMultiprocessorCount, dev);
        hipFuncSetAttribute((const void*)mk_fwd, hipFuncAttributeMaxDynamicSharedMemorySize, LDS_BYTES);
        hipOccupancyMaxActiveBlocksPerMultiprocessor(&per_cu, (const void*)mk_fwd, NTHR, LDS_BYTES);
        (void)hipGetLastError();
        grid = (per_cu >= 1 && ws_size >= WS_END && n_in == 37 && (cus % 8) == 0) ? cus : -1;
        if (grid < 0) fprintf(stderr, "kernel_launch: refusing to launch (per_cu %d, ws %zu, n_in %d)\n", per_cu, ws_size, n_in);
    }
    if (grid < 0) return;
    Params P{};
    for (int i = 0; i < 37; ++i) P.in[i] = (const float*)d_in[i];
    P.out = (float*)d_out;
    P.ws = (char*)d_ws;
    char* ws = (char*)d_ws;

    hipMemsetAsync(ws + OFF_CTL, 0, CTL_BYTES, stream);
    hipLaunchKernelGGL(mk_fwd, dim3(grid), dim3(NTHR), LDS_BYTES, stream, P, 0, NPHASE, REP_MASK);
}
```

```cpp
#include <hip/hip_runtime.h>
#include <math.h>
#include <stdint.h>
#include <stdio.h>

#define B_ 8
#define S_ 2048
#define D_ 1024
#define CT_ 256
#define NL_ (B_ * S_)
#define NC_ (B_ * CT_)
#define DIN_ 2560
#define NTHR 512
#ifndef REP_MASK
#define REP_MASK 0
#endif

typedef unsigned short bf16_t;
typedef __attribute__((ext_vector_type(8))) short bf16x8;
typedef __attribute__((ext_vector_type(16))) float f32x16;
typedef __attribute__((ext_vector_type(4))) float f32x4;
typedef __attribute__((ext_vector_type(4))) unsigned u32x4;
#define DI __device__ __forceinline__
#define MFMA32(a, b, c) __builtin_amdgcn_mfma_f32_32x32x16_bf16((a), (b), (c), 0, 0, 0)

DI bf16_t f2bf(float x) {
    unsigned u = __float_as_uint(x);
    u += 0x7fffu + ((u >> 16) & 1u);
    return (bf16_t)(u >> 16);
}
DI float bf2f(bf16_t v) { return __uint_as_float(((unsigned)v) << 16); }
DI unsigned pack2(float lo, float hi) { return (unsigned)f2bf(lo) | ((unsigned)f2bf(hi) << 16); }
DI float sigmoidf_(float x) { return 1.f / (1.f + expf(-x)); }
DI float shx(float v, int mask, int lane) { return __int_as_float(__builtin_amdgcn_ds_bpermute((lane ^ mask) << 2, __float_as_int(v))); }

#define OFF_CTL 0ull
#define CTL_BYTES 65536ull
#define OFF_MOD (OFF_CTL + CTL_BYTES)
#define OFF_PE (OFF_MOD + 262144ull)
#define OFF_HDN2 (OFF_PE + 131072ull)
#define OFF_NRM2 (OFF_HDN2 + 262144ull)
#define OFF_RALL (OFF_NRM2 + 8192ull)
#define OFF_WIN_T (OFF_RALL + 8404992ull)
#define OFF_WOUT_T (OFF_WIN_T + 5242880ull)
#define OFF_WRNN_T (OFF_WOUT_T + 2097152ull)
#define OFF_WR_T (OFF_WRNN_T + 262144ull)
#define OFF_WG_T (OFF_WR_T + 131072ull)
#define OFF_WU_T (OFF_WG_T + 33554432ull)
#define OFF_WD_T (OFF_WU_T + 33554432ull)
#define OFF_PHT (OFF_WD_T + 33554432ull)
#define OFF_PA (OFF_PHT + 50331648ull)
#define OFF_PU (OFF_PA + 16777216ull)
#define OFF_H1 (OFF_PU + 18874368ull)
#define OFF_HS (OFF_H1 + 37748736ull)
#define OFF_YBT (OFF_HS + 33554432ull)
#define OFF_H2 OFF_H1
#define OFF_YN (OFF_H1 + 0ull)
#define OFF_ACT OFF_HS
#define OFF_Y OFF_HS
#define OFF_SLOT OFF_PHT
#define OFF_LIST (OFF_YBT + 16777216ull)
#define OFF_TOKSLOT (OFF_LIST + 2097152ull)
#define OFF_EW (OFF_TOKSLOT + 131072ull)
#define OFF_EWS (OFF_EW + 131072ull)
#define WS_END (OFF_EWS + 131072ull)
#define QUEUE_WORD 4096

struct Params {
    const float* in[37];
    float* out;
    char* ws;
};

#define XB_TMO 128
#define XB_XCNT(j) (256 + 64 * (j))
#define XB_XSUB(j) (1280 + 64 * (j))
#define XB_XGEN(j) (2304 + 64 * (j))
#define XB_TOP 3328
#define XB_TOPGEN 3392
#define XCD_BAR_WORDS 3456
#define XB_SPIN_CAP (1u << 18)

DI unsigned xb_ld(unsigned* p) { return __hip_atomic_load(p, __ATOMIC_RELAXED, __HIP_MEMORY_SCOPE_AGENT); }
DI unsigned xb_add(unsigned* p, unsigned v) { return __hip_atomic_fetch_add(p, v, __ATOMIC_RELAXED, __HIP_MEMORY_SCOPE_AGENT); }
DI unsigned xb_xcc_id() { return (unsigned)__builtin_amdgcn_s_getreg((3 << 11) | 20) & 0xFu; }
#define XB_SPIN(cond, bar)                                                         \
    do {                                                                           \
        unsigned _sp = 0;                                                          \
        while (cond) {                                                             \
            __builtin_amdgcn_s_sleep(1);                                           \
            if ((++_sp & 255u) == 0u) {                                            \
                if (xb_ld(&(bar)[XB_TMO])) break;                                  \
                if (_sp > XB_SPIN_CAP) { atomicAdd(&(bar)[XB_TMO], 1u); break; }   \
            }                                                                      \
        }                                                                          \
    } while (0)

struct XcdBarrier {
    unsigned* bar;
    unsigned x;
    volatile unsigned* st;
};
DI XcdBarrier xcd_barrier_post(unsigned* bar, volatile unsigned* st) {
    XcdBarrier b;
    b.bar = bar;
    b.x = xb_xcc_id();
    b.st = st;
    if (threadIdx.x == 0) (void)xb_add(&bar[XB_XCNT(b.x)], 1u);
    return b;
}
DI void xcd_barrier_complete(unsigned* bar, unsigned x, unsigned& nloc, unsigned& nx) {
    const unsigned G = gridDim.x * gridDim.y * gridDim.z;
    unsigned sum, cnt, mine, sp = 0u;
    for (;;) {
        sum = 0u; cnt = 0u; mine = 0u;
#pragma unroll
        for (unsigned j = 0; j < 16; ++j) {
            const unsigned c = xb_ld(&bar[XB_XCNT(j)]);
            sum += c;
            cnt += (c > 0u) ? 1u : 0u;
            mine = (j == x) ? c : mine;
        }
        if (sum == G) break;
        __builtin_amdgcn_s_sleep(1);
        if ((++sp & 255u) == 0u) {
            if (xb_ld(&bar[XB_TMO])) break;
            if (sp > XB_SPIN_CAP) { atomicAdd(&bar[XB_TMO], 1u); break; }
        }
    }
    nloc = mine > 0u ? mine : 1u;
    nx = cnt > 0u ? cnt : 1u;
}
DI void xcd_barrier(const XcdBarrier& b) {
    asm volatile("s_waitcnt vmcnt(0)" ::: "memory");
    __syncthreads();
    if (threadIdx.x == 0) {
        unsigned* bar = b.bar;
        __builtin_amdgcn_s_waitcnt(0);
        unsigned nloc = b.st[0], nx = b.st[1];
        if (nloc == 0u) {
            xcd_barrier_complete(bar, b.x, nloc, nx);
            b.st[0] = nloc;
            b.st[1] = nx;
        }
        const unsigned old = xb_add(&bar[XB_XSUB(b.x)], 1u);
        const unsigned gen = old / nloc;
        if (old + 1u == (gen + 1u) * nloc) {
            __builtin_amdgcn_fence(__ATOMIC_RELEASE, "agent");
            asm volatile("s_waitcnt vmcnt(0)" ::: "memory");
            const unsigned og = xb_add(&bar[XB_TOP], 1u);
            const unsigned tg = og / nx;
            if (og + 1u == (tg + 1u) * nx) xb_add(&bar[XB_TOPGEN], 1u);
            else XB_SPIN(xb_ld(&bar[XB_TOPGEN]) == tg, bar);
            __builtin_amdgcn_fence(__ATOMIC_ACQUIRE, "agent");
            xb_add(&bar[XB_XGEN(b.x)], 1u);
            asm volatile("s_waitcnt vmcnt(0)" ::: "memory");
        } else {
            XB_SPIN(xb_ld(&bar[XB_XGEN(b.x)]) == gen, bar);
            __builtin_amdgcn_fence(__ATOMIC_ACQUIRE, "agent");
            asm volatile("s_waitcnt vmcnt(0)" ::: "memory");
        }
    }
    __syncthreads();
}

#define LDS_BYTES 163840
#define LDS_MISC (LDS_BYTES - 1024)
#define LROW 144
#define A_STAGE (256 * LROW)
#define B_STAGE (128 * LROW)
#define STAGE_BYTES (A_STAGE + B_STAGE)

DI void conv_tile(const float* src, int ld_src, bf16_t* dst, int ld_dst, const float* rowscale, float* l, int tid) {
    __syncthreads();
    {
        int r = tid >> 3, c0 = (tid & 7) * 8;
        const float4* s = (const float4*)(src + (size_t)r * ld_src + c0);
        float4 v0 = s[0], v1 = s[1];
        float sc = rowscale ? rowscale[r] : 1.f;
        float* d = l + r * 65 + c0;
        d[0] = v0.x * sc; d[1] = v0.y * sc; d[2] = v0.z * sc; d[3] = v0.w * sc;
        d[4] = v1.x * sc; d[5] = v1.y * sc; d[6] = v1.z * sc; d[7] = v1.w * sc;
    }
    __syncthreads();
    {
        int n = tid >> 3, k0 = (tid & 7) * 8;
        uint4 o;
        o.x = pack2(l[(k0 + 0) * 65 + n], l[(k0 + 1) * 65 + n]);
        o.y = pack2(l[(k0 + 2) * 65 + n], l[(k0 + 3) * 65 + n]);
        o.z = pack2(l[(k0 + 4) * 65 + n], l[(k0 + 5) * 65 + n]);
        o.w = pack2(l[(k0 + 6) * 65 + n], l[(k0 + 7) * 65 + n]);
        *(uint4*)(dst + (size_t)n * ld_dst + k0) = o;
    }
}

#define NCONV_RNN 32
DI void conv_item(const Params& P, int it, char* lds, int tid) {
    float* l = (float*)lds;
    const int hh = it & 7, gate = (it >> 3) & 1, dir = it >> 4;
    const float* src = (gate ? P.in[12] : P.in[10]) + (size_t)(dir * 8 + hh) * 4096;
    conv_tile(src, 64, (bf16_t*)(P.ws + OFF_WRNN_T) + (size_t)(hh * 256 + (dir * 2 + gate) * 64) * 64, 64, nullptr, l, tid);
}

#define NG_WIN 160
#define NG_WOUT 64
#define NG_EXP 1024
#define NG_TOTAL (NG_WIN + NG_WOUT + 3 * NG_EXP)
#define CV_LD 257
struct ConvDesc { const float* src; bf16_t* dst; const float* rs; int ld_src, ld_dst; };
DI ConvDesc conv_desc(const Params& P, int g) {
    ConvDesc d;
    d.rs = nullptr;
    if (g < NG_WIN) {
        const int kt = g / 10, ng = g % 10;
        d.src = P.in[7] + (size_t)kt * 64 * DIN_ + ng * 256; d.ld_src = DIN_;
        d.dst = (bf16_t*)(P.ws + OFF_WIN_T) + (size_t)ng * 256 * 1024 + kt * 64; d.ld_dst = 1024;
    } else if (g < NG_WIN + NG_WOUT) {
        g -= NG_WIN;
        const int kt = g >> 2, ng = g & 3;
        d.src = P.in[27] + (size_t)kt * 64 * 1024 + ng * 256; d.ld_src = 1024;
        d.dst = (bf16_t*)(P.ws + OFF_WOUT_T) + (size_t)ng * 256 * 1024 + kt * 64; d.ld_dst = 1024;
        d.rs = (kt < 8) ? P.in[25] + kt * 64 : P.in[26] + (kt - 8) * 64;
    } else {
        g -= NG_WIN + NG_WOUT;
        const int which = g >> 10, rem0 = g & 1023, e = rem0 >> 5, rem = rem0 & 31;
        if (which < 2) {
            const int kt = rem >> 1, ng = rem & 1;
            d.src = P.in[33 + which] + (size_t)e * 1024 * 512 + (size_t)kt * 64 * 512 + ng * 256; d.ld_src = 512;
            d.dst = (bf16_t*)(P.ws + (which ? OFF_WU_T : OFF_WG_T)) + (size_t)(e * 512 + ng * 256) * 1024 + kt * 64; d.ld_dst = 1024;
        } else {
            const int kt = rem >> 2, ng = rem & 3;
            d.src = P.in[35] + (size_t)e * 512 * 1024 + (size_t)kt * 64 * 1024 + ng * 256; d.ld_src = 1024;
            d.dst = (bf16_t*)(P.ws + OFF_WD_T) + (size_t)(e * 1024 + ng * 256) * 512 + kt * 64; d.ld_dst = 512;
        }
    }
    return d;
}
DI void conv_load(const ConvDesc& d, float4 (&r)[8], int tid) {
#pragma unroll
    for (int i = 0; i < 8; ++i) {
        const int q = tid + NTHR * i;
        r[i] = *(const float4*)(d.src + (size_t)(q >> 6) * d.ld_src + (q & 63) * 4);
    }
}
DI void conv_groups(const Params& P, int g0, int g1, int stride, char* lds, int tid) {
    float* l = (float*)lds;
    float4 r[8];
    int g = g0;
    ConvDesc d;
    if (g < g1) { d = conv_desc(P, g); conv_load(d, r, tid); }
    while (g < g1) {
        __syncthreads();
#pragma unroll
        for (int i = 0; i < 8; ++i) {
            const int q = tid + NTHR * i, row = q >> 6, c = (q & 63) * 4;
            const float sc = d.rs ? d.rs[row] : 1.f;
            float* p = l + row * CV_LD + c;
            p[0] = r[i].x * sc; p[1] = r[i].y * sc; p[2] = r[i].z * sc; p[3] = r[i].w * sc;
        }
        const ConvDesc dc = d;
        const int gn = g + stride;
        if (gn < g1) { d = conv_desc(P, gn); conv_load(d, r, tid); }
        __syncthreads();
#pragma unroll
        for (int i = 0; i < 4; ++i) {
            const int q = tid + NTHR * i, n = q >> 3, k0 = (q & 7) * 8;
            const float* p = l + k0 * CV_LD + n;
            uint4 o;
            o.x = pack2(p[0], p[CV_LD]);
            o.y = pack2(p[2 * CV_LD], p[3 * CV_LD]);
            o.z = pack2(p[4 * CV_LD], p[5 * CV_LD]);
            o.w = pack2(p[6 * CV_LD], p[7 * CV_LD]);
            *(uint4*)(dc.dst + (size_t)n * dc.ld_dst + k0) = o;
        }
        g = gn;
    }
}

DI void mod_item(const Params& P, int it, char* lds, int tid) {
    float* sl = (float*)lds;
    float* red = sl + 9 * 1024;
    __syncthreads();
    for (int i = tid; i < 9 * 1024; i += NTHR) {
        int r = i >> 10, k = i & 1023;
        float v = (r < 8) ? P.in[1][r * 1024 + k] : P.in[3][k];
        sl[i] = v * __builtin_amdgcn_rcpf(1.f + __expf(-v));
    }
    __syncthreads();
    const int w = tid >> 6, lane = tid & 63, col = lane & 31, kp = lane >> 5;
    const int n0 = it * 32;
    const float* wa = P.in[4] + n0 + col;
    float acc[9];
#pragma unroll
    for (int r = 0; r < 9; ++r) acc[r] = 0.f;
#pragma unroll 1
    for (int i0 = 0; i0 < 64; i0 += 32) {
        float wv[32];
#pragma unroll
        for (int q = 0; q < 32; ++q) wv[q] = wa[(size_t)(w * 128 + 2 * (i0 + q) + kp) * 6144];
#pragma unroll
        for (int q = 0; q < 32; ++q) {
            const int k = w * 128 + 2 * (i0 + q) + kp;
#pragma unroll
            for (int r = 0; r < 9; ++r) acc[r] += sl[r * 1024 + k] * wv[q];
        }
    }
#pragma unroll
    for (int r = 0; r < 9; ++r) {
        acc[r] += shx(acc[r], 32, lane);
        if (kp == 0) red[(w * 9 + r) * 32 + col] = acc[r];
    }
    __syncthreads();
    if (tid < 9 * 32) {
        int r = tid >> 5, c = tid & 31;
        float s = P.in[5][n0 + c];
#pragma unroll
        for (int ww = 0; ww < 8; ++ww) s += red[(ww * 9 + r) * 32 + c];
        ((float*)(P.ws + OFF_MOD))[r * 6144 + n0 + c] = s;
    }
}

DI void pe_item(const Params& P, int it, int tid) {
    int p = it, i = tid & 255;
    float omega = 1.0f / powf(10000.0f, (float)i / 256.0f);
    float ang = (float)p * omega;
    ((float*)(P.ws + OFF_PE))[p * 512 + tid] = (tid < 256) ? sinf(ang) : cosf(ang);
}

DI void hdn_item(const Params& P, int it, char* lds, int tid) {
    const int w = tid >> 6, j = tid & 63;
    float* w1s = (float*)lds;
    float* w2s = w1s + 33 * 64;
    float* zz = w2s + 64 * 64 + w * 128;
    float* h1s = zz + 64;
    __syncthreads();
    for (int i = tid; i < 33 * 64; i += NTHR) w1s[i] = P.in[16][i];
    for (int i = tid; i < 64 * 64; i += NTHR) w2s[i] = P.in[19][i];
    const float b1 = P.in[17][j], f1 = P.in[18][j], b2 = P.in[20][j], f2 = P.in[21][j];
    __syncthreads();
    for (int q = 0; q < 8; ++q) {
        const int t = it * 64 + w * 8 + q;
        if (j < 33) {
            float val;
            if (j == 0) val = (float)t / 2047.f;
            else {
                int bi = (j - 1) & 15;
                float freq = 1e-4f + (float)bi * ((15.f - 1e-4f) / 15.f);
                float ang = (6.283185307179586f * (float)t / 2048.f) * freq;
                val = (j <= 16) ? cosf(ang) : -sinf(ang);
            }
            zz[j] = val;
        }
        float acc = b1;
#pragma unroll 11
        for (int i = 0; i < 33; ++i) acc += zz[i] * w1s[i * 64 + j];
        h1s[j] = sinf(f1 * acc);
        acc = b2;
#pragma unroll 16
        for (int i = 0; i < 64; ++i) acc += h1s[i] * w2s[i * 64 + j];
        ((bf16_t*)(P.ws + OFF_HDN2))[t * 64 + j] = f2bf(sinf(f2 * acc));
    }
}

DI void wr_item(const Params& P, int j, int tid) {
    bf16_t* WRT = (bf16_t*)(P.ws + OFF_WR_T);
    {
        const int k = 16 * j + (tid >> 5), e = tid & 31;
        WRT[(4 + e) * 1024 + k] = f2bf(P.in[31][k * 32 + e]);
    }
    if (tid < 64) {
        const int k = 16 * j + (tid >> 2), n = tid & 3;
        WRT[n * 1024 + k] = f2bf(P.in[29][k * 4 + n]);
    }
    if (tid < 448) WRT[(36 + (tid >> 4)) * 1024 + 16 * j + (tid & 15)] = 0;
}
#define P0A_MOD 192
#define P0A_PE 128
#define P0A_HDN 32
#define P0A_GROUPS 2200
DI void phase0a(const Params& P, char* lds, int tid) {
#ifdef PROBE_P0
    const unsigned long long p0t0 = __builtin_amdgcn_s_memrealtime();
#endif
    const int total = P0A_MOD + P0A_PE + P0A_HDN + NCONV_RNN;
    if (gridDim.x == 256) {
        const int b = blockIdx.x;
        if (b < P0A_MOD) mod_item(P, b, lds, tid);
        else {
            const int j = b - P0A_MOD;
            pe_item(P, j, tid);
            wr_item(P, j, tid);
            if (j < P0A_HDN) hdn_item(P, j, lds, tid); else conv_item(P, j - P0A_HDN, lds, tid);
        }
    } else
    for (int it = blockIdx.x; it < total; it += gridDim.x) {
        if (it < P0A_MOD) mod_item(P, it, lds, tid);
        else if (it < P0A_MOD + P0A_PE) { if (it - P0A_MOD < 64) pe_item(P, it - P0A_MOD, tid); else wr_item(P, it - P0A_MOD - 64, tid); }
        else if (it < P0A_MOD + P0A_PE + P0A_HDN) hdn_item(P, it - P0A_MOD - P0A_PE, lds, tid);
        else conv_item(P, it - (P0A_MOD + P0A_PE + P0A_HDN), lds, tid);
    }
#ifdef PROBE_P0
    const unsigned long long p0t1 = __builtin_amdgcn_s_memrealtime();
#endif
    conv_groups(P, blockIdx.x, P0A_GROUPS, gridDim.x, lds, tid);
#ifdef PROBE_P0
    if (tid == 0) { volatile unsigned* mm = (volatile unsigned*)(lds + LDS_MISC); mm[203] = (unsigned)(p0t1 - p0t0); mm[204] = (unsigned)(__builtin_amdgcn_s_memrealtime() - p0t1); }
#endif
}

DI void h1_item(const Params& P, int it, int tid) {
    const int w = tid >> 6, lane = tid & 63;
    const int row = it * 8 + w;
    const bool lat = row < NL_;
    const float* src = lat ? P.in[0] + (size_t)row * D_ : P.in[2] + (size_t)(row - NL_) * D_;
    const int b = lat ? (row >> 11) : 8;
    const int t = row & 2047;
    const float* mod = (const float*)(P.ws + OFF_MOD) + b * 6144;
    const float* pe = (const float*)(P.ws + OFF_PE);
    const float* g = P.in[6];
    float v[16];
    float ss = 0.f;
#pragma unroll
    for (int i = 0; i < 2; ++i) {
        const int d = i * 512 + lane * 8;
        float4 x0 = *(const float4*)(src + d), x1 = *(const float4*)(src + d + 4);
        if (lat) {
            const float* pp = (i == 0) ? pe + (t >> 6) * 512 + d : pe + (t & 63) * 512 + (d - 512);
            const float4 p0 = *(const float4*)pp, p1 = *(const float4*)(pp + 4);
            x0.x += p0.x; x0.y += p0.y; x0.z += p0.z; x0.w += p0.w;
            x1.x += p1.x; x1.y += p1.y; x1.z += p1.z; x1.w += p1.w;
        }
        v[i * 8 + 0] = x0.x; v[i * 8 + 1] = x0.y; v[i * 8 + 2] = x0.z; v[i * 8 + 3] = x0.w;
        v[i * 8 + 4] = x1.x; v[i * 8 + 5] = x1.y; v[i * 8 + 6] = x1.z; v[i * 8 + 7] = x1.w;
        ss += x0.x * x0.x + x0.y * x0.y + x0.z * x0.z + x0.w * x0.w + x1.x * x1.x + x1.y * x1.y + x1.z * x1.z + x1.w * x1.w;
    }
#pragma unroll
    for (int o = 32; o > 0; o >>= 1) ss += shx(ss, o, lane);
    const float rstd = rsqrtf(ss * (1.f / 1024.f) + 1e-6f);
    bf16_t* dst = (bf16_t*)(P.ws + OFF_H1) + (size_t)row * D_;
#pragma unroll
    for (int i = 0; i < 2; ++i) {
        const int d = i * 512 + lane * 8;
        float o[8];
#pragma unroll
        for (int hh = 0; hh < 2; ++hh) {
            const float4 gv = *(const float4*)(g + d + 4 * hh), sh = *(const float4*)(mod + d + 4 * hh), sc = *(const float4*)(mod + 1024 + d + 4 * hh);
            o[4 * hh + 0] = v[i * 8 + 4 * hh + 0] * rstd * gv.x * (1.f + sc.x) + sh.x;
            o[4 * hh + 1] = v[i * 8 + 4 * hh + 1] * rstd * gv.y * (1.f + sc.y) + sh.y;
            o[4 * hh + 2] = v[i * 8 + 4 * hh + 2] * rstd * gv.z * (1.f + sc.z) + sh.z;
            o[4 * hh + 3] = v[i * 8 + 4 * hh + 3] * rstd * gv.w * (1.f + sc.w) + sh.w;
        }
        *(uint4*)(dst + d) = make_uint4(pack2(o[0], o[1]), pack2(o[2], o[3]), pack2(o[4], o[5]), pack2(o[6], o[7]));
    }
}
#define P0B_H1 ((NL_ + NC_) / 8)
#define P0B_TAPS 64
DI void taps_item(const Params& P, int it, char* lds, int tid);
DI void phase0b(const Params& P, char* lds, int tid) {
#ifdef PROBE_P0
    const unsigned long long p0t0 = __builtin_amdgcn_s_memrealtime();
#endif
    const int total = P0B_TAPS + P0B_H1;
    if (gridDim.x == 256) {
        const int b = blockIdx.x;
        if (b < P0B_TAPS) {
            taps_item(P, b, lds, tid);
            for (int q = 0; q < 3; ++q) h1_item(P, b * 3 + q, tid);
        } else {
            for (int q = 0; q < 11; ++q) h1_item(P, 192 + (b - P0B_TAPS) * 11 + q, tid);
        }
    } else
    for (int it = blockIdx.x; it < total; it += gridDim.x) {
        if (it < P0B_TAPS) taps_item(P, it, lds, tid);
        else h1_item(P, it - P0B_TAPS, tid);
    }
#ifdef PROBE_P0
    const unsigned long long p0t1 = __builtin_amdgcn_s_memrealtime();
#endif
    conv_groups(P, P0A_GROUPS + blockIdx.x, NG_TOTAL, gridDim.x, lds, tid);
#ifdef PROBE_P0
    if (tid == 0) { volatile unsigned* mm = (volatile unsigned*)(lds + LDS_MISC); mm[205] = (unsigned)(p0t1 - p0t0); mm[206] = (unsigned)(__builtin_amdgcn_s_memrealtime() - p0t1); }
#endif
}

namespace pg8 {
typedef f32x4 f32x4r;
#define PG8_LAS __attribute__((address_space(3)))
constexpr int BM = 256, BK = 64, HALF = 128, HTB = HALF * BK * 2, STAGE_BYTES8 = 8 * HTB;
DI int lds_byte(int r, int c) { const int st = (r >> 4) * 2 + (c >> 5), rr = r & 15, cc = c & 31, ob = rr * 64 + cc * 2; return st * 1024 + (ob ^ (((ob >> 9) & 1) << 5)); }
DI void stage_rc(int b, int& R, int& C) { const int st = b / 1024, sb = b % 1024, swz = sb ^ (((sb >> 9) & 1) << 5); R = (st >> 1) * 16 + swz / 64; C = (st & 1) * 32 + (swz % 64) / 2; }
DI int perm32(int rho) { const int n = rho >> 4, i = rho & 15; return 8 * (i >> 2) + 4 * n + (i & 3); }
DI unsigned cvt_pk_bf16(float lo, float hi) { unsigned r; asm volatile("v_cvt_pk_bf16_f32 %0, %1, %2" : "=v"(r) : "v"(lo), "v"(hi)); return r; }

struct GUnit { const char* A; const char* B; const char* B1; bf16_t* O; int ldc, valid, aux; const char* ga[2][2]; };
DI void stage_piece(int tid, int i, int& R, int& C) { stage_rc(tid * 16 + i * 8192, R, C); }

struct EpiStore {
    DI void operator()(const f32x4 (&acc)[2][2][4][2], const GUnit& u, int wr, int wc, int fr, int fq, char* lds) const {
        asm volatile("" : "+v"(fr), "+v"(fq));
#pragma unroll
        for (int ai = 0; ai < 2; ++ai)
#pragma unroll
            for (int m = 0; m < 4; ++m) {
                const int r = ai * HALF + wr * 64 + m * 16 + fr;
                bf16_t* rowp = u.O + (size_t)r * u.ldc + wc * 32 + 8 * fq;
                if (r < u.valid) {
#pragma unroll
                    for (int bj = 0; bj < 2; ++bj) {
                        const f32x4 v0 = acc[ai][bj][m][0], v1 = acc[ai][bj][m][1];
                        u32x4 w;
                        w.x = cvt_pk_bf16(v0[0], v0[1]); w.y = cvt_pk_bf16(v0[2], v0[3]); w.z = cvt_pk_bf16(v1[0], v1[1]); w.w = cvt_pk_bf16(v1[2], v1[3]);
                        *(u32x4*)(rowp + bj * HALF) = w;
                    }
                }
            }
    }
};

template <bool GATHER, class Epi, class Sched>
DI void gemm_phase(char* lds_generic, const int K, const Sched& S, const Epi& E, const int tid) {
    PG8_LAS unsigned char* lds = (PG8_LAS unsigned char*)lds_generic;
    const int wid = __builtin_amdgcn_readfirstlane(tid >> 6), lane = tid & 63, wr = wid >> 2, wc = wid & 3, fr = lane & 15, fq = lane >> 4;
    const int nt = K / BK;
    unsigned voffA[2], voffB[2];
#pragma unroll
    for (int i = 0; i < 2; ++i) {
        int R, C;
        stage_rc(tid * 16 + i * 8192, R, C);
        const int Rb = (R & ~31) + perm32(R & 31);
        voffA[i] = (unsigned)(R * K + C) * 2u;
        voffB[i] = (unsigned)(Rb * K + C) * 2u;
    }
    const size_t kstep = (size_t)(BK * 2);
    const size_t hstep = (size_t)HALF * K * 2;
    const unsigned ldsw = (unsigned)wid * 1024u;
    const int aoff = lds_byte(wr * 64 + fr, fq * 8), boff = lds_byte(wc * 32 + fr, fq * 8);
#define PG8_SA(b, h) (((b) * 2 + (h)) * HTB)
#define PG8_SB(b, h) ((4 + (b) * 2 + (h)) * HTB)
#define PG8_STAGE(bufoff, gbase, voff) do { _Pragma("unroll") for (int _i = 0; _i < 2; ++_i) \
        __builtin_amdgcn_global_load_lds((const unsigned*)((const char*)(gbase) + (voff)[_i]), (PG8_LAS unsigned*)(lds + (bufoff) + ldsw + _i * 8192), 16, 0, 0); } while (0)
#define PG8_STAGE_A(bufoff, uu, ubase, h, kb) do { _Pragma("unroll") for (int _i = 0; _i < 2; ++_i) { \
        const char* _p = GATHER ? (uu).ga[h][_i] + (kb) : (ubase) + (size_t)(h) * hstep + (kb) + voffA[_i]; \
        __builtin_amdgcn_global_load_lds((const unsigned*)_p, (PG8_LAS unsigned*)(lds + (bufoff) + ldsw + _i * 8192), 16, 0, 0); } } while (0)
#define PG8_LDA(dst, b, h) do { _Pragma("unroll") for (int m = 0; m < 4; ++m) _Pragma("unroll") for (int k = 0; k < 2; ++k) dst[m][k] = *(const PG8_LAS bf16x8*)(lds + PG8_SA(b, h) + aoff + m * 2048 + k * 1024); } while (0)
#define PG8_LDB(dst, b, h) do { _Pragma("unroll") for (int n = 0; n < 2; ++n) _Pragma("unroll") for (int k = 0; k < 2; ++k) dst[n][k] = *(const PG8_LAS bf16x8*)(lds + PG8_SB(b, h) + boff + n * 2048 + k * 1024); } while (0)
#define PG8_MMA(ai, bj, At, Bt) do { __builtin_amdgcn_s_setprio(1); _Pragma("unroll") for (int m = 0; m < 4; ++m) _Pragma("unroll") for (int n = 0; n < 2; ++n) _Pragma("unroll") for (int k = 0; k < 2; ++k) \
        acc[ai][bj][m][n] = __builtin_amdgcn_mfma_f32_16x16x32_bf16(Bt[n][k], At[m][k], acc[ai][bj][m][n], 0, 0, 0); __builtin_amdgcn_s_setprio(0); } while (0)
#define PG8_WAIT_V(n) asm volatile("s_waitcnt vmcnt(" #n ")" ::: "memory")
#define PG8_WAIT_L(n) asm volatile("s_waitcnt lgkmcnt(" #n ")" ::: "memory")
#define PG8_BAR __builtin_amdgcn_s_barrier()
#define PG8_SCHED __builtin_amdgcn_sched_barrier(0)
    GUnit cur, nxt;
    int ui = 0;
    if (!S.next(0, cur)) return;
    f32x4 acc[2][2][4][2];
#pragma unroll
    for (int a = 0; a < 2; ++a)
#pragma unroll
        for (int b = 0; b < 2; ++b)
#pragma unroll
            for (int m = 0; m < 4; ++m)
#pragma unroll
                for (int n = 0; n < 2; ++n) acc[a][b][m][n] = (f32x4){0.f, 0.f, 0.f, 0.f};
    bf16x8 At[4][2], B0[2][2], B1[2][2];
    PG8_STAGE(PG8_SB(0, 0), cur.B, voffB); PG8_STAGE_A(PG8_SA(0, 0), cur, cur.A, 0, 0); PG8_STAGE(PG8_SB(0, 1), cur.B1, voffB); PG8_STAGE_A(PG8_SA(0, 1), cur, cur.A, 1, 0);
    if (wr == 1) PG8_BAR;
    PG8_WAIT_V(4); PG8_BAR;
    PG8_STAGE(PG8_SB(1, 0), cur.B + kstep, voffB); PG8_STAGE_A(PG8_SA(1, 0), cur, cur.A, 0, kstep); PG8_STAGE(PG8_SB(1, 1), cur.B1 + kstep, voffB);
    PG8_WAIT_V(6); PG8_BAR;
    for (;;) {
        const bool has_next = S.next(ui + 1, nxt);
        if (!has_next) {
            nxt.A = cur.A; nxt.B = cur.B; nxt.B1 = cur.B1;
            if (GATHER) { nxt.ga[0][0] = cur.ga[0][0]; nxt.ga[0][1] = cur.ga[0][1]; nxt.ga[1][0] = cur.ga[1][0]; nxt.ga[1][1] = cur.ga[1][1]; }
        }
        for (int t = 0; t < nt; t += 2) {
            const bool last = (t == nt - 2);
            const size_t k2 = last ? (size_t)0 : (size_t)(t + 2) * kstep;
            const size_t k1 = (size_t)(t + 1) * kstep, k3 = k2 + kstep;
            struct { const char* A; const char* B; const char* B1; const char* ga[2][2]; } w2;
            w2.A = last ? nxt.A : cur.A; w2.B = last ? nxt.B : cur.B; w2.B1 = last ? nxt.B1 : cur.B1;
            if (GATHER) {
                w2.ga[0][0] = last ? nxt.ga[0][0] : cur.ga[0][0]; w2.ga[0][1] = last ? nxt.ga[0][1] : cur.ga[0][1];
                w2.ga[1][0] = last ? nxt.ga[1][0] : cur.ga[1][0]; w2.ga[1][1] = last ? nxt.ga[1][1] : cur.ga[1][1];
            }
            PG8_LDB(B0, 0, 0); PG8_SCHED; PG8_LDA(At, 0, 0); PG8_STAGE_A(PG8_SA(1, 1), cur, cur.A, 1, k1);
            PG8_WAIT_L(8); PG8_BAR; PG8_WAIT_L(0); PG8_MMA(0, 0, At, B0); PG8_BAR; PG8_SCHED;
            PG8_LDB(B1, 0, 1); PG8_STAGE(PG8_SB(0, 0), w2.B + k2, voffB);
            PG8_BAR; PG8_WAIT_L(0); PG8_MMA(0, 1, At, B1); PG8_BAR;
            PG8_LDA(At, 0, 1); PG8_STAGE_A(PG8_SA(0, 0), w2, w2.A, 0, k2);
            PG8_BAR; PG8_WAIT_L(0); PG8_MMA(1, 0, At, B0); PG8_BAR; PG8_SCHED;
            PG8_STAGE(PG8_SB(0, 1), w2.B1 + k2, voffB);
            PG8_WAIT_V(6); PG8_BAR; PG8_MMA(1, 1, At, B1); PG8_BAR;
            PG8_LDB(B0, 1, 0); PG8_SCHED; PG8_LDA(At, 1, 0); PG8_STAGE_A(PG8_SA(0, 1), w2, w2.A, 1, k2);
            PG8_WAIT_L(8); PG8_BAR; PG8_WAIT_L(0); PG8_MMA(0, 0, At, B0); PG8_BAR; PG8_SCHED;
            PG8_LDB(B1, 1, 1); PG8_STAGE(PG8_SB(1, 0), w2.B + k3, voffB);
            PG8_BAR; PG8_WAIT_L(0); PG8_MMA(0, 1, At, B1); PG8_BAR;
            PG8_LDA(At, 1, 1); PG8_STAGE_A(PG8_SA(1, 0), w2, w2.A, 0, k3);
            PG8_BAR; PG8_WAIT_L(0); PG8_MMA(1, 0, At, B0); PG8_BAR; PG8_SCHED;
            PG8_STAGE(PG8_SB(1, 1), w2.B1 + k3, voffB);
            PG8_WAIT_V(6); PG8_BAR; PG8_MMA(1, 1, At, B1); PG8_BAR;
        }
        E(acc, cur, wr, wc, fr, fq, lds_generic);
        if (!has_next) break;
#pragma unroll
        for (int a = 0; a < 2; ++a)
#pragma unroll
            for (int b = 0; b < 2; ++b)
#pragma unroll
                for (int m = 0; m < 4; ++m)
#pragma unroll
                    for (int n = 0; n < 2; ++n) acc[a][b][m][n] = (f32x4){0.f, 0.f, 0.f, 0.f};
        cur.A = nxt.A; cur.B = nxt.B; cur.B1 = nxt.B1; cur.O = nxt.O; cur.ldc = nxt.ldc; cur.valid = nxt.valid; cur.aux = nxt.aux;
        if (GATHER) { cur.ga[0][0] = nxt.ga[0][0]; cur.ga[0][1] = nxt.ga[0][1]; cur.ga[1][0] = nxt.ga[1][0]; cur.ga[1][1] = nxt.ga[1][1]; }
        ++ui;
    }
    PG8_WAIT_V(0);
    if (wr == 0) PG8_BAR;
    PG8_BAR;
#undef PG8_SA
#undef PG8_SB
#undef PG8_STAGE
#undef PG8_STAGE_A
#undef PG8_LDA
#undef PG8_LDB
#undef PG8_MMA
#undef PG8_WAIT_V
#undef PG8_WAIT_L
#undef PG8_BAR
#undef PG8_SCHED
}
}

struct GPtr { const bf16_t* a[4]; const bf16_t* b[2]; };
#define GC_LOAD(SI, kt_)                                                                                 \
    do {                                                                                                  \
        const int ko_ = (kt_) * 64;                                                                       \
        S[SI][0] = *(const u32x4*)(g.a[0] + ko_); S[SI][1] = *(const u32x4*)(g.a[1] + ko_);               \
        S[SI][2] = *(const u32x4*)(g.a[2] + ko_); S[SI][3] = *(const u32x4*)(g.a[3] + ko_);               \
        S[SI][4] = *(const u32x4*)(g.b[0] + ko_); S[SI][5] = *(const u32x4*)(g.b[1] + ko_);               \
    } while (0)
#define GC_STORE(SI, st_)                                                                                 \
    do {                                                                                                  \
        char* s2_ = lds + (st_) * STAGE_BYTES;                                                            \
        *(u32x4*)(s2_ + a_w) = S[SI][0]; *(u32x4*)(s2_ + a_w + 64 * LROW) = S[SI][1];                      \
        *(u32x4*)(s2_ + a_w + 128 * LROW) = S[SI][2]; *(u32x4*)(s2_ + a_w + 192 * LROW) = S[SI][3];        \
        *(u32x4*)(s2_ + b_w) = S[SI][4]; *(u32x4*)(s2_ + b_w + 64 * LROW) = S[SI][5];                      \
    } while (0)
#define GC_BODY(kt_, SL, SS)                                                                              \
    do {                                                                                                  \
        if ((kt_) + 3 < nk) GC_LOAD(SL, (kt_) + 3);                                                       \
        const char* s_ = lds + ((kt_) & 1) * STAGE_BYTES;                                                 \
        _Pragma("unroll") for (int ks = 0; ks < 4; ++ks) {                                                \
            const bf16x8 fa0 = *(const bf16x8*)(s_ + a_r + ks * 32);                                      \
            const bf16x8 fa1 = *(const bf16x8*)(s_ + a_r + 32 * LROW + ks * 32);                          \
            const bf16x8 fb0 = *(const bf16x8*)(s_ + b_r + ks * 32);                                      \
            const bf16x8 fb1 = *(const bf16x8*)(s_ + b_r + 32 * LROW + ks * 32);                          \
            if (SWAP) {                                                                                   \
                acc[0][0] = MFMA32(fb0, fa0, acc[0][0]); acc[0][1] = MFMA32(fb1, fa0, acc[0][1]);         \
                acc[1][0] = MFMA32(fb0, fa1, acc[1][0]); acc[1][1] = MFMA32(fb1, fa1, acc[1][1]);         \
            } else {                                                                                      \
                acc[0][0] = MFMA32(fa0, fb0, acc[0][0]); acc[0][1] = MFMA32(fa0, fb1, acc[0][1]);         \
                acc[1][0] = MFMA32(fa1, fb0, acc[1][0]); acc[1][1] = MFMA32(fa1, fb1, acc[1][1]);         \
            }                                                                                             \
        }                                                                                                 \
        if ((kt_) + 1 < nk) GC_STORE(SS, ((kt_) + 1) & 1);                                                \
        __syncthreads();                                                                                  \
    } while (0)

DI void gemm_issue(u32x4 (&S)[3][6], const GPtr& g) {
    GC_LOAD(0, 0);
    GC_LOAD(1, 1);
    GC_LOAD(2, 2);
}
template <bool SWAP>
DI void gemm_run(f32x16 (&acc)[2][2], u32x4 (&S)[3][6], const GPtr& g, int nk, char* lds, int tid) {
    const int lrow = tid >> 3, lchunk = tid & 7;
    const unsigned a_w = lrow * LROW + lchunk * 16;
    const unsigned b_w = A_STAGE + lrow * LROW + lchunk * 16;
    const int lane = tid & 63, w = tid >> 6, wm = w >> 1, wn = w & 1, r = lane & 31, h = lane >> 5;
    const unsigned a_r = (wm * 64 + r) * LROW + h * 16;
    const unsigned b_r = A_STAGE + (wn * 64 + r) * LROW + h * 16;
#pragma unroll
    for (int i = 0; i < 2; ++i)
#pragma unroll
        for (int j = 0; j < 2; ++j)
#pragma unroll
            for (int e = 0; e < 16; ++e) acc[i][j][e] = 0.f;
    __syncthreads();
    GC_STORE(0, 0);
    __syncthreads();
    for (int kt = 0; kt < nk; kt += 3) {
        GC_BODY(kt, 0, 1);
        if (kt + 1 < nk) GC_BODY(kt + 1, 1, 2);
        if (kt + 2 < nk) GC_BODY(kt + 2, 2, 0);
    }
}

#define ET_ROW 272
#define ETS_ROW 528
DI void acc_to_lds_tok(const f32x16 (&acc)[2][2], char* lds, int wm, int wn, int r, int h) {
#pragma unroll
    for (int i = 0; i < 2; ++i)
#pragma unroll
        for (int j = 0; j < 2; ++j)
#pragma unroll
            for (int g = 0; g < 4; ++g)
                *(uint2*)(lds + (wm * 64 + i * 32 + r) * ET_ROW + (wn * 64 + j * 32 + 8 * g + 4 * h) * 2) =
                    make_uint2(pack2(acc[i][j][4 * g], acc[i][j][4 * g + 1]), pack2(acc[i][j][4 * g + 2], acc[i][j][4 * g + 3]));
}
DI void acc_to_lds_chan(const f32x16 (&acc)[2][2], char* lds, int wm, int wn, int r, int h) {
#pragma unroll
    for (int i = 0; i < 2; ++i)
#pragma unroll
        for (int j = 0; j < 2; ++j)
#pragma unroll
            for (int g = 0; g < 4; ++g)
                *(uint2*)(lds + (wn * 64 + j * 32 + r) * ETS_ROW + (wm * 64 + i * 32 + 8 * g + 4 * h) * 2) =
                    make_uint2(pack2(acc[i][j][4 * g], acc[i][j][4 * g + 1]), pack2(acc[i][j][4 * g + 2], acc[i][j][4 * g + 3]));
}
DI void lds_to_rows(char* lds, bf16_t* dst, int ld, int valid, int tid) {
#pragma unroll
    for (int i = 0; i < 8; ++i) {
        const int q = tid + NTHR * i, row = q >> 4, ch = q & 15;
        if (row < valid) *(uint4*)(dst + (size_t)row * ld + ch * 8) = *(const uint4*)(lds + row * ET_ROW + ch * 16);
    }
}

struct P1Sched {
    const char* h1; const char* wt; bf16_t* pa; bf16_t* pu; bf16_t* pht; int x, j, nj;
    DI bool next(int i, pg8::GUnit& u) const {
        const int k = j + i * nj;
        if (k >= 82) return false;
        u.valid = 256; u.aux = 0;
        if (k < 32) {
            const int pm = (k >> 2) * 8 + x, pn = k & 3;
            u.A = h1 + (size_t)pm * 256 * 2048;
            u.B = wt + (size_t)pn * 256 * 2048;
            u.B1 = u.B + (size_t)128 * 2048;
            u.O = ((pn < 2) ? pa + pn * 256 : pu + (pn - 2) * 256) + (size_t)pm * 256 * 512;
            u.ldc = 512;
        } else if (k < 34) {
            const int pn = k - 32;
            u.A = h1 + (size_t)(NL_ + x * 256) * 2048;
            u.B = wt + (size_t)(512 + pn * 256) * 2048;
            u.B1 = u.B + (size_t)128 * 2048;
            u.O = pu + (size_t)(NL_ + x * 256) * 512 + pn * 256;
            u.ldc = 512;
        } else {
            const int k2 = k - 34, tt = (k2 / 6) * 8 + x, pm = k2 % 6;
            u.A = wt + (size_t)(1024 + pm * 256) * 2048;
            u.B = h1 + (size_t)tt * 256 * 2048;
            u.B1 = u.B + (size_t)128 * 2048;
            u.O = pht + (size_t)pm * 256 * NL_ + tt * 256;
            u.ldc = NL_;
        }
        return true;
    }
};
DI void phase1(const Params& P, char* lds, int tid) {
    char* ws = P.ws;
    P1Sched S{ws + OFF_H1, ws + OFF_WIN_T, (bf16_t*)(ws + OFF_PA), (bf16_t*)(ws + OFF_PU), (bf16_t*)(ws + OFF_PHT),
              (int)(blockIdx.x & 7), (int)(blockIdx.x >> 3), (int)(gridDim.x >> 3)};
    pg8::EpiStore E;
    pg8::gemm_phase<false>(lds, 1024, S, E, tid);
}

DI int crow(int e, int h) { return (e & 3) + 8 * (e >> 2) + 4 * h; }

DI void taps_item(const Params& P, int it, char* lds, int tid) {
    const int lane = tid & 63, w = __builtin_amdgcn_readfirstlane(tid >> 6), r = lane & 31, h = lane >> 5;
    const int col0 = it * 32;
    const int dir = col0 >> 10, o = (col0 >> 9) & 1;
    const float* w3 = P.in[22];
    const float* b3 = P.in[23];
    const bf16_t* HB = (const bf16_t*)(P.ws + OFF_HDN2);
    bf16_t* RALL = (bf16_t*)(P.ws + OFF_RALL);
    float* red = (float*)lds;
    __syncthreads();
    bf16x8 fa[4];
#pragma unroll
    for (int ks = 0; ks < 4; ++ks)
#pragma unroll
        for (int j = 0; j < 8; ++j) fa[ks][j] = (short)f2bf(w3[(size_t)(16 * ks + 8 * h + j) * 2048 + col0 + r]);
    float s[16];
#pragma unroll
    for (int e = 0; e < 16; ++e) s[e] = 0.f;
    const float mind = -3.0701134573253945f, maxd = -15.350567286626973f;
    for (int q = 0; q < 8; ++q) {
        const int t0 = (w * 8 + q) * 32, t = t0 + r;
        f32x16 acc;
#pragma unroll
        for (int e = 0; e < 16; ++e) acc[e] = 0.f;
#pragma unroll
        for (int ks = 0; ks < 4; ++ks) {
            bf16x8 fb = *(const bf16x8*)(HB + (size_t)t * 64 + 16 * ks + 8 * h);
            acc = MFMA32(fa[ks], fb, acc);
        }
        const float tt = (float)t / 2047.f;
        const bool valid = !(dir == 1 && t == 0);
#pragma unroll
        for (int e = 0; e < 16; ++e) {
            const int col = col0 + crow(e, h);
            const int c = col & 511;
            const float delta = fabsf(mind + (float)c * ((maxd - mind) / 511.f));
            const float val = (acc[e] + b3[col]) * __expf(-tt * delta);
            if (valid) s[e] += fabsf(val);
            *(bf16_t*)(lds + 4096 + crow(e, h) * 4112 + (dir ? t : 2048 - t) * 2) = f2bf(valid ? val : 0.f);
        }
    }
#pragma unroll
    for (int e = 0; e < 16; ++e) {
        float v = s[e];
        v += shx(v, 16, lane); v += shx(v, 8, lane); v += shx(v, 4, lane); v += shx(v, 2, lane); v += shx(v, 1, lane);
        if (r == 0) red[w * 32 + crow(e, h)] = v;
    }
    if (dir == 0 && tid < 32) *(bf16_t*)(lds + 4096 + tid * 4112) = 0;
    __syncthreads();
    if (tid < 32) {
        float v = 0.f;
#pragma unroll
        for (int ww = 0; ww < 8; ++ww) v += red[ww * 32 + tid];
        const int c = (col0 + tid) & 511;
        ((float*)(P.ws + OFF_NRM2))[(dir * 2 + o) * 512 + c] = v;
        bf16_t* R = RALL + (size_t)(c * 2 + o) * 4104;
        const bf16_t* img = (const bf16_t*)(lds + 4096 + tid * 4112);
        if (dir == 0) {
            R[2048] = img[2048];
            unsigned z = 0u;
            asm volatile("" : "+v"(z));
            *(uint4*)(R + 4096) = make_uint4(z, z, z, z);
        } else {
#pragma unroll
            for (int k = 1; k < 8; ++k) R[2048 + k] = img[k];
        }
    }
    for (int q = tid; q < 32 * 256; q += NTHR) {
        const int cl = q >> 8, k = q & 255;
        if (dir == 1 && k == 0) continue;
        const int c = (col0 + cl) & 511;
        *(uint4*)(RALL + (size_t)(c * 2 + o) * 4104 + (dir ? 2048 : 0) + 8 * k) = *(const uint4*)(lds + 4096 + cl * 4112 + 16 * k);
    }
}

#define HY_G 0
#define HY_GSTRIDE 8448
#define HY_GOFF(sh) ((0x8D518D50u >> (4 * (sh))) & 15u)
#define HY_U 67584
#define HY_UROW 6160
#define HY_PAD 15
#define HY_GATE (HY_U + 8 * HY_UROW)

DI void conv32(const bf16_t* src, int J, float w0, float w1, float w2, uint4 (&o)[4]) {
    const uint4* p = (const uint4*)(src + 32 * J);
    const uint4 q0 = p[0], q1 = p[1], q2 = p[2], q3 = p[3];
    const float prev = (J > 0) ? bf2f(src[32 * J - 1]) : 0.f;
    const float next = (J < 63) ? bf2f(src[32 * J + 32]) : 0.f;
    const unsigned wv[16] = {q0.x, q0.y, q0.z, q0.w, q1.x, q1.y, q1.z, q1.w, q2.x, q2.y, q2.z, q2.w, q3.x, q3.y, q3.z, q3.w};
    float x[34];
    x[0] = prev;
#pragma unroll
    for (int i = 0; i < 16; ++i) {
        x[1 + 2 * i] = __uint_as_float(wv[i] << 16);
        x[2 + 2 * i] = __uint_as_float(wv[i] & 0xffff0000u);
    }
    x[33] = next;
    unsigned y[16];
#pragma unroll
    for (int i = 0; i < 16; ++i) {
        const float a = w0 * x[2 * i] + w1 * x[2 * i + 1] + w2 * x[2 * i + 2];
        const float b = w0 * x[2 * i + 1] + w1 * x[2 * i + 2] + w2 * x[2 * i + 3];
        y[i] = pack2(a, b);
    }
    o[0] = make_uint4(y[0], y[1], y[2], y[3]);
    o[1] = make_uint4(y[4], y[5], y[6], y[7]);
    o[2] = make_uint4(y[8], y[9], y[10], y[11]);
    o[3] = make_uint4(y[12], y[13], y[14], y[15]);
}

DI void hyena_item(const Params& P, int c, char* lds, int tid) {
#ifdef PROBE_HY
    const unsigned long long hy_it0 = __builtin_amdgcn_s_memrealtime();
#endif
    const bf16_t* PHT = (const bf16_t*)(P.ws + OFF_PHT);
    const bf16_t* RALL = (const bf16_t*)(P.ws + OFF_RALL) + (size_t)c * 2 * 4104;
    const float* NRM2 = (const float*)(P.ws + OFF_NRM2);
    bf16_t* YBT = (bf16_t*)(P.ws + OFF_YBT);
    const float* cw = P.in[15];
    const int lane = tid & 63;
    const int w = __builtin_amdgcn_readfirstlane(tid >> 6);
    const int g = w & 3, par = w >> 2;
    const int h = lane >> 5, i_ = lane & 31;
    const int lb = tid >> 6, lJ = tid & 63;
    __syncthreads();
    for (int q = tid; q < 8 * 2 * 60; q += NTHR) {
        const int b = q / 120, rem = q % 120, side = rem / 60, k = rem % 60;
        *(uint4*)(lds + HY_U + b * HY_UROW + (side ? (HY_PAD + 64) * 64 : 0) + k * 16) = make_uint4(0u, 0u, 0u, 0u);
    }
    {
        uint4 o[4];
        conv32(PHT + (size_t)c * NL_ + lb * S_, lJ, cw[c], cw[1536 + c], cw[3072 + c], o);
        uint4* d = (uint4*)(lds + HY_U + lb * HY_UROW + (HY_PAD + lJ) * 64);
        d[0] = o[0]; d[1] = o[1]; d[2] = o[2]; d[3] = o[3];
        conv32(PHT + (size_t)(512 + c) * NL_ + lb * S_, lJ, cw[512 + c], cw[1536 + 512 + c], cw[3072 + 512 + c], o);
        uint4* e = (uint4*)(lds + HY_GATE + lb * 4096 + lJ * 64);
        e[0] = o[0]; e[1] = o[1]; e[2] = o[2]; e[3] = o[3];
    }
    const int sh_ = (-i_) & 7;
    const int a_base = HY_G + sh_ * HY_GSTRIDE + (int)HY_GOFF(sh_) * 16 + (2048 - i_ + 8 * h - sh_) * 2;
    const int batch = i_ >> 2, blk = i_ & 3;
    const int b_base = HY_U + batch * HY_UROW + ((HY_PAD + blk) * 32 + 8 * h) * 2;
    for (int o_ = 0; o_ < 2; ++o_) {
        __syncthreads();
        if (o_ == 1) {
            uint4 o[4];
            conv32(PHT + (size_t)(1024 + c) * NL_ + lb * S_, lJ, cw[1024 + c], cw[1536 + 1024 + c], cw[3072 + 1024 + c], o);
            uint4* e = (uint4*)(lds + HY_GATE + lb * 4096 + lJ * 64);
            e[0] = o[0]; e[1] = o[1]; e[2] = o[2]; e[3] = o[3];
        }
        {
            const uint4* Rg = (const uint4*)(RALL + (size_t)o_ * 4104);
            const uint4 lo = Rg[tid], hi = Rg[tid + 1];
            const unsigned wv[8] = {lo.x, lo.y, lo.z, lo.w, hi.x, hi.y, hi.z, hi.w};
#pragma unroll
            for (int sh = 0; sh < 8; ++sh) {
                const int s2 = sh >> 1;
                uint4 ov;
                if (sh & 1) {
                    ov.x = (wv[s2] >> 16) | (wv[s2 + 1] << 16);
                    ov.y = (wv[s2 + 1] >> 16) | (wv[s2 + 2] << 16);
                    ov.z = (wv[s2 + 2] >> 16) | (wv[s2 + 3] << 16);
                    ov.w = (wv[s2 + 3] >> 16) | (wv[s2 + 4] << 16);
                } else {
                    ov = make_uint4(wv[s2], wv[s2 + 1], wv[s2 + 2], wv[s2 + 3]);
                }
                *(uint4*)(lds + HY_G + sh * HY_GSTRIDE + (int)HY_GOFF(sh) * 16 + tid * 16) = ov;
            }
        }
        __syncthreads();
        f32x16 acc[4];
#pragma unroll
        for (int tt = 0; tt < 4; ++tt)
#pragma unroll
            for (int e = 0; e < 16; ++e) acc[tt][e] = 0.f;
#ifdef PROBE_HY
        unsigned long long hy_t0 = __builtin_amdgcn_s_memrealtime();
#endif
#pragma unroll 2
        for (int D = 16 * g - 63 + par; D <= 16 * g + 15; D += 2) {
#pragma unroll
            for (int ks = 0; ks < 2; ++ks) {
                const bf16x8 fa = *(const bf16x8*)(lds + a_base + (-64 * D + 32 * ks));
#pragma unroll
                for (int tt = 0; tt < 4; ++tt) {
                    const bf16x8 fb = *(const bf16x8*)(lds + b_base + ((4 * (4 * g + tt) - D) * 64 + 32 * ks));
                    acc[tt] = MFMA32(fa, fb, acc[tt]);
                }
            }
        }
        __syncthreads();
#ifdef PROBE_HY
        if (tid == 0) { volatile unsigned* mm = (volatile unsigned*)(lds + LDS_MISC); mm[200] += (unsigned)(__builtin_amdgcn_s_memrealtime() - hy_t0); mm[201] += 1u; }
#endif
        float* scr = (float*)(lds + HY_G);
        if (par == 1) {
#pragma unroll
            for (int tt = 0; tt < 4; ++tt)
#pragma unroll
                for (int e = 0; e < 16; ++e) scr[((g * 4 + tt) * 16 + e) * 64 + lane] = acc[tt][e];
        }
        __syncthreads();
        if (par == 0) {
            const float inv = 1.f / (NRM2[(0 * 2 + o_) * 512 + c] + NRM2[(1 * 2 + o_) * 512 + c]);
            const float bias = P.in[24][o_ * 512 + c];
#pragma unroll
            for (int tt = 0; tt < 4; ++tt) {
                const int I = 4 * (4 * g + tt) + blk;
#pragma unroll
                for (int q = 0; q < 4; ++q) {
                    const int i0 = 8 * q + 4 * h;
                    char* up = lds + HY_U + batch * HY_UROW + ((HY_PAD + I) * 32 + i0) * 2;
                    const uint2 uu = *(const uint2*)up;
                    const uint2 gg = *(const uint2*)(lds + HY_GATE + batch * 4096 + (32 * I + i0) * 2);
                    float rr[4];
#pragma unroll
                    for (int e = 0; e < 4; ++e) {
                        const float a = acc[tt][4 * q + e] + scr[((g * 4 + tt) * 16 + 4 * q + e) * 64 + lane];
                        const unsigned uw = (e < 2) ? uu.x : uu.y, gw = (e < 2) ? gg.x : gg.y;
                        const float uf = (e & 1) ? __uint_as_float(uw & 0xffff0000u) : __uint_as_float(uw << 16);
                        const float gf = (e & 1) ? __uint_as_float(gw & 0xffff0000u) : __uint_as_float(gw << 16);
                        rr[e] = gf * (a * inv + uf * bias);
                    }
                    uint2 ov;
                    ov.x = pack2(rr[0], rr[1]);
                    ov.y = pack2(rr[2], rr[3]);
                    *(uint2*)up = ov;
                }
            }
        }
    }
    __syncthreads();
    {
        const uint4* sp = (const uint4*)(lds + HY_U + lb * HY_UROW + (HY_PAD + lJ) * 64);
        uint4* gp = (uint4*)(YBT + (size_t)c * NL_ + lb * S_ + lJ * 32);
        gp[0] = sp[0]; gp[1] = sp[1]; gp[2] = sp[2]; gp[3] = sp[3];
    }
#ifdef PROBE_HY
    if (tid == 0) { volatile unsigned* mm = (volatile unsigned*)(lds + LDS_MISC); mm[202] += (unsigned)(__builtin_amdgcn_s_memrealtime() - hy_it0); }
#endif
}

#define RN_V 0
#define RN_W 36864
#define RN_AGG 55296
#define RN_CARRY 59392

DI void rnn_item(const Params& P, int it, char* lds, int tid) {
    const int b = it >> 4, hd = (it >> 1) & 7, dir = it & 1;
    const bf16_t* PU = (const bf16_t*)(P.ws + OFF_PU);
    const bf16_t* WR = (const bf16_t*)(P.ws + OFF_WRNN_T);
    bf16_t* HS = (bf16_t*)(P.ws + OFF_HS) + (size_t)dir * NL_ * 512;
    const int lane = tid & 63, w = __builtin_amdgcn_readfirstlane(tid >> 6), r = lane & 31, h = lane >> 5;
    float* AGG = (float*)(lds + RN_AGG);
    float* CARRY = (float*)(lds + RN_CARRY);
    __syncthreads();
    for (int q = tid; q < 1024; q += NTHR) {
        const int n = q >> 3, ch = q & 7;
        *(uint4*)(lds + RN_W + n * LROW + ch * 16) = *(const uint4*)(WR + (size_t)(hd * 256 + dir * 128 + n) * 64 + ch * 8);
    }
    if (tid < 64) CARRY[tid] = 0.f;
    float ba[2], bx[2], sp[2];
#pragma unroll
    for (int jh = 0; jh < 2; ++jh) {
        const int ch = hd * 64 + jh * 32 + r;
        ba[jh] = P.in[11][dir * 512 + ch];
        bx[jh] = P.in[13][dir * 512 + ch];
        sp[jh] = log1pf(expf(-P.in[14][dir * 512 + ch]));
    }
    const int cc = tid & 7, tg = tid >> 3;
    for (int ci = 0; ci < 9; ++ci) {
        const bool isctx = (ci == 0);
        const int n = isctx ? CT_ : S_;
        const int tbase = isctx ? 0 : (dir ? (8 - ci) * 256 : (ci - 1) * 256);
        const bf16_t* src = (isctx ? PU + (size_t)(NL_ + b * CT_) * 512 : PU + (size_t)(b * S_) * 512) + hd * 64 + cc * 8;
        const int tlo = dir ? (tbase + 255 - 4 * tg - 3) : (tbase + 4 * tg);
        {
            float cwv[4][8], cbv[8];
            {
                const float4* cb4 = (const float4*)(P.in[9] + hd * 64 + cc * 8);
                const float4 c0 = cb4[0], c1 = cb4[1];
                cbv[0] = c0.x; cbv[1] = c0.y; cbv[2] = c0.z; cbv[3] = c0.w; cbv[4] = c1.x; cbv[5] = c1.y; cbv[6] = c1.z; cbv[7] = c1.w;
#pragma unroll
                for (int m = 0; m < 4; ++m) {
                    const float4* cw4 = (const float4*)(P.in[8] + m * 512 + hd * 64 + cc * 8);
                    const float4 d0 = cw4[0], d1 = cw4[1];
                    cwv[m][0] = d0.x; cwv[m][1] = d0.y; cwv[m][2] = d0.z; cwv[m][3] = d0.w;
                    cwv[m][4] = d1.x; cwv[m][5] = d1.y; cwv[m][6] = d1.z; cwv[m][7] = d1.w;
                }
            }
            float x[7][8];
#pragma unroll
            for (int m = 0; m < 7; ++m) {
                const int t = tlo - 2 + m;
                uint4 q = make_uint4(0u, 0u, 0u, 0u);
                if (t >= 0 && t < n) q = *(const uint4*)(src + (size_t)t * 512);
                x[m][0] = __uint_as_float(q.x << 16); x[m][1] = __uint_as_float(q.x & 0xffff0000u);
                x[m][2] = __uint_as_float(q.y << 16); x[m][3] = __uint_as_float(q.y & 0xffff0000u);
                x[m][4] = __uint_as_float(q.z << 16); x[m][5] = __uint_as_float(q.z & 0xffff0000u);
                x[m][6] = __uint_as_float(q.w << 16); x[m][7] = __uint_as_float(q.w & 0xffff0000u);
            }
#pragma unroll
            for (int k = 0; k < 4; ++k) {
                float v[8];
#pragma unroll
                for (int j = 0; j < 8; ++j)
                    v[j] = cbv[j] + cwv[0][j] * x[k][j] + cwv[1][j] * x[k + 1][j] + cwv[2][j] * x[k + 2][j] + cwv[3][j] * x[k + 3][j];
                const int rho = dir ? (4 * tg + 3 - k) : (4 * tg + k);
                *(uint4*)(lds + RN_V + rho * LROW + cc * 16) = make_uint4(pack2(v[0], v[1]), pack2(v[2], v[3]), pack2(v[4], v[5]), pack2(v[6], v[7]));
            }
        }
        __syncthreads();
        f32x16 acc[4];
#pragma unroll
        for (int nt = 0; nt < 4; ++nt)
#pragma unroll
            for (int e = 0; e < 16; ++e) acc[nt][e] = 0.f;
#pragma unroll
        for (int ks = 0; ks < 4; ++ks) {
            const bf16x8 fa = *(const bf16x8*)(lds + RN_V + (32 * w + r) * LROW + ks * 32 + h * 16);
#pragma unroll
            for (int nt = 0; nt < 4; ++nt) {
                const bf16x8 fb = *(const bf16x8*)(lds + RN_W + (32 * nt + r) * LROW + ks * 32 + h * 16);
                acc[nt] = MFMA32(fa, fb, acc[nt]);
            }
        }
        float av[2][16], bv[2][16];
#pragma unroll
        for (int jh = 0; jh < 2; ++jh)
#pragma unroll
            for (int e = 0; e < 16; ++e) {
                const int rho = 32 * w + crow(e, h);
                const float vv = bf2f(*(const bf16_t*)(lds + RN_V + rho * LROW + (jh * 32 + r) * 2));
                const float ra = acc[jh][e] + ba[jh], ri = acc[2 + jh][e] + bx[jh];
                const float rg = __builtin_amdgcn_rcpf(1.f + __expf(-ra));
                const float ig = __builtin_amdgcn_rcpf(1.f + __expf(-ri));
                const float la = -8.f * rg * sp[jh];
                const float x2 = 2.f * la;
                const float em = -x2 * (1.f + x2 * (0.5f + x2 * (0.16666667f + x2 * (0.041666668f + x2 * (0.0083333338f + x2 * 0.0013888889f)))));
                av[jh][e] = __expf(la);
                bv[jh][e] = __builtin_amdgcn_sqrtf(fmaxf(em, 0.f)) * ig * vv;
            }
        float s0A[2][4], s0B[2][4], PA_[2][4], PB_[2][4], WA[2], WB[2];
#pragma unroll
        for (int jh = 0; jh < 2; ++jh) {
#pragma unroll
            for (int q = 0; q < 4; ++q) {
                const float A = av[jh][4 * q] * av[jh][4 * q + 1] * av[jh][4 * q + 2] * av[jh][4 * q + 3];
                float x = bv[jh][4 * q];
                x = av[jh][4 * q + 1] * x + bv[jh][4 * q + 1];
                x = av[jh][4 * q + 2] * x + bv[jh][4 * q + 2];
                x = av[jh][4 * q + 3] * x + bv[jh][4 * q + 3];
                const float oA = shx(A, 32, lane), oB = shx(x, 32, lane);
                s0A[jh][q] = h ? oA : A;
                s0B[jh][q] = h ? oB : x;
                const float s1A = h ? A : oA, s1B = h ? x : oB;
                PA_[jh][q] = s1A * s0A[jh][q];
                PB_[jh][q] = s1A * s0B[jh][q] + s1B;
            }
            WA[jh] = PA_[jh][0] * PA_[jh][1] * PA_[jh][2] * PA_[jh][3];
            float x = PB_[jh][0];
            x = PA_[jh][1] * x + PB_[jh][1];
            x = PA_[jh][2] * x + PB_[jh][2];
            x = PA_[jh][3] * x + PB_[jh][3];
            WB[jh] = x;
            if (h == 0) {
                AGG[(w * 64 + jh * 32 + r) * 2] = WA[jh];
                AGG[(w * 64 + jh * 32 + r) * 2 + 1] = WB[jh];
            }
        }
        __syncthreads();
        float cout_[2];
        char* hvp = lds + RN_V + (32 * w + 4 * h) * LROW + r * 2;
#pragma unroll
        for (int jh = 0; jh < 2; ++jh) {
            const int j = jh * 32 + r;
            float cin = CARRY[j];
            for (int w2 = 0; w2 < w; ++w2) cin = AGG[(w2 * 64 + j) * 2] * cin + AGG[(w2 * 64 + j) * 2 + 1];
            cout_[jh] = WA[jh] * cin + WB[jh];
            float C = cin;
#pragma unroll
            for (int q = 0; q < 4; ++q) {
                const float c1 = s0A[jh][q] * C + s0B[jh][q];
                float x = h ? c1 : C;
#pragma unroll
                for (int e4 = 0; e4 < 4; ++e4) {
                    x = av[jh][4 * q + e4] * x + bv[jh][4 * q + e4];
                    if (!isctx) *(bf16_t*)(hvp + (e4 + 8 * q) * LROW + jh * 64) = f2bf(x);
                }
                C = PA_[jh][q] * C + PB_[jh][q];
            }
        }
        __syncthreads();
        if (w == 7 && h == 0) {
            CARRY[r] = cout_[0];
            CARRY[32 + r] = cout_[1];
        }
        if (!isctx) {
            const int rho = tid >> 1, hf2 = tid & 1;
            const int t = dir ? (tbase + 255 - rho) : (tbase + rho);
            const uint4* sp = (const uint4*)(lds + RN_V + rho * LROW + hf2 * 64);
            uint4* gp = (uint4*)(HS + (size_t)(b * S_ + t) * 512 + hd * 64 + hf2 * 32);
            const uint4 v0 = sp[0], v1 = sp[1], v2 = sp[2], v3 = sp[3];
            gp[0] = v0; gp[1] = v1; gp[2] = v2; gp[3] = v3;
            __syncthreads();
        }
    }
}

#define P2_RNN 128
#define P2_HY 512
DI void phase2(const Params& P, char* lds, int tid, volatile unsigned* misc, int pass) {
    unsigned* qctr = (unsigned*)(P.ws + OFF_CTL) + QUEUE_WORD + pass;
    for (;;) {
        __syncthreads();
        if (tid == 0) misc[8] = atomicAdd(qctr, 1u);
        __syncthreads();
        const int it = __builtin_amdgcn_readfirstlane((int)misc[8]);
        if (it >= P2_RNN + P2_HY) break;
        int tq = tid;
        asm volatile("" : "+v"(tq));
#ifdef PROBE_P2
        if (pass == 1 && ((PROBE_P2 == 1) != (it < P2_RNN))) continue;
#endif
        if (it < P2_RNN) rnn_item(P, it, lds, tq);
        else hyena_item(P, it - P2_RNN, lds, tq);
    }
}

#define P3_A 0
#define P3_AROW 2064
#define P3_LG 132096
#define P3_SC 148480
#define P3_RED 149760
#define CNT_WORD 4160

DI float gelu_tanh(float x) {
    const float u = 0.7978845608028654f * (x + 0.044715f * x * x * x);
    const float t = 1.f - 2.f * __builtin_amdgcn_rcpf(1.f + __expf(2.f * u));
    return 0.5f * x * (1.f + t);
}
DI float bflo(unsigned v) { return __uint_as_float(v << 16); }
DI float bfhi(unsigned v) { return __uint_as_float(v & 0xffff0000u); }

DI void p2b_item(const Params& P, int it, char* lds, int tid) {
    const int tok0 = it * 64;
    const bf16_t* PA = (const bf16_t*)(P.ws + OFF_PA);
    const bf16_t* HF = (const bf16_t*)(P.ws + OFF_HS);
    const bf16_t* HB = HF + (size_t)NL_ * 512;
    const bf16_t* YBT = (const bf16_t*)(P.ws + OFF_YBT);
    bf16_t* YN = (bf16_t*)(P.ws + OFF_YN);
    float* sc = (float*)(lds + P3_SC);
    float* red = (float*)(lds + P3_RED);
    const int lane = tid & 63, w = __builtin_amdgcn_readfirstlane(tid >> 6);
    __syncthreads();
#pragma unroll 2
    for (int i = 0; i < 8; ++i) {
        const int tok = w + 8 * i, c8 = lane;
        const size_t g = (size_t)(tok0 + tok) * 512 + c8 * 8;
        const uint4 pa = *(const uint4*)(PA + g), hf = *(const uint4*)(HF + g), hb = *(const uint4*)(HB + g);
        const unsigned pw[4] = {pa.x, pa.y, pa.z, pa.w}, fw[4] = {hf.x, hf.y, hf.z, hf.w}, bw[4] = {hb.x, hb.y, hb.z, hb.w};
        unsigned ow[4];
        float ss = 0.f;
#pragma unroll
        for (int k = 0; k < 4; ++k) {
            const float y0 = gelu_tanh(bflo(pw[k])) * (bflo(fw[k]) + bflo(bw[k]));
            const float y1 = gelu_tanh(bfhi(pw[k])) * (bfhi(fw[k]) + bfhi(bw[k]));
            ss += y0 * y0 + y1 * y1;
            ow[k] = pack2(y0, y1);
        }
        *(uint4*)(lds + P3_A + tok * P3_AROW + c8 * 16) = make_uint4(ow[0], ow[1], ow[2], ow[3]);
#pragma unroll
        for (int o = 32; o > 0; o >>= 1) ss += shx(ss, o, lane);
        if (lane == 0) sc[tok] = ss;
    }
    {
        float sb[8];
#pragma unroll
        for (int e = 0; e < 8; ++e) sb[e] = 0.f;
        const int j = tid & 7;
#pragma unroll 2
        for (int pass = 0; pass < 8; ++pass) {
            const int c = pass * 64 + (tid >> 3);
            const uint4 v = *(const uint4*)(YBT + (size_t)c * NL_ + tok0 + 8 * j);
            const unsigned vw[4] = {v.x, v.y, v.z, v.w};
#pragma unroll
            for (int k = 0; k < 4; ++k) {
                const float f0 = bflo(vw[k]), f1 = bfhi(vw[k]);
                sb[2 * k] += f0 * f0;
                sb[2 * k + 1] += f1 * f1;
                *(bf16_t*)(lds + P3_A + (8 * j + 2 * k) * P3_AROW + (512 + c) * 2) = (bf16_t)(vw[k] & 0xffffu);
                *(bf16_t*)(lds + P3_A + (8 * j + 2 * k + 1) * P3_AROW + (512 + c) * 2) = (bf16_t)(vw[k] >> 16);
            }
        }
#pragma unroll
        for (int e = 0; e < 8; ++e) {
            float v = sb[e];
            v += shx(v, 8, lane); v += shx(v, 16, lane); v += shx(v, 32, lane);
            if (lane < 8) red[w * 64 + 8 * j + e] = v;
        }
    }
    __syncthreads();
    if (tid < 64) {
        float ssb = 0.f;
#pragma unroll
        for (int ww = 0; ww < 8; ++ww) ssb += red[ww * 64 + tid];
        sc[128 + tid] = rsqrtf(sc[tid] * (1.f / 512.f) + 1e-6f);
        sc[192 + tid] = rsqrtf(ssb * (1.f / 512.f) + 1e-6f);
    }
    __syncthreads();
#pragma unroll 4
    for (int i = 0; i < 16; ++i) {
        const int q = tid + NTHR * i, row = q >> 7, c16 = q & 127;
        const uint4 v = *(const uint4*)(lds + P3_A + row * P3_AROW + c16 * 16);
        const float scl = sc[(c16 < 64 ? 128 : 192) + row];
        uint4 o;
        o.x = pack2(bflo(v.x) * scl, bfhi(v.x) * scl);
        o.y = pack2(bflo(v.y) * scl, bfhi(v.y) * scl);
        o.z = pack2(bflo(v.z) * scl, bfhi(v.z) * scl);
        o.w = pack2(bflo(v.w) * scl, bfhi(v.w) * scl);
        *(uint4*)(YN + (size_t)(tok0 + row) * 1024 + c16 * 8) = o;
    }
}
DI void phase2b(const Params& P, char* lds, int tid) {
    for (int it = blockIdx.x; it < NL_ / 64; it += gridDim.x) p2b_item(P, it, lds, tid);
}

struct P3Sched {
    const char* yn; const char* wt; bf16_t* y; int x, j, nj;
    DI bool next(int i, pg8::GUnit& u) const {
        const int k = j + i * nj;
        if (k >= 32) return false;
        const int pm = (k >> 2) * 8 + x, pn = k & 3;
        u.A = yn + (size_t)pm * 256 * 2048;
        u.B = wt + (size_t)pn * 256 * 2048;
        u.B1 = u.B + (size_t)128 * 2048;
        u.O = y + (size_t)pm * 256 * 1024 + pn * 256;
        u.ldc = 1024; u.valid = 256; u.aux = 0;
        return true;
    }
};
DI void phase3(const Params& P, char* lds, int tid) {
    char* ws = P.ws;
    P3Sched S{ws + OFF_YN, ws + OFF_WOUT_T, (bf16_t*)(ws + OFF_Y), (int)(blockIdx.x & 7), (int)(blockIdx.x >> 3), (int)(gridDim.x >> 3)};
    pg8::EpiStore E;
    pg8::gemm_phase<false>(lds, 1024, S, E, tid);
}

DI void p3b_item(const Params& P, int it, char* lds, int tid, int pass) {
    const int tok0 = it * 64, b = tok0 >> 11;
    const bf16_t* WRT = (const bf16_t*)(P.ws + OFF_WR_T);
    bf16_t* H2 = (bf16_t*)(P.ws + OFF_H2);
    const float* mod = (const float*)(P.ws + OFF_MOD) + b * 6144;
    float* LG = (float*)(lds + P3_LG);
    const int lane = tid & 63, w = __builtin_amdgcn_readfirstlane(tid >> 6), r = lane & 31, h = lane >> 5;
    __syncthreads();
    const bf16_t* Y = (const bf16_t*)(P.ws + OFF_Y);
    const float* pe = (const float*)(P.ws + OFF_PE);
#pragma unroll 1
    for (int rb = 0; rb < 8; rb += 4) {
        float4 xv[4][4];
#pragma unroll
        for (int q = 0; q < 4; ++q) {
            const int tok = tok0 + w * 8 + rb + q, t = tok & 2047;
#pragma unroll
            for (int i2 = 0; i2 < 2; ++i2) {
                const int d = i2 * 512 + lane * 8;
                const float4 xa = *(const float4*)(P.in[0] + (size_t)tok * 1024 + d), xb = *(const float4*)(P.in[0] + (size_t)tok * 1024 + d + 4);
                const uint4 yv = *(const uint4*)(Y + (size_t)tok * 1024 + d);
                const float* pp = i2 ? pe + (t & 63) * 512 + lane * 8 : pe + (t >> 6) * 512 + lane * 8;
                const float4 pa = *(const float4*)pp, pb = *(const float4*)(pp + 4);
                const float4 ga = *(const float4*)(mod + 2048 + d), gb = *(const float4*)(mod + 2048 + d + 4);
                float4 oa, ob;
                oa.x = xa.x + pa.x + ga.x * bflo(yv.x); oa.y = xa.y + pa.y + ga.y * bfhi(yv.x);
                oa.z = xa.z + pa.z + ga.z * bflo(yv.y); oa.w = xa.w + pa.w + ga.w * bfhi(yv.y);
                ob.x = xb.x + pb.x + gb.x * bflo(yv.z); ob.y = xb.y + pb.y + gb.y * bfhi(yv.z);
                ob.z = xb.z + pb.z + gb.z * bflo(yv.w); ob.w = xb.w + pb.w + gb.w * bfhi(yv.w);
                *(float4*)(P.out + (size_t)tok * 1024 + d) = oa;
                *(float4*)(P.out + (size_t)tok * 1024 + d + 4) = ob;
                xv[q][2 * i2] = oa;
                xv[q][2 * i2 + 1] = ob;
            }
        }
        float ss[4];
#pragma unroll
        for (int q = 0; q < 4; ++q) {
            ss[q] = 0.f;
#pragma unroll
            for (int i = 0; i < 4; ++i) ss[q] += xv[q][i].x * xv[q][i].x + xv[q][i].y * xv[q][i].y + xv[q][i].z * xv[q][i].z + xv[q][i].w * xv[q][i].w;
        }
#pragma unroll
        for (int o = 32; o > 0; o >>= 1)
#pragma unroll
            for (int q = 0; q < 4; ++q) ss[q] += shx(ss[q], o, lane);
#pragma unroll
        for (int i2 = 0; i2 < 2; ++i2) {
            const int d = i2 * 512 + lane * 8;
            float gm[8], shf[8];
#pragma unroll
            for (int hh = 0; hh < 2; ++hh) {
                const float4 gn = *(const float4*)(P.in[28] + d + 4 * hh), s2v = *(const float4*)(mod + 4096 + d + 4 * hh), shv = *(const float4*)(mod + 3072 + d + 4 * hh);
                gm[4 * hh + 0] = gn.x * (1.f + s2v.x); gm[4 * hh + 1] = gn.y * (1.f + s2v.y); gm[4 * hh + 2] = gn.z * (1.f + s2v.z); gm[4 * hh + 3] = gn.w * (1.f + s2v.w);
                shf[4 * hh + 0] = shv.x; shf[4 * hh + 1] = shv.y; shf[4 * hh + 2] = shv.z; shf[4 * hh + 3] = shv.w;
            }
#pragma unroll
            for (int q = 0; q < 4; ++q) {
                const int row = w * 8 + rb + q;
                const float rs = rsqrtf(ss[q] * (1.f / 1024.f) + 1e-6f);
                const float4 a = xv[q][2 * i2], bq = xv[q][2 * i2 + 1];
                uint4 pk;
                pk.x = pack2(a.x * rs * gm[0] + shf[0], a.y * rs * gm[1] + shf[1]);
                pk.y = pack2(a.z * rs * gm[2] + shf[2], a.w * rs * gm[3] + shf[3]);
                pk.z = pack2(bq.x * rs * gm[4] + shf[4], bq.y * rs * gm[5] + shf[5]);
                pk.w = pack2(bq.z * rs * gm[6] + shf[6], bq.w * rs * gm[7] + shf[7]);
                *(uint4*)(H2 + (size_t)(tok0 + row) * 1024 + d) = pk;
                *(uint4*)(lds + P3_A + row * P3_AROW + d * 2) = pk;
            }
        }
    }
    __syncthreads();
    if (w < 4) {
        const int mi = w >> 1, ni = w & 1;
        f32x16 lg;
#pragma unroll
        for (int e = 0; e < 16; ++e) lg[e] = 0.f;
        const bf16_t* wr = WRT + (size_t)(32 * ni + r) * 1024 + 8 * h;
        const char* ar = lds + P3_A + (32 * mi + r) * P3_AROW + 16 * h;
#pragma unroll 8
        for (int ks = 0; ks < 64; ++ks) {
            const bf16x8 fa = *(const bf16x8*)(ar + ks * 32);
            const bf16x8 fbb = *(const bf16x8*)(wr + ks * 16);
            lg = MFMA32(fa, fbb, lg);
        }
        const int nn = 32 * ni + r;
        const float bias = (nn < 4) ? P.in[30][nn] : ((nn < 36) ? P.in[32][nn - 4] : 0.f);
#pragma unroll
        for (int e = 0; e < 16; ++e) LG[(32 * mi + crow(e, h)) * 64 + nn] = lg[e] + bias;
    }
    __syncthreads();
    int* lcnt = (int*)(lds + P3_RED);
    int* lbase = lcnt + 32;
    if (tid < 32) lcnt[tid] = 0;
    __syncthreads();
    int ex0 = 0, ex1 = 0, r0 = 0, r1 = 0;
    float w0 = 0.f, w1 = 0.f;
    if (tid < 64 && pass == 0) {
        const float* l = LG + tid * 64;
        int gi = 0;
        float gmx = l[0];
        for (int j = 1; j < 4; ++j) if (l[j] > gmx) { gmx = l[j]; gi = j; }
        float gs = 0.f;
        for (int j = 0; j < 4; ++j) gs += __expf(l[j] - gmx);
        const float gp = 1.f / gs;
        const float* el = l + 4 + gi * 8;
        int e0 = 0;
        float m0 = el[0];
        for (int j = 1; j < 8; ++j) if (el[j] > m0) { m0 = el[j]; e0 = j; }
        int e1 = 0;
        float m1 = -1e30f;
        for (int j = 0; j < 8; ++j) if (j != e0 && el[j] > m1) { m1 = el[j]; e1 = j; }
        const float p1 = __expf(m1 - m0);
        w0 = gp / (1.f + p1);
        w1 = gp * p1 / (1.f + p1);
        ex0 = gi * 8 + e0;
        ex1 = gi * 8 + e1;
        r0 = atomicAdd(&lcnt[ex0], 1);
        r1 = atomicAdd(&lcnt[ex1], 1);
    }
    __syncthreads();
    if (tid < 32 && pass == 0) {
        const int c = lcnt[tid];
        unsigned* cnt = (unsigned*)(P.ws + OFF_CTL) + CNT_WORD;
        lbase[tid] = (c > 0) ? (int)atomicAdd(&cnt[tid * 64], (unsigned)c) : 0;
    }
    __syncthreads();
    if (tid < 64 && pass == 0) {
        const int tok = tok0 + tid;
        unsigned* LIST = (unsigned*)(P.ws + OFF_LIST);
        unsigned* TS = (unsigned*)(P.ws + OFF_TOKSLOT);
        float* EW = (float*)(P.ws + OFF_EW);
        const unsigned p0 = (unsigned)(lbase[ex0] + r0), p1i = (unsigned)(lbase[ex1] + r1);
        LIST[ex0 * 16384 + p0] = tok * 2;
        TS[tok * 2] = ((unsigned)ex0 << 16) | p0;
        EW[tok * 2] = w0;
        LIST[ex1 * 16384 + p1i] = tok * 2 + 1;
        TS[tok * 2 + 1] = ((unsigned)ex1 << 16) | p1i;
        EW[tok * 2 + 1] = w1;
    }
}
DI void phase3b(const Params& P, char* lds, int tid, int pass) {
    for (int it = blockIdx.x; it < NL_ / 64; it += gridDim.x) p3b_item(P, it, lds, tid, pass);
}

#define MISC_TB 16
#define MISC_SB 56
#define MISC_CNT 96
DI void moe_tables(const Params& P, volatile unsigned* misc, int tid) {
    __syncthreads();
    if (tid == 0) {
        unsigned* cnt = (unsigned*)(P.ws + OFF_CTL) + CNT_WORD;
        unsigned t = 0, sb = 0;
        for (int e = 0; e < 32; ++e) {
            const unsigned c = __hip_atomic_load(&cnt[e * 64], __ATOMIC_RELAXED, __HIP_MEMORY_SCOPE_AGENT);
            misc[MISC_TB + e] = t;
            misc[MISC_SB + e] = sb;
            misc[MISC_CNT + e] = c;
            t += (c + 255u) >> 8;
            sb += c;
        }
        misc[MISC_TB + 32] = t;
    }
    __syncthreads();
}

struct MoeTile { int e, mt, ntile, valid, pos0; };
DI int moe_label_items(volatile unsigned* misc, int x) {
    int n = 0;
#pragma unroll
    for (int q = 0; q < 4; ++q) n += (int)((misc[MISC_CNT + x + 8 * q] + 255u) >> 8);
    return n * 8;
}
DI MoeTile moe_tile(volatile unsigned* misc, int x, int k) {
    MoeTile t;
    int mtg = k >> 3;
    t.ntile = k & 7;
    int e = x;
    bool more = true;
#pragma unroll
    for (int q = 0; q < 3; ++q) {
        const int tiles = (int)((misc[MISC_CNT + e] + 255u) >> 8);
        if (more && mtg >= tiles) { mtg -= tiles; e += 8; } else more = false;
    }
    t.e = e;
    t.mt = mtg;
    t.valid = min(256, (int)misc[MISC_CNT + e] - mtg * 256);
    t.pos0 = (int)misc[MISC_SB + e] + mtg * 256;
    return t;
}
struct EpiAct {
    DI void operator()(const pg8::f32x4r (&acc)[2][2][4][2], const pg8::GUnit& u, int wr, int wc, int fr, int fq, char* lds) const {
        asm volatile("" : "+v"(fr), "+v"(fq));
#pragma unroll
        for (int ai = 0; ai < 2; ++ai)
#pragma unroll
            for (int m = 0; m < 4; ++m) {
                const int r = ai * 128 + wr * 64 + m * 16 + fr;
                if (r < u.valid) {
                    float a[8];
#pragma unroll
                    for (int n = 0; n < 2; ++n)
#pragma unroll
                        for (int k = 0; k < 4; ++k) {
                            const float gt = acc[ai][0][m][n][k], up = acc[ai][1][m][n][k];
                            a[4 * n + k] = gt * __builtin_amdgcn_rcpf(1.f + __expf(-gt)) * up;
                        }
                    u32x4 w;
                    w.x = pg8::cvt_pk_bf16(a[0], a[1]); w.y = pg8::cvt_pk_bf16(a[2], a[3]); w.z = pg8::cvt_pk_bf16(a[4], a[5]); w.w = pg8::cvt_pk_bf16(a[6], a[7]);
                    *(u32x4*)(u.O + (size_t)r * u.ldc + wc * 32 + 8 * fq) = w;
                }
            }
    }
};
struct P4Sched {
    const char* h2; const char* wg; const char* wu; bf16_t* act; const unsigned* list; int x, j, nj, total;
    int c0, c1, c2, c3, b0, b1, b2, b3;
    int r0, cb0, r1, cb1;
    DI bool next(int i, pg8::GUnit& u) const {
        const int k = j + i * nj;
        if (k >= total) return false;
        int mtg = k >> 2;
        const int nu = k & 3;
        const int t0 = (c0 + 255) >> 8, t1 = (c1 + 255) >> 8, t2 = (c2 + 255) >> 8;
        int q = 0, c = c0, b = b0;
        if (mtg >= t0) {
            mtg -= t0; q = 1; c = c1; b = b1;
            if (mtg >= t1) {
                mtg -= t1; q = 2; c = c2; b = b2;
                if (mtg >= t2) { mtg -= t2; q = 3; c = c3; b = b3; }
            }
        }
        const int e = x + 8 * q, pos0 = b + mtg * 256;
        u.A = h2;
        u.B = wg + (size_t)(e * 512 + nu * 128) * 2048;
        u.B1 = wu + (size_t)(e * 512 + nu * 128) * 2048;
        u.O = act + (size_t)pos0 * 512 + nu * 128;
        u.ldc = 512;
        u.valid = min(256, c - mtg * 256);
        u.aux = pos0;
        const unsigned* lp = list + e * 16384 + mtg * 256;
        const int vm = u.valid - 1;
        u.ga[0][0] = h2 + (size_t)(lp[min(r0, vm)] >> 1) * 2048 + cb0;
        u.ga[0][1] = h2 + (size_t)(lp[min(r1, vm)] >> 1) * 2048 + cb1;
        u.ga[1][0] = h2 + (size_t)(lp[min(128 + r0, vm)] >> 1) * 2048 + cb0;
        u.ga[1][1] = h2 + (size_t)(lp[min(128 + r1, vm)] >> 1) * 2048 + cb1;
        return true;
    }
};
DI void phase4(const Params& P, char* lds, int tid, volatile unsigned* misc) {
    moe_tables(P, misc, tid);
    {
        const int p = blockIdx.x * 128 + tid;
        if (tid < 128 && p < 2 * NL_) {
            int e = 0;
            for (int q = 1; q < 32; ++q) e = ((int)misc[MISC_SB + q] <= p) ? q : e;
            const unsigned slot = ((const unsigned*)(P.ws + OFF_LIST))[e * 16384 + (p - (int)misc[MISC_SB + e])];
            ((float*)(P.ws + OFF_EWS))[p] = ((const float*)(P.ws + OFF_EW))[slot];
        }
    }
    char* ws = P.ws;
    const int x = (int)(blockIdx.x & 7);
    const int c0 = __builtin_amdgcn_readfirstlane((int)misc[MISC_CNT + x]), c1 = __builtin_amdgcn_readfirstlane((int)misc[MISC_CNT + x + 8]);
    const int c2 = __builtin_amdgcn_readfirstlane((int)misc[MISC_CNT + x + 16]), c3 = __builtin_amdgcn_readfirstlane((int)misc[MISC_CNT + x + 24]);
    const int b0 = __builtin_amdgcn_readfirstlane((int)misc[MISC_SB + x]), b1 = __builtin_amdgcn_readfirstlane((int)misc[MISC_SB + x + 8]);
    const int b2 = __builtin_amdgcn_readfirstlane((int)misc[MISC_SB + x + 16]), b3 = __builtin_amdgcn_readfirstlane((int)misc[MISC_SB + x + 24]);
    const int total = 4 * (((c0 + 255) >> 8) + ((c1 + 255) >> 8) + ((c2 + 255) >> 8) + ((c3 + 255) >> 8));
    int r0, cc0, r1, cc1;
    pg8::stage_piece(tid, 0, r0, cc0);
    pg8::stage_piece(tid, 1, r1, cc1);
    const P4Sched S{ws + OFF_H2, ws + OFF_WG_T, ws + OFF_WU_T, (bf16_t*)(ws + OFF_ACT), (const unsigned*)(ws + OFF_LIST), x, (int)(blockIdx.x >> 3), (int)(gridDim.x >> 3), total,
                    c0, c1, c2, c3, b0, b1, b2, b3, r0, cc0 * 2, r1, cc1 * 2};
    const EpiAct E;
    pg8::gemm_phase<true>(lds, 1024, S, E, tid);
}

struct EpiDown {
    const float* ews;
    DI void operator()(const pg8::f32x4r (&acc)[2][2][4][2], const pg8::GUnit& u, int wr, int wc, int fr, int fq, char* lds) const {
        asm volatile("" : "+v"(fr), "+v"(fq));
#pragma unroll
        for (int ai = 0; ai < 2; ++ai)
#pragma unroll
            for (int m = 0; m < 4; ++m) {
                const int r = ai * 128 + wr * 64 + m * 16 + fr;
                if (r < u.valid) {
                    const float wv = ews[u.aux + r];
                    bf16_t* rowp = u.O + (size_t)r * u.ldc + wc * 32 + 8 * fq;
#pragma unroll
                    for (int bj = 0; bj < 2; ++bj) {
                        const pg8::f32x4r v0 = acc[ai][bj][m][0] * wv, v1 = acc[ai][bj][m][1] * wv;
                        u32x4 w;
                        w.x = pg8::cvt_pk_bf16(v0[0], v0[1]); w.y = pg8::cvt_pk_bf16(v0[2], v0[3]); w.z = pg8::cvt_pk_bf16(v1[0], v1[1]); w.w = pg8::cvt_pk_bf16(v1[2], v1[3]);
                        *(u32x4*)(rowp + bj * 128) = w;
                    }
                }
                asm volatile("" ::: "memory");
            }
    }
};
struct P5Sched {
    const char* act; const char* wd; bf16_t* slot; int x, j, nj, total;
    int c0, c1, c2, c3, b0, b1, b2, b3;
    DI bool next(int i, pg8::GUnit& u) const {
        const int k = j + i * nj;
        if (k >= total) return false;
        int mtg = k >> 2;
        const int pn = k & 3;
        const int t0 = (c0 + 255) >> 8, t1 = (c1 + 255) >> 8, t2 = (c2 + 255) >> 8;
        int q = 0, c = c0, b = b0;
        if (mtg >= t0) {
            mtg -= t0; q = 1; c = c1; b = b1;
            if (mtg >= t1) {
                mtg -= t1; q = 2; c = c2; b = b2;
                if (mtg >= t2) { mtg -= t2; q = 3; c = c3; b = b3; }
            }
        }
        const int e = x + 8 * q, pos0 = b + mtg * 256;
        u.A = act + (size_t)pos0 * 1024;
        u.B = wd + (size_t)(e * 1024 + pn * 256) * 1024;
        u.B1 = u.B + (size_t)128 * 1024;
        u.O = slot + (size_t)pos0 * 1024 + pn * 256;
        u.ldc = 1024;
        u.valid = min(256, c - mtg * 256);
        u.aux = pos0;
        return true;
    }
};
DI void phase5(const Params& P, char* lds, int tid, volatile unsigned* misc) {
    char* ws = P.ws;
    const int x = (int)(blockIdx.x & 7);
    const int c0 = __builtin_amdgcn_readfirstlane((int)misc[MISC_CNT + x]), c1 = __builtin_amdgcn_readfirstlane((int)misc[MISC_CNT + x + 8]);
    const int c2 = __builtin_amdgcn_readfirstlane((int)misc[MISC_CNT + x + 16]), c3 = __builtin_amdgcn_readfirstlane((int)misc[MISC_CNT + x + 24]);
    const int b0 = __builtin_amdgcn_readfirstlane((int)misc[MISC_SB + x]), b1 = __builtin_amdgcn_readfirstlane((int)misc[MISC_SB + x + 8]);
    const int b2 = __builtin_amdgcn_readfirstlane((int)misc[MISC_SB + x + 16]), b3 = __builtin_amdgcn_readfirstlane((int)misc[MISC_SB + x + 24]);
    const int total = 4 * (((c0 + 255) >> 8) + ((c1 + 255) >> 8) + ((c2 + 255) >> 8) + ((c3 + 255) >> 8));
    const P5Sched S{ws + OFF_ACT, ws + OFF_WD_T, (bf16_t*)(ws + OFF_SLOT), x, (int)(blockIdx.x >> 3), (int)(gridDim.x >> 3), total, c0, c1, c2, c3, b0, b1, b2, b3};
    const EpiDown E{(const float*)(ws + OFF_EWS)};
    pg8::gemm_phase<false>(lds, 512, S, E, tid);
}

DI void phase6(const Params& P, int tid, volatile unsigned* misc, bool dummy) {
    const bf16_t* SLOT = (const bf16_t*)(P.ws + OFF_SLOT);
    const unsigned* TS = (const unsigned*)(P.ws + OFF_TOKSLOT);
    const float* modb = (const float*)(P.ws + OFF_MOD);
    const int lane = tid & 63, w = tid >> 6;
    for (int it = blockIdx.x; it < NL_ / 8; it += gridDim.x) {
        const int tok = it * 8 + w;
        const float* g2 = modb + (tok >> 11) * 6144 + 5120;
        const unsigned t0 = TS[tok * 2], t1 = TS[tok * 2 + 1];
        const bf16_t* s0 = SLOT + (size_t)(misc[MISC_SB + (t0 >> 16)] + (t0 & 0xffffu)) * 1024;
        const bf16_t* s1 = SLOT + (size_t)(misc[MISC_SB + (t1 >> 16)] + (t1 & 0xffffu)) * 1024;
        float* xo = P.out + (size_t)tok * 1024;
        float* xw = dummy ? (float*)(P.ws + OFF_H1) + (size_t)tok * 1024 : xo;
        float v[16];
        float ss = 0.f;
#pragma unroll
        for (int i = 0; i < 4; ++i) {
            const int d = i * 256 + lane * 4;
            const float4 xv = *(const float4*)(xo + d);
            const float4 gv = *(const float4*)(g2 + d);
            const uint2 a = *(const uint2*)(s0 + d), bq = *(const uint2*)(s1 + d);
            v[i * 4 + 0] = xv.x + gv.x * (bflo(a.x) + bflo(bq.x));
            v[i * 4 + 1] = xv.y + gv.y * (bfhi(a.x) + bfhi(bq.x));
            v[i * 4 + 2] = xv.z + gv.z * (bflo(a.y) + bflo(bq.y));
            v[i * 4 + 3] = xv.w + gv.w * (bfhi(a.y) + bfhi(bq.y));
            ss += v[i * 4] * v[i * 4] + v[i * 4 + 1] * v[i * 4 + 1] + v[i * 4 + 2] * v[i * 4 + 2] + v[i * 4 + 3] * v[i * 4 + 3];
        }
#pragma unroll
        for (int o = 32; o > 0; o >>= 1) ss += shx(ss, o, lane);
        const float rstd = rsqrtf(ss * (1.f / 1024.f) + 1e-6f);
#pragma unroll
        for (int i = 0; i < 4; ++i) {
            const int d = i * 256 + lane * 4;
            const float4 fg = *(const float4*)(P.in[36] + d);
            float4 o;
            o.x = v[i * 4 + 0] * rstd * fg.x; o.y = v[i * 4 + 1] * rstd * fg.y;
            o.z = v[i * 4 + 2] * rstd * fg.z; o.w = v[i * 4 + 3] * rstd * fg.w;
            *(float4*)(xw + d) = o;
        }
    }
}

#define NPHASE 10
DI void run_phase(const Params& P, int ph, int pass, int npass, char* lds, int tq, volatile unsigned* misc) {
    if (ph == 0) phase0a(P, lds, tq);
    else if (ph == 1) phase0b(P, lds, tq);
    else if (ph == 2) phase1(P, lds, tq);
    else if (ph == 3) phase2(P, lds, tq, misc, pass);
    else if (ph == 4) phase2b(P, lds, tq);
    else if (ph == 5) phase3(P, lds, tq);
    else if (ph == 6) phase3b(P, lds, tq, pass);
    else if (ph == 7) phase4(P, lds, tq, misc);
    else if (ph == 8) phase5(P, lds, tq, misc);
    else if (ph == 9) phase6(P, tq, misc, pass + 1 < npass);
}
__global__ void __launch_bounds__(NTHR, 2) mk_fwd(Params P, int ph_lo, int ph_hi, int rep_mask) {
    extern __shared__ __attribute__((aligned(16))) char lds[];
    const int tid = threadIdx.x;
    volatile unsigned* misc = (volatile unsigned*)(lds + LDS_MISC);
    if (tid < 256) misc[tid] = 0u;
    __syncthreads();
    XcdBarrier bar = xcd_barrier_post((unsigned*)(P.ws + OFF_CTL), misc);
#ifdef PROBE_PH
    unsigned long long pt0 = 0ull, pdt = 0ull;
#define MK_PROBE_BEGIN(k) if ((k) == PROBE_PH) pt0 = __builtin_amdgcn_s_memrealtime();
#define MK_PROBE_END(k) if ((k) == PROBE_PH) pdt = __builtin_amdgcn_s_memrealtime() - pt0;
#define MK_BAR_ALWAYS 1
#else
#define MK_PROBE_BEGIN(k)
#define MK_PROBE_END(k)
#define MK_BAR_ALWAYS 0
#endif
#define MK_PHASE(k)                                                                                           \
    if (ph_lo <= (k) && (k) < ph_hi) {                                                                        \
        const int npass = ((rep_mask >> (k)) & 1) ? 2 : 1;     \
        MK_PROBE_BEGIN(k)                                                                                     \
        for (int pass = 0; pass < npass; ++pass) {                                                            \
            int tq = tid;                                                                                     \
            asm volatile("" : "+v"(tq));                                                                      \
            run_phase(P, (k), pass, npass, lds, tq, misc);                                                    \
            if (MK_BAR_ALWAYS || pass + 1 < npass || (k) + 1 < ph_hi) xcd_barrier(bar);                        \
        }                                                                                                     \
        MK_PROBE_END(k)                                                                                       \
    }
    MK_PHASE(0) MK_PHASE(1) MK_PHASE(2) MK_PHASE(3) MK_PHASE(4) MK_PHASE(5) MK_PHASE(6) MK_PHASE(7) MK_PHASE(8) MK_PHASE(9)
#ifdef EXTRA_BARRIERS
    for (int q = 0; q < EXTRA_BARRIERS; ++q) xcd_barrier(bar);
#endif
#ifdef PROBE_P0
    if (blockIdx.x == PROBE_BLK) {
        const unsigned long long tend = __builtin_amdgcn_s_memrealtime() + 4ull * misc[PROBE_P0];
        while (__builtin_amdgcn_s_memrealtime() < tend) __builtin_amdgcn_s_sleep(20);
    }
#endif
#ifdef PROBE_HY
    if (blockIdx.x == 0) {
        const unsigned long long tend = __builtin_amdgcn_s_memrealtime() + (PROBE_HY > 0 ? (unsigned long long)PROBE_HY * misc[200] : (PROBE_HY == 0 ? (unsigned long long)misc[201] * 2000ull : (unsigned long long)misc[202]));
        while (__builtin_amdgcn_s_memrealtime() < tend) __builtin_amdgcn_s_sleep(20);
    }
#endif
#ifdef PROBE_PH
    if (blockIdx.x == 0) {
        const unsigned long long tend = __builtin_amdgcn_s_memrealtime() + 4ull * pdt;
        while (__builtin_amdgcn_s_memrealtime() < tend) __builtin_amdgcn_s_sleep(20);
    }
#endif
}

extern "C" void kernel_launch(void* const* d_in, const int* in_sizes, int n_in, void* d_out, int out_size, void* d_ws,
                              size_t ws_size, hipStream_t stream) {
    static int grid = 0;
    if (grid == 0) {
        int dev = 0, cus = 0, per_cu = 0;
        hipGetDevice(&dev);
        hipDeviceGetAttribute(&cus, hipDeviceAttributeMultiprocessorCount, dev);
        hipFuncSetAttribute((const void*)mk_fwd, hipFuncAttributeMaxDynamicSharedMemorySize, LDS_BYTES);
        hipOccupancyMaxActiveBlocksPerMultiprocessor(&per_cu, (const void*)mk_fwd, NTHR, LDS_BYTES);
        (void)hipGetLastError();
        grid = (per_cu >= 1 && ws_size >= WS_END && n_in == 37 && (cus % 8) == 0) ? cus : -1;
        if (grid < 0) fprintf(stderr, "kernel_launch: refusing to launch (per_cu %d, ws %zu, n_in %d)\n", per_cu, ws_size, n_in);
    }
    if (grid < 0) return;
    Params P{};
    for (int i = 0; i < 37; ++i) P.in[i] = (const float*)d_in[i];
    P.out = (float*)d_out;
    P.ws = (char*)d_ws;
    char* ws = (char*)d_ws;

    hipMemsetAsync(ws + OFF_CTL, 0, CTL_BYTES, stream);
    hipLaunchKernelGGL(mk_fwd, dim3(grid), dim3(NTHR), LDS_BYTES, stream, P, 0, NPHASE, REP_MASK);
}
```

```cpp
#include <hip/hip_runtime.h>
#include <math.h>
#include <stdint.h>
#include <stdio.h>

#define B_ 8
#define S_ 2048
#define D_ 1024
#define CT_ 256
#define NL_ (B_ * S_)
#define NC_ (B_ * CT_)
#define DIN_ 2560
#define NTHR 512
#ifndef REP_MASK
#define REP_MASK 0
#endif

typedef unsigned short bf16_t;
typedef __attribute__((ext_vector_type(8))) short bf16x8;
typedef __attribute__((ext_vector_type(16))) float f32x16;
typedef __attribute__((ext_vector_type(4))) float f32x4;
typedef __attribute__((ext_vector_type(4))) unsigned u32x4;
#define DI __device__ __forceinline__
#define MFMA32(a, b, c) __builtin_amdgcn_mfma_f32_32x32x16_bf16((a), (b), (c), 0, 0, 0)

DI bf16_t f2bf(float x) {
    unsigned u = __float_as_uint(x);
    u += 0x7fffu + ((u >> 16) & 1u);
    return (bf16_t)(u >> 16);
}
DI float bf2f(bf16_t v) { return __uint_as_float(((unsigned)v) << 16); }
DI unsigned pack2(float lo, float hi) { return (unsigned)f2bf(lo) | ((unsigned)f2bf(hi) << 16); }
DI float sigmoidf_(float x) { return 1.f / (1.f + expf(-x)); }
DI float shx(float v, int mask, int lane) { return __int_as_float(__builtin_amdgcn_ds_bpermute((lane ^ mask) << 2, __float_as_int(v))); }

#define OFF_CTL 0ull
#define CTL_BYTES 65536ull
#define OFF_MOD (OFF_CTL + CTL_BYTES)
#define OFF_PE (OFF_MOD + 262144ull)
#define OFF_HDN2 (OFF_PE + 131072ull)
#define OFF_NRM2 (OFF_HDN2 + 262144ull)
#define OFF_RALL (OFF_NRM2 + 8192ull)
#define OFF_WIN_T (OFF_RALL + 8404992ull)
#define OFF_WOUT_T (OFF_WIN_T + 5242880ull)
#define OFF_WRNN_T (OFF_WOUT_T + 2097152ull)
#define OFF_WR_T (OFF_WRNN_T + 262144ull)
#define OFF_WG_T (OFF_WR_T + 131072ull)
#define OFF_WU_T (OFF_WG_T + 33554432ull)
#define OFF_WD_T (OFF_WU_T + 33554432ull)
#define OFF_PHT (OFF_WD_T + 33554432ull)
#define OFF_PA (OFF_PHT + 50331648ull)
#define OFF_PU (OFF_PA + 16777216ull)
#define OFF_H1 (OFF_PU + 18874368ull)
#define OFF_HS (OFF_H1 + 37748736ull)
#define OFF_YBT (OFF_HS + 33554432ull)
#define OFF_H2 OFF_H1
#define OFF_YN (OFF_H1 + 0ull)
#define OFF_ACT OFF_HS
#define OFF_Y OFF_HS
#define OFF_SLOT OFF_PHT
#define OFF_LIST (OFF_YBT + 16777216ull)
#define OFF_TOKSLOT (OFF_LIST + 2097152ull)
#define OFF_EW (OFF_TOKSLOT + 131072ull)
#define OFF_EWS (OFF_EW + 131072ull)
#define WS_END (OFF_EWS + 131072ull)
#define QUEUE_WORD 4096

struct Params {
    const float* in[37];
    float* out;
    char* ws;
};

#define XB_TMO 128
#define XB_XCNT(j) (256 + 64 * (j))
#define XB_XSUB(j) (1280 + 64 * (j))
#define XB_XGEN(j) (2304 + 64 * (j))
#define XB_TOP 3328
#define XB_TOPGEN 3392
#define XCD_BAR_WORDS 3456
#define XB_SPIN_CAP (1u << 18)

DI unsigned xb_ld(unsigned* p) { return __hip_atomic_load(p, __ATOMIC_RELAXED, __HIP_MEMORY_SCOPE_AGENT); }
DI unsigned xb_add(unsigned* p, unsigned v) { return __hip_atomic_fetch_add(p, v, __ATOMIC_RELAXED, __HIP_MEMORY_SCOPE_AGENT); }
DI unsigned xb_xcc_id() { return (unsigned)__builtin_amdgcn_s_getreg((3 << 11) | 20) & 0xFu; }
#define XB_SPIN(cond, bar)                                                         \
    do {                                                                           \
        unsigned _sp = 0;                                                          \
        while (cond) {                                                             \
            __builtin_amdgcn_s_sleep(1);                                           \
            if ((++_sp & 255u) == 0u) {                                            \
                if (xb_ld(&(bar)[XB_TMO])) break;                                  \
                if (_sp > XB_SPIN_CAP) { atomicAdd(&(bar)[XB_TMO], 1u); break; }   \
            }                                                                      \
        }                                                                          \
    } while (0)

struct XcdBarrier {
    unsigned* bar;
    unsigned x;
    volatile unsigned* st;
};
DI XcdBarrier xcd_barrier_post(unsigned* bar, volatile unsigned* st) {
    XcdBarrier b;
    b.bar = bar;
    b.x = xb_xcc_id();
    b.st = st;
    if (threadIdx.x == 0) (void)xb_add(&bar[XB_XCNT(b.x)], 1u);
    return b;
}
DI void xcd_barrier_complete(unsigned* bar, unsigned x, unsigned& nloc, unsigned& nx) {
    const unsigned G = gridDim.x * gridDim.y * gridDim.z;
    unsigned sum, cnt, mine, sp = 0u;
    for (;;) {
        sum = 0u; cnt = 0u; mine = 0u;
#pragma unroll
        for (unsigned j = 0; j < 16; ++j) {
            const unsigned c = xb_ld(&bar[XB_XCNT(j)]);
            sum += c;
            cnt += (c > 0u) ? 1u : 0u;
            mine = (j == x) ? c : mine;
        }
        if (sum == G) break;
        __builtin_amdgcn_s_sleep(1);
        if ((++sp & 255u) == 0u) {
            if (xb_ld(&bar[XB_TMO])) break;
            if (sp > XB_SPIN_CAP) { atomicAdd(&bar[XB_TMO], 1u); break; }
        }
    }
    nloc = mine > 0u ? mine : 1u;
    nx = cnt > 0u ? cnt : 1u;
}
DI void xcd_barrier(const XcdBarrier& b) {
    asm volatile("s_waitcnt vmcnt(0)" ::: "memory");
    __syncthreads();
    if (threadIdx.x == 0) {
        unsigned* bar = b.bar;
        __builtin_amdgcn_s_waitcnt(0);
        unsigned nloc = b.st[0], nx = b.st[1];
        if (nloc == 0u) {
            xcd_barrier_complete(bar, b.x, nloc, nx);
            b.st[0] = nloc;
            b.st[1] = nx;
        }
        const unsigned old = xb_add(&bar[XB_XSUB(b.x)], 1u);
        const unsigned gen = old / nloc;
        if (old + 1u == (gen + 1u) * nloc) {
            __builtin_amdgcn_fence(__ATOMIC_RELEASE, "agent");
            asm volatile("s_waitcnt vmcnt(0)" ::: "memory");
            const unsigned og = xb_add(&bar[XB_TOP], 1u);
            const unsigned tg = og / nx;
            if (og + 1u == (tg + 1u) * nx) xb_add(&bar[XB_TOPGEN], 1u);
            else XB_SPIN(xb_ld(&bar[XB_TOPGEN]) == tg, bar);
            __builtin_amdgcn_fence(__ATOMIC_ACQUIRE, "agent");
            xb_add(&bar[XB_XGEN(b.x)], 1u);
            asm volatile("s_waitcnt vmcnt(0)" ::: "memory");
        } else {
            XB_SPIN(xb_ld(&bar[XB_XGEN(b.x)]) == gen, bar);
            __builtin_amdgcn_fence(__ATOMIC_ACQUIRE, "agent");
            asm volatile("s_waitcnt vmcnt(0)" ::: "memory");
        }
    }
    __syncthreads();
}

#define LDS_BYTES 163840
#define LDS_MISC (LDS_BYTES - 1024)
#define LROW 144
#define A_STAGE (256 * LROW)
#define B_STAGE (128 * LROW)
#define STAGE_BYTES (A_STAGE + B_STAGE)

DI void conv_tile(const float* src, int ld_src, bf16_t* dst, int ld_dst, const float* rowscale, float* l, int tid) {
    __syncthreads();
    {
        int r = tid >> 3, c0 = (tid & 7) * 8;
        const float4* s = (const float4*)(src + (size_t)r * ld_src + c0);
        float4 v0 = s[0], v1 = s[1];
        float sc = rowscale ? rowscale[r] : 1.f;
        float* d = l + r * 65 + c0;
        d[0] = v0.x * sc; d[1] = v0.y * sc; d[2] = v0.z * sc; d[3] = v0.w * sc;
        d[4] = v1.x * sc; d[5] = v1.y * sc; d[6] = v1.z * sc; d[7] = v1.w * sc;
    }
    __syncthreads();
    {
        int n = tid >> 3, k0 = (tid & 7) * 8;
        uint4 o;
        o.x = pack2(l[(k0 + 0) * 65 + n], l[(k0 + 1) * 65 + n]);
        o.y = pack2(l[(k0 + 2) * 65 + n], l[(k0 + 3) * 65 + n]);
        o.z = pack2(l[(k0 + 4) * 65 + n], l[(k0 + 5) * 65 + n]);
        o.w = pack2(l[(k0 + 6) * 65 + n], l[(k0 + 7) * 65 + n]);
        *(uint4*)(dst + (size_t)n * ld_dst + k0) = o;
    }
}

#define NCONV_RNN 32
DI void conv_item(const Params& P, int it, char* lds, int tid) {
    float* l = (float*)lds;
    const int hh = it & 7, gate = (it >> 3) & 1, dir = it >> 4;
    const float* src = (gate ? P.in[12] : P.in[10]) + (size_t)(dir * 8 + hh) * 4096;
    conv_tile(src, 64, (bf16_t*)(P.ws + OFF_WRNN_T) + (size_t)(hh * 256 + (dir * 2 + gate) * 64) * 64, 64, nullptr, l, tid);
}

#define NG_WIN 160
#define NG_WOUT 64
#define NG_EXP 1024
#define NG_TOTAL (NG_WIN + NG_WOUT + 3 * NG_EXP)
#define CV_LD 257
struct ConvDesc { const float* src; bf16_t* dst; const float* rs; int ld_src, ld_dst; };
DI ConvDesc conv_desc(const Params& P, int g) {
    ConvDesc d;
    d.rs = nullptr;
    if (g < NG_WIN) {
        const int kt = g / 10, ng = g % 10;
        d.src = P.in[7] + (size_t)kt * 64 * DIN_ + ng * 256; d.ld_src = DIN_;
        d.dst = (bf16_t*)(P.ws + OFF_WIN_T) + (size_t)ng * 256 * 1024 + kt * 64; d.ld_dst = 1024;
    } else if (g < NG_WIN + NG_WOUT) {
        g -= NG_WIN;
        const int kt = g >> 2, ng = g & 3;
        d.src = P.in[27] + (size_t)kt * 64 * 1024 + ng * 256; d.ld_src = 1024;
        d.dst = (bf16_t*)(P.ws + OFF_WOUT_T) + (size_t)ng * 256 * 1024 + kt * 64; d.ld_dst = 1024;
        d.rs = (kt < 8) ? P.in[25] + kt * 64 : P.in[26] + (kt - 8) * 64;
    } else {
        g -= NG_WIN + NG_WOUT;
        const int which = g >> 10, rem0 = g & 1023, e = rem0 >> 5, rem = rem0 & 31;
        if (which < 2) {
            const int kt = rem >> 1, ng = rem & 1;
            d.src = P.in[33 + which] + (size_t)e * 1024 * 512 + (size_t)kt * 64 * 512 + ng * 256; d.ld_src = 512;
            d.dst = (bf16_t*)(P.ws + (which ? OFF_WU_T : OFF_WG_T)) + (size_t)(e * 512 + ng * 256) * 1024 + kt * 64; d.ld_dst = 1024;
        } else {
            const int kt = rem >> 2, ng = rem & 3;
            d.src = P.in[35] + (size_t)e * 512 * 1024 + (size_t)kt * 64 * 1024 + ng * 256; d.ld_src = 1024;
            d.dst = (bf16_t*)(P.ws + OFF_WD_T) + (size_t)(e * 1024 + ng * 256) * 512 + kt * 64; d.ld_dst = 512;
        }
    }
    return d;
}
DI void conv_load(const ConvDesc& d, float4 (&r)[8], int tid) {
#pragma unroll
    for (int i = 0; i < 8; ++i) {
        const int q = tid + NTHR * i;
        r[i] = *(const float4*)(d.src + (size_t)(q >> 6) * d.ld_src + (q & 63) * 4);
    }
}
DI void conv_groups(const Params& P, int g0, int g1, int stride, char* lds, int tid) {
    float* l = (float*)lds;
    float4 r[8];
    int g = g0;
    ConvDesc d;
    if (g < g1) { d = conv_desc(P, g); conv_load(d, r, tid); }
    while (g < g1) {
        __syncthreads();
#pragma unroll
        for (int i = 0; i < 8; ++i) {
            const int q = tid + NTHR * i, row = q >> 6, c = (q & 63) * 4;
            const float sc = d.rs ? d.rs[row] : 1.f;
            float* p = l + row * CV_LD + c;
            p[0] = r[i].x * sc; p[1] = r[i].y * sc; p[2] = r[i].z * sc; p[3] = r[i].w * sc;
        }
        const ConvDesc dc = d;
        const int gn = g + stride;
        if (gn < g1) { d = conv_desc(P, gn); conv_load(d, r, tid); }
        __syncthreads();
#pragma unroll
        for (int i = 0; i < 4; ++i) {
            const int q = tid + NTHR * i, n = q >> 3, k0 = (q & 7) * 8;
            const float* p = l + k0 * CV_LD + n;
            uint4 o;
            o.x = pack2(p[0], p[CV_LD]);
            o.y = pack2(p[2 * CV_LD], p[3 * CV_LD]);
            o.z = pack2(p[4 * CV_LD], p[5 * CV_LD]);
            o.w = pack2(p[6 * CV_LD], p[7 * CV_LD]);
            *(uint4*)(dc.dst + (size_t)n * dc.ld_dst + k0) = o;
        }
        g = gn;
    }
}

DI void mod_item(const Params& P, int it, char* lds, int tid) {
    float* sl = (float*)lds;
    float* red = sl + 9 * 1024;
    __syncthreads();
    for (int i = tid; i < 9 * 1024; i += NTHR) {
        int r = i >> 10, k = i & 1023;
        float v = (r < 8) ? P.in[1][r * 1024 + k] : P.in[3][k];
        sl[i] = v * __builtin_amdgcn_rcpf(1.f + __expf(-v));
    }
    __syncthreads();
    const int w = tid >> 6, lane = tid & 63, col = lane & 31, kp = lane >> 5;
    const int n0 = it * 32;
    const float* wa = P.in[4] + n0 + col;
    float acc[9];
#pragma unroll
    for (int r = 0; r < 9; ++r) acc[r] = 0.f;
#pragma unroll 1
    for (int i0 = 0; i0 < 64; i0 += 32) {
        float wv[32];
#pragma unroll
        for (int q = 0; q < 32; ++q) wv[q] = wa[(size_t)(w * 128 + 2 * (i0 + q) + kp) * 6144];
#pragma unroll
        for (int q = 0; q < 32; ++q) {
            const int k = w * 128 + 2 * (i0 + q) + kp;
#pragma unroll
            for (int r = 0; r < 9; ++r) acc[r] += sl[r * 1024 + k] * wv[q];
        }
    }
#pragma unroll
    for (int r = 0; r < 9; ++r) {
        acc[r] += shx(acc[r], 32, lane);
        if (kp == 0) red[(w * 9 + r) * 32 + col] = acc[r];
    }
    __syncthreads();
    if (tid < 9 * 32) {
        int r = tid >> 5, c = tid & 31;
        float s = P.in[5][n0 + c];
#pragma unroll
        for (int ww = 0; ww < 8; ++ww) s += red[(ww * 9 + r) * 32 + c];
        ((float*)(P.ws + OFF_MOD))[r * 6144 + n0 + c] = s;
    }
}

DI void pe_item(const Params& P, int it, int tid) {
    int p = it, i = tid & 255;
    float omega = 1.0f / powf(10000.0f, (float)i / 256.0f);
    float ang = (float)p * omega;
    ((float*)(P.ws + OFF_PE))[p * 512 + tid] = (tid < 256) ? sinf(ang) : cosf(ang);
}

DI void hdn_item(const Params& P, int it, char* lds, int tid) {
    const int w = tid >> 6, j = tid & 63;
    float* w1s = (float*)lds;
    float* w2s = w1s + 33 * 64;
    float* zz = w2s + 64 * 64 + w * 128;
    float* h1s = zz + 64;
    __syncthreads();
    for (int i = tid; i < 33 * 64; i += NTHR) w1s[i] = P.in[16][i];
    for (int i = tid; i < 64 * 64; i += NTHR) w2s[i] = P.in[19][i];
    const float b1 = P.in[17][j], f1 = P.in[18][j], b2 = P.in[20][j], f2 = P.in[21][j];
    __syncthreads();
    for (int q = 0; q < 8; ++q) {
        const int t = it * 64 + w * 8 + q;
        if (j < 33) {
            float val;
            if (j == 0) val = (float)t / 2047.f;
            else {
                int bi = (j - 1) & 15;
                float freq = 1e-4f + (float)bi * ((15.f - 1e-4f) / 15.f);
                float ang = (6.283185307179586f * (float)t / 2048.f) * freq;
                val = (j <= 16) ? cosf(ang) : -sinf(ang);
            }
            zz[j] = val;
        }
        float acc = b1;
#pragma unroll 11
        for (int i = 0; i < 33; ++i) acc += zz[i] * w1s[i * 64 + j];
        h1s[j] = sinf(f1 * acc);
        acc = b2;
#pragma unroll 16
        for (int i = 0; i < 64; ++i) acc += h1s[i] * w2s[i * 64 + j];
        ((bf16_t*)(P.ws + OFF_HDN2))[t * 64 + j] = f2bf(sinf(f2 * acc));
    }
}

DI void wr_item(const Params& P, int j, int tid) {
    bf16_t* WRT = (bf16_t*)(P.ws + OFF_WR_T);
    {
        const int k = 16 * j + (tid >> 5), e = tid & 31;
        WRT[(4 + e) * 1024 + k] = f2bf(P.in[31][k * 32 + e]);
    }
    if (tid < 64) {
        const int k = 16 * j + (tid >> 2), n = tid & 3;
        WRT[n * 1024 + k] = f2bf(P.in[29][k * 4 + n]);
    }
    if (tid < 448) WRT[(36 + (tid >> 4)) * 1024 + 16 * j + (tid & 15)] = 0;
}
#define P0A_MOD 192
#define P0A_PE 128
#define P0A_HDN 32
#define P0A_GROUPS 2200
DI void phase0a(const Params& P, char* lds, int tid) {
#ifdef PROBE_P0
    const unsigned long long p0t0 = __builtin_amdgcn_s_memrealtime();
#endif
    const int total = P0A_MOD + P0A_PE + P0A_HDN + NCONV_RNN;
    if (gridDim.x == 256) {
        const int b = blockIdx.x;
        if (b < P0A_MOD) mod_item(P, b, lds, tid);
        else {
            const int j = b - P0A_MOD;
            pe_item(P, j, tid);
            wr_item(P, j, tid);
            if (j < P0A_HDN) hdn_item(P, j, lds, tid); else conv_item(P, j - P0A_HDN, lds, tid);
        }
    } else
    for (int it = blockIdx.x; it < total; it += gridDim.x) {
        if (it < P0A_MOD) mod_item(P, it, lds, tid);
        else if (it < P0A_MOD + P0A_PE) { if (it - P0A_MOD < 64) pe_item(P, it - P0A_MOD, tid); else wr_item(P, it - P0A_MOD - 64, tid); }
        else if (it < P0A_MOD + P0A_PE + P0A_HDN) hdn_item(P, it - P0A_MOD - P0A_PE, lds, tid);
        else conv_item(P, it - (P0A_MOD + P0A_PE + P0A_HDN), lds, tid);
    }
#ifdef PROBE_P0
    const unsigned long long p0t1 = __builtin_amdgcn_s_memrealtime();
#endif
    conv_groups(P, blockIdx.x, P0A_GROUPS, gridDim.x, lds, tid);
#ifdef PROBE_P0
    if (tid == 0) { volatile unsigned* mm = (volatile unsigned*)(lds + LDS_MISC); mm[203] = (unsigned)(p0t1 - p0t0); mm[204] = (unsigned)(__builtin_amdgcn_s_memrealtime() - p0t1); }
#endif
}

DI void h1_item(const Params& P, int it, int tid) {
    const int w = tid >> 6, lane = tid & 63;
    const int row = it * 8 + w;
    const bool lat = row < NL_;
    const float* src = lat ? P.in[0] + (size_t)row * D_ : P.in[2] + (size_t)(row - NL_) * D_;
    const int b = lat ? (row >> 11) : 8;
    const int t = row & 2047;
    const float* mod = (const float*)(P.ws + OFF_MOD) + b * 6144;
    const float* pe = (const float*)(P.ws + OFF_PE);
    const float* g = P.in[6];
    float v[16];
    float ss = 0.f;
#pragma unroll
    for (int i = 0; i < 2; ++i) {
        const int d = i * 512 + lane * 8;
        float4 x0 = *(const float4*)(src + d), x1 = *(const float4*)(src + d + 4);
        if (lat) {
            const float* pp = (i == 0) ? pe + (t >> 6) * 512 + d : pe + (t & 63) * 512 + (d - 512);
            const float4 p0 = *(const float4*)pp, p1 = *(const float4*)(pp + 4);
            x0.x += p0.x; x0.y += p0.y; x0.z += p0.z; x0.w += p0.w;
            x1.x += p1.x; x1.y += p1.y; x1.z += p1.z; x1.w += p1.w;
        }
        v[i * 8 + 0] = x0.x; v[i * 8 + 1] = x0.y; v[i * 8 + 2] = x0.z; v[i * 8 + 3] = x0.w;
        v[i * 8 + 4] = x1.x; v[i * 8 + 5] = x1.y; v[i * 8 + 6] = x1.z; v[i * 8 + 7] = x1.w;
        ss += x0.x * x0.x + x0.y * x0.y + x0.z * x0.z + x0.w * x0.w + x1.x * x1.x + x1.y * x1.y + x1.z * x1.z + x1.w * x1.w;
    }
#pragma unroll
    for (int o = 32; o > 0; o >>= 1) ss += shx(ss, o, lane);
    const float rstd = rsqrtf(ss * (1.f / 1024.f) + 1e-6f);
    bf16_t* dst = (bf16_t*)(P.ws + OFF_H1) + (size_t)row * D_;
#pragma unroll
    for (int i = 0; i < 2; ++i) {
        const int d = i * 512 + lane * 8;
        float o[8];
#pragma unroll
        for (int hh = 0; hh < 2; ++hh) {
            const float4 gv = *(const float4*)(g + d + 4 * hh), sh = *(const float4*)(mod + d + 4 * hh), sc = *(const float4*)(mod + 1024 + d + 4 * hh);
            o[4 * hh + 0] = v[i * 8 + 4 * hh + 0] * rstd * gv.x * (1.f + sc.x) + sh.x;
            o[4 * hh + 1] = v[i * 8 + 4 * hh + 1] * rstd * gv.y * (1.f + sc.y) + sh.y;
            o[4 * hh + 2] = v[i * 8 + 4 * hh + 2] * rstd * gv.z * (1.f + sc.z) + sh.z;
            o[4 * hh + 3] = v[i * 8 + 4 * hh + 3] * rstd * gv.w * (1.f + sc.w) + sh.w;
        }
        *(uint4*)(dst + d) = make_uint4(pack2(o[0], o[1]), pack2(o[2], o[3]), pack2(o[4], o[5]), pack2(o[6], o[7]));
    }
}
#define P0B_H1 ((NL_ + NC_) / 8)
#define P0B_TAPS 64
DI void taps_item(const Params& P, int it, char* lds, int tid);
DI void phase0b(const Params& P, char* lds, int tid) {
#ifdef PROBE_P0
    const unsigned long long p0t0 = __builtin_amdgcn_s_memrealtime();
#endif
    const int total = P0B_TAPS + P0B_H1;
    if (gridDim.x == 256) {
        const int b = blockIdx.x;
        if (b < P0B_TAPS) {
            taps_item(P, b, lds, tid);
            for (int q = 0; q < 3; ++q) h1_item(P, b * 3 + q, tid);
        } else {
            for (int q = 0; q < 11; ++q) h1_item(P, 192 + (b - P0B_TAPS) * 11 + q, tid);
        }
    } else
    for (int it = blockIdx.x; it < total; it += gridDim.x) {
        if (it < P0B_TAPS) taps_item(P, it, lds, tid);
        else h1_item(P, it - P0B_TAPS, tid);
    }
#ifdef PROBE_P0
    const unsigned long long p0t1 = __builtin_amdgcn_s_memrealtime();
#endif
    conv_groups(P, P0A_GROUPS + blockIdx.x, NG_TOTAL, gridDim.x, lds, tid);
#ifdef PROBE_P0
    if (tid == 0) { volatile unsigned* mm = (volatile unsigned*)(lds + LDS_MISC); mm[205] = (unsigned)(p0t1 - p0t0); mm[206] = (unsigned)(__builtin_amdgcn_s_memrealtime() - p0t1); }
#endif
}

namespace pg8 {
typedef f32x4 f32x4r;
#define PG8_LAS __attribute__((address_space(3)))
constexpr int BM = 256, BK = 64, HALF = 128, HTB = HALF * BK * 2, STAGE_BYTES8 = 8 * HTB;
DI int lds_byte(int r, int c) { const int st = (r >> 4) * 2 + (c >> 5), rr = r & 15, cc = c & 31, ob = rr * 64 + cc * 2; return st * 1024 + (ob ^ (((ob >> 9) & 1) << 5)); }
DI void stage_rc(int b, int& R, int& C) { const int st = b / 1024, sb = b % 1024, swz = sb ^ (((sb >> 9) & 1) << 5); R = (st >> 1) * 16 + swz / 64; C = (st & 1) * 32 + (swz % 64) / 2; }
DI int perm32(int rho) { const int n = rho >> 4, i = rho & 15; return 8 * (i >> 2) + 4 * n + (i & 3); }
DI unsigned cvt_pk_bf16(float lo, float hi) { unsigned r; asm volatile("v_cvt_pk_bf16_f32 %0, %1, %2" : "=v"(r) : "v"(lo), "v"(hi)); return r; }

struct GUnit { const char* A; const char* B; const char* B1; bf16_t* O; int ldc, valid, aux; const char* ga[2][2]; };
DI void stage_piece(int tid, int i, int& R, int& C) { stage_rc(tid * 16 + i * 8192, R, C); }

struct EpiStore {
    DI void operator()(const f32x4 (&acc)[2][2][4][2], const GUnit& u, int wr, int wc, int fr, int fq, char* lds) const {
        asm volatile("" : "+v"(fr), "+v"(fq));
#pragma unroll
        for (int ai = 0; ai < 2; ++ai)
#pragma unroll
            for (int m = 0; m < 4; ++m) {
                const int r = ai * HALF + wr * 64 + m * 16 + fr;
                bf16_t* rowp = u.O + (size_t)r * u.ldc + wc * 32 + 8 * fq;
                if (r < u.valid) {
#pragma unroll
                    for (int bj = 0; bj < 2; ++bj) {
                        const f32x4 v0 = acc[ai][bj][m][0], v1 = acc[ai][bj][m][1];
                        u32x4 w;
                        w.x = cvt_pk_bf16(v0[0], v0[1]); w.y = cvt_pk_bf16(v0[2], v0[3]); w.z = cvt_pk_bf16(v1[0], v1[1]); w.w = cvt_pk_bf16(v1[2], v1[3]);
                        *(u32x4*)(rowp + bj * HALF) = w;
                    }
                }
            }
    }
};

template <bool GATHER, class Epi, class Sched>
DI void gemm_phase(char* lds_generic, const int K, const Sched& S, const Epi& E, const int tid) {
    PG8_LAS unsigned char* lds = (PG8_LAS unsigned char*)lds_generic;
    const int wid = __builtin_amdgcn_readfirstlane(tid >> 6), lane = tid & 63, wr = wid >> 2, wc = wid & 3, fr = lane & 15, fq = lane >> 4;
    const int nt = K / BK;
    unsigned voffA[2], voffB[2];
#pragma unroll
    for (int i = 0; i < 2; ++i) {
        int R, C;
        stage_rc(tid * 16 + i * 8192, R, C);
        const int Rb = (R & ~31) + perm32(R & 31);
        voffA[i] = (unsigned)(R * K + C) * 2u;
        voffB[i] = (unsigned)(Rb * K + C) * 2u;
    }
    const size_t kstep = (size_t)(BK * 2);
    const size_t hstep = (size_t)HALF * K * 2;
    const unsigned ldsw = (unsigned)wid * 1024u;
    const int aoff = lds_byte(wr * 64 + fr, fq * 8), boff = lds_byte(wc * 32 + fr, fq * 8);
#define PG8_SA(b, h) (((b) * 2 + (h)) * HTB)
#define PG8_SB(b, h) ((4 + (b) * 2 + (h)) * HTB)
#define PG8_STAGE(bufoff, gbase, voff) do { _Pragma("unroll") for (int _i = 0; _i < 2; ++_i) \
        __builtin_amdgcn_global_load_lds((const unsigned*)((const char*)(gbase) + (voff)[_i]), (PG8_LAS unsigned*)(lds + (bufoff) + ldsw + _i * 8192), 16, 0, 0); } while (0)
#define PG8_STAGE_A(bufoff, uu, ubase, h, kb) do { _Pragma("unroll") for (int _i = 0; _i < 2; ++_i) { \
        const char* _p = GATHER ? (uu).ga[h][_i] + (kb) : (ubase) + (size_t)(h) * hstep + (kb) + voffA[_i]; \
        __builtin_amdgcn_global_load_lds((const unsigned*)_p, (PG8_LAS unsigned*)(lds + (bufoff) + ldsw + _i * 8192), 16, 0, 0); } } while (0)
#define PG8_LDA(dst, b, h) do { _Pragma("unroll") for (int m = 0; m < 4; ++m) _Pragma("unroll") for (int k = 0; k < 2; ++k) dst[m][k] = *(const PG8_LAS bf16x8*)(lds + PG8_SA(b, h) + aoff + m * 2048 + k * 1024); } while (0)
#define PG8_LDB(dst, b, h) do { _Pragma("unroll") for (int n = 0; n < 2; ++n) _Pragma("unroll") for (int k = 0; k < 2; ++k) dst[n][k] = *(const PG8_LAS bf16x8*)(lds + PG8_SB(b, h) + boff + n * 2048 + k * 1024); } while (0)
#define PG8_MMA(ai, bj, At, Bt) do { __builtin_amdgcn_s_setprio(1); _Pragma("unroll") for (int m = 0; m < 4; ++m) _Pragma("unroll") for (int n = 0; n < 2; ++n) _Pragma("unroll") for (int k = 0; k < 2; ++k) \
        acc[ai][bj][m][n] = __builtin_amdgcn_mfma_f32_16x16x32_bf16(Bt[n][k], At[m][k], acc[ai][bj][m][n], 0, 0, 0); __builtin_amdgcn_s_setprio(0); } while (0)
#define PG8_WAIT_V(n) asm volatile("s_waitcnt vmcnt(" #n ")" ::: "memory")
#define PG8_WAIT_L(n) asm volatile("s_waitcnt lgkmcnt(" #n ")" ::: "memory")
#define PG8_BAR __builtin_amdgcn_s_barrier()
#define PG8_SCHED __builtin_amdgcn_sched_barrier(0)
    GUnit cur, nxt;
    int ui = 0;
    if (!S.next(0, cur)) return;
    f32x4 acc[2][2][4][2];
#pragma unroll
    for (int a = 0; a < 2; ++a)
#pragma unroll
        for (int b = 0; b < 2; ++b)
#pragma unroll
            for (int m = 0; m < 4; ++m)
#pragma unroll
                for (int n = 0; n < 2; ++n) acc[a][b][m][n] = (f32x4){0.f, 0.f, 0.f, 0.f};
    bf16x8 At[4][2], B0[2][2], B1[2][2];
    PG8_STAGE(PG8_SB(0, 0), cur.B, voffB); PG8_STAGE_A(PG8_SA(0, 0), cur, cur.A, 0, 0); PG8_STAGE(PG8_SB(0, 1), cur.B1, voffB); PG8_STAGE_A(PG8_SA(0, 1), cur, cur.A, 1, 0);
    if (wr == 1) PG8_BAR;
    PG8_WAIT_V(4); PG8_BAR;
    PG8_STAGE(PG8_SB(1, 0), cur.B + kstep, voffB); PG8_STAGE_A(PG8_SA(1, 0), cur, cur.A, 0, kstep); PG8_STAGE(PG8_SB(1, 1), cur.B1 + kstep, voffB);
    PG8_WAIT_V(6); PG8_BAR;
    for (;;) {
        const bool has_next = S.next(ui + 1, nxt);
        if (!has_next) {
            nxt.A = cur.A; nxt.B = cur.B; nxt.B1 = cur.B1;
            if (GATHER) { nxt.ga[0][0] = cur.ga[0][0]; nxt.ga[0][1] = cur.ga[0][1]; nxt.ga[1][0] = cur.ga[1][0]; nxt.ga[1][1] = cur.ga[1][1]; }
        }
        for (int t = 0; t < nt; t += 2) {
            const bool last = (t == nt - 2);
            const size_t k2 = last ? (size_t)0 : (size_t)(t + 2) * kstep;
            const size_t k1 = (size_t)(t + 1) * kstep, k3 = k2 + kstep;
            struct { const char* A; const char* B; const char* B1; const char* ga[2][2]; } w2;
            w2.A = last ? nxt.A : cur.A; w2.B = last ? nxt.B : cur.B; w2.B1 = last ? nxt.B1 : cur.B1;
            if (GATHER) {
                w2.ga[0][0] = last ? nxt.ga[0][0] : cur.ga[0][0]; w2.ga[0][1] = last ? nxt.ga[0][1] : cur.ga[0][1];
                w2.ga[1][0] = last ? nxt.ga[1][0] : cur.ga[1][0]; w2.ga[1][1] = last ? nxt.ga[1][1] : cur.ga[1][1];
            }
            PG8_LDB(B0, 0, 0); PG8_SCHED; PG8_LDA(At, 0, 0); PG8_STAGE_A(PG8_SA(1, 1), cur, cur.A, 1, k1);
            PG8_WAIT_L(8); PG8_BAR; PG8_WAIT_L(0); PG8_MMA(0, 0, At, B0); PG8_BAR; PG8_SCHED;
            PG8_LDB(B1, 0, 1); PG8_STAGE(PG8_SB(0, 0), w2.B + k2, voffB);
            PG8_BAR; PG8_WAIT_L(0); PG8_MMA(0, 1, At, B1); PG8_BAR;
            PG8_LDA(At, 0, 1); PG8_STAGE_A(PG8_SA(0, 0), w2, w2.A, 0, k2);
            PG8_BAR; PG8_WAIT_L(0); PG8_MMA(1, 0, At, B0); PG8_BAR; PG8_SCHED;
            PG8_STAGE(PG8_SB(0, 1), w2.B1 + k2, voffB);
            PG8_WAIT_V(6); PG8_BAR; PG8_MMA(1, 1, At, B1); PG8_BAR;
            PG8_LDB(B0, 1, 0); PG8_SCHED; PG8_LDA(At, 1, 0); PG8_STAGE_A(PG8_SA(0, 1), w2, w2.A, 1, k2);
            PG8_WAIT_L(8); PG8_BAR; PG8_WAIT_L(0); PG8_MMA(0, 0, At, B0); PG8_BAR; PG8_SCHED;
            PG8_LDB(B1, 1, 1); PG8_STAGE(PG8_SB(1, 0), w2.B + k3, voffB);
            PG8_BAR; PG8_WAIT_L(0); PG8_MMA(0, 1, At, B1); PG8_BAR;
            PG8_LDA(At, 1, 1); PG8_STAGE_A(PG8_SA(1, 0), w2, w2.A, 0, k3);
            PG8_BAR; PG8_WAIT_L(0); PG8_MMA(1, 0, At, B0); PG8_BAR; PG8_SCHED;
            PG8_STAGE(PG8_SB(1, 1), w2.B1 + k3, voffB);
            PG8_WAIT_V(6); PG8_BAR; PG8_MMA(1, 1, At, B1); PG8_BAR;
        }
        E(acc, cur, wr, wc, fr, fq, lds_generic);
        if (!has_next) break;
#pragma unroll
        for (int a = 0; a < 2; ++a)
#pragma unroll
            for (int b = 0; b < 2; ++b)
#pragma unroll
                for (int m = 0; m < 4; ++m)
#pragma unroll
                    for (int n = 0; n < 2; ++n) acc[a][b][m][n] = (f32x4){0.f, 0.f, 0.f, 0.f};
        cur.A = nxt.A; cur.B = nxt.B; cur.B1 = nxt.B1; cur.O = nxt.O; cur.ldc = nxt.ldc; cur.valid = nxt.valid; cur.aux = nxt.aux;
        if (GATHER) { cur.ga[0][0] = nxt.ga[0][0]; cur.ga[0][1] = nxt.ga[0][1]; cur.ga[1][0] = nxt.ga[1][0]; cur.ga[1][1] = nxt.ga[1][1]; }
        ++ui;
    }
    PG8_WAIT_V(0);
    if (wr == 0) PG8_BAR;
    PG8_BAR;
#undef PG8_SA
#undef PG8_SB
#undef PG8_STAGE
#undef PG8_STAGE_A
#undef PG8_LDA
#undef PG8_LDB
#undef PG8_MMA
#undef PG8_WAIT_V
#undef PG8_WAIT_L
#undef PG8_BAR
#undef PG8_SCHED
}
}

struct GPtr { const bf16_t* a[4]; const bf16_t* b[2]; };
#define GC_LOAD(SI, kt_)                                                                                 \
    do {                                                                                                  \
        const int ko_ = (kt_) * 64;                                                                       \
        S[SI][0] = *(const u32x4*)(g.a[0] + ko_); S[SI][1] = *(const u32x4*)(g.a[1] + ko_);               \
        S[SI][2] = *(const u32x4*)(g.a[2] + ko_); S[SI][3] = *(const u32x4*)(g.a[3] + ko_);               \
        S[SI][4] = *(const u32x4*)(g.b[0] + ko_); S[SI][5] = *(const u32x4*)(g.b[1] + ko_);               \
    } while (0)
#define GC_STORE(SI, st_)                                                                                 \
    do {                                                                                                  \
        char* s2_ = lds + (st_) * STAGE_BYTES;                                                            \
        *(u32x4*)(s2_ + a_w) = S[SI][0]; *(u32x4*)(s2_ + a_w + 64 * LROW) = S[SI][1];                      \
        *(u32x4*)(s2_ + a_w + 128 * LROW) = S[SI][2]; *(u32x4*)(s2_ + a_w + 192 * LROW) = S[SI][3];        \
        *(u32x4*)(s2_ + b_w) = S[SI][4]; *(u32x4*)(s2_ + b_w + 64 * LROW) = S[SI][5];                      \
    } while (0)
#define GC_BODY(kt_, SL, SS)                                                                              \
    do {                                                                                                  \
        if ((kt_) + 3 < nk) GC_LOAD(SL, (kt_) + 3);                                                       \
        const char* s_ = lds + ((kt_) & 1) * STAGE_BYTES;                                                 \
        _Pragma("unroll") for (int ks = 0; ks < 4; ++ks) {                                                \
            const bf16x8 fa0 = *(const bf16x8*)(s_ + a_r + ks * 32);                                      \
            const bf16x8 fa1 = *(const bf16x8*)(s_ + a_r + 32 * LROW + ks * 32);                          \
            const bf16x8 fb0 = *(const bf16x8*)(s_ + b_r + ks * 32);                                      \
            const bf16x8 fb1 = *(const bf16x8*)(s_ + b_r + 32 * LROW + ks * 32);                          \
            if (SWAP) {                                                                                   \
                acc[0][0] = MFMA32(fb0, fa0, acc[0][0]); acc[0][1] = MFMA32(fb1, fa0, acc[0][1]);         \
                acc[1][0] = MFMA32(fb0, fa1, acc[1][0]); acc[1][1] = MFMA32(fb1, fa1, acc[1][1]);         \
            } else {                                                                                      \
                acc[0][0] = MFMA32(fa0, fb0, acc[0][0]); acc[0][1] = MFMA32(fa0, fb1, acc[0][1]);         \
                acc[1][0] = MFMA32(fa1, fb0, acc[1][0]); acc[1][1] = MFMA32(fa1, fb1, acc[1][1]);         \
            }                                                                                             \
        }                                                                                                 \
        if ((kt_) + 1 < nk) GC_STORE(SS, ((kt_) + 1) & 1);                                                \
        __syncthreads();                                                                                  \
    } while (0)

DI void gemm_issue(u32x4 (&S)[3][6], const GPtr& g) {
    GC_LOAD(0, 0);
    GC_LOAD(1, 1);
    GC_LOAD(2, 2);
}
template <bool SWAP>
DI void gemm_run(f32x16 (&acc)[2][2], u32x4 (&S)[3][6], const GPtr& g, int nk, char* lds, int tid) {
    const int lrow = tid >> 3, lchunk = tid & 7;
    const unsigned a_w = lrow * LROW + lchunk * 16;
    const unsigned b_w = A_STAGE + lrow * LROW + lchunk * 16;
    const int lane = tid & 63, w = tid >> 6, wm = w >> 1, wn = w & 1, r = lane & 31, h = lane >> 5;
    const unsigned a_r = (wm * 64 + r) * LROW + h * 16;
    const unsigned b_r = A_STAGE + (wn * 64 + r) * LROW + h * 16;
#pragma unroll
    for (int i = 0; i < 2; ++i)
#pragma unroll
        for (int j = 0; j < 2; ++j)
#pragma unroll
            for (int e = 0; e < 16; ++e) acc[i][j][e] = 0.f;
    __syncthreads();
    GC_STORE(0, 0);
    __syncthreads();
    for (int kt = 0; kt < nk; kt += 3) {
        GC_BODY(kt, 0, 1);
        if (kt + 1 < nk) GC_BODY(kt + 1, 1, 2);
        if (kt + 2 < nk) GC_BODY(kt + 2, 2, 0);
    }
}

#define ET_ROW 272
#define ETS_ROW 528
DI void acc_to_lds_tok(const f32x16 (&acc)[2][2], char* lds, int wm, int wn, int r, int h) {
#pragma unroll
    for (int i = 0; i < 2; ++i)
#pragma unroll
        for (int j = 0; j < 2; ++j)
#pragma unroll
            for (int g = 0; g < 4; ++g)
                *(uint2*)(lds + (wm * 64 + i * 32 + r) * ET_ROW + (wn * 64 + j * 32 + 8 * g + 4 * h) * 2) =
                    make_uint2(pack2(acc[i][j][4 * g], acc[i][j][4 * g + 1]), pack2(acc[i][j][4 * g + 2], acc[i][j][4 * g + 3]));
}
DI void acc_to_lds_chan(const f32x16 (&acc)[2][2], char* lds, int wm, int wn, int r, int h) {
#pragma unroll
    for (int i = 0; i < 2; ++i)
#pragma unroll
        for (int j = 0; j < 2; ++j)
#pragma unroll
            for (int g = 0; g < 4; ++g)
                *(uint2*)(lds + (wn * 64 + j * 32 + r) * ETS_ROW + (wm * 64 + i * 32 + 8 * g + 4 * h) * 2) =
                    make_uint2(pack2(acc[i][j][4 * g], acc[i][j][4 * g + 1]), pack2(acc[i][j][4 * g + 2], acc[i][j][4 * g + 3]));
}
DI void lds_to_rows(char* lds, bf16_t* dst, int ld, int valid, int tid) {
#pragma unroll
    for (int i = 0; i < 8; ++i) {
        const int q = tid + NTHR * i, row = q >> 4, ch = q & 15;
        if (row < valid) *(uint4*)(dst + (size_t)row * ld + ch * 8) = *(const uint4*)(lds + row * ET_ROW + ch * 16);
    }
}

struct P1Sched {
    const char* h1; const char* wt; bf16_t* pa; bf16_t* pu; bf16_t* pht; int x, j, nj;
    DI bool next(int i, pg8::GUnit& u) const {
        const int k = j + i * nj;
        if (k >= 82) return false;
        u.valid = 256; u.aux = 0;
        if (k < 32) {
            const int pm = (k >> 2) * 8 + x, pn = k & 3;
            u.A = h1 + (size_t)pm * 256 * 2048;
            u.B = wt + (size_t)pn * 256 * 2048;
            u.B1 = u.B + (size_t)128 * 2048;
            u.O = ((pn < 2) ? pa + pn * 256 : pu + (pn - 2) * 256) + (size_t)pm * 256 * 512;
            u.ldc = 512;
        } else if (k < 34) {
            const int pn = k - 32;
            u.A = h1 + (size_t)(NL_ + x * 256) * 2048;
            u.B = wt + (size_t)(512 + pn * 256) * 2048;
            u.B1 = u.B + (size_t)128 * 2048;
            u.O = pu + (size_t)(NL_ + x * 256) * 512 + pn * 256;
            u.ldc = 512;
        } else {
            const int k2 = k - 34, tt = (k2 / 6) * 8 + x, pm = k2 % 6;
            u.A = wt + (size_t)(1024 + pm * 256) * 2048;
            u.B = h1 + (size_t)tt * 256 * 2048;
            u.B1 = u.B + (size_t)128 * 2048;
            u.O = pht + (size_t)pm * 256 * NL_ + tt * 256;
            u.ldc = NL_;
        }
        return true;
    }
};
DI void phase1(const Params& P, char* lds, int tid) {
    char* ws = P.ws;
    P1Sched S{ws + OFF_H1, ws + OFF_WIN_T, (bf16_t*)(ws + OFF_PA), (bf16_t*)(ws + OFF_PU), (bf16_t*)(ws + OFF_PHT),
              (int)(blockIdx.x & 7), (int)(blockIdx.x >> 3), (int)(gridDim.x >> 3)};
    pg8::EpiStore E;
    pg8::gemm_phase<false>(lds, 1024, S, E, tid);
}

DI int crow(int e, int h) { return (e & 3) + 8 * (e >> 2) + 4 * h; }

DI void taps_item(const Params& P, int it, char* lds, int tid) {
    const int lane = tid & 63, w = __builtin_amdgcn_readfirstlane(tid >> 6), r = lane & 31, h = lane >> 5;
    const int col0 = it * 32;
    const int dir = col0 >> 10, o = (col0 >> 9) & 1;
    const float* w3 = P.in[22];
    const float* b3 = P.in[23];
    const bf16_t* HB = (const bf16_t*)(P.ws + OFF_HDN2);
    bf16_t* RALL = (bf16_t*)(P.ws + OFF_RALL);
    float* red = (float*)lds;
    __syncthreads();
    bf16x8 fa[4];
#pragma unroll
    for (int ks = 0; ks < 4; ++ks)
#pragma unroll
        for (int j = 0; j < 8; ++j) fa[ks][j] = (short)f2bf(w3[(size_t)(16 * ks + 8 * h + j) * 2048 + col0 + r]);
    float s[16];
#pragma unroll
    for (int e = 0; e < 16; ++e) s[e] = 0.f;
    const float mind = -3.0701134573253945f, maxd = -15.350567286626973f;
    for (int q = 0; q < 8; ++q) {
        const int t0 = (w * 8 + q) * 32, t = t0 + r;
        f32x16 acc;
#pragma unroll
        for (int e = 0; e < 16; ++e) acc[e] = 0.f;
#pragma unroll
        for (int ks = 0; ks < 4; ++ks) {
            bf16x8 fb = *(const bf16x8*)(HB + (size_t)t * 64 + 16 * ks + 8 * h);
            acc = MFMA32(fa[ks], fb, acc);
        }
        const float tt = (float)t / 2047.f;
        const bool valid = !(dir == 1 && t == 0);
#pragma unroll
        for (int e = 0; e < 16; ++e) {
            const int col = col0 + crow(e, h);
            const int c = col & 511;
            const float delta = fabsf(mind + (float)c * ((maxd - mind) / 511.f));
            const float val = (acc[e] + b3[col]) * __expf(-tt * delta);
            if (valid) s[e] += fabsf(val);
            *(bf16_t*)(lds + 4096 + crow(e, h) * 4112 + (dir ? t : 2048 - t) * 2) = f2bf(valid ? val : 0.f);
        }
    }
#pragma unroll
    for (int e = 0; e < 16; ++e) {
        float v = s[e];
        v += shx(v, 16, lane); v += shx(v, 8, lane); v += shx(v, 4, lane); v += shx(v, 2, lane); v += shx(v, 1, lane);
        if (r == 0) red[w * 32 + crow(e, h)] = v;
    }
    if (dir == 0 && tid < 32) *(bf16_t*)(lds + 4096 + tid * 4112) = 0;
    __syncthreads();
    if (tid < 32) {
        float v = 0.f;
#pragma unroll
        for (int ww = 0; ww < 8; ++ww) v += red[ww * 32 + tid];
        const int c = (col0 + tid) & 511;
        ((float*)(P.ws + OFF_NRM2))[(dir * 2 + o) * 512 + c] = v;
        bf16_t* R = RALL + (size_t)(c * 2 + o) * 4104;
        const bf16_t* img = (const bf16_t*)(lds + 4096 + tid * 4112);
        if (dir == 0) {
            R[2048] = img[2048];
            unsigned z = 0u;
            asm volatile("" : "+v"(z));
            *(uint4*)(R + 4096) = make_uint4(z, z, z, z);
        } else {
#pragma unroll
            for (int k = 1; k < 8; ++k) R[2048 + k] = img[k];
        }
    }
    for (int q = tid; q < 32 * 256; q += NTHR) {
        const int cl = q >> 8, k = q & 255;
        if (dir == 1 && k == 0) continue;
        const int c = (col0 + cl) & 511;
        *(uint4*)(RALL + (size_t)(c * 2 + o) * 4104 + (dir ? 2048 : 0) + 8 * k) = *(const uint4*)(lds + 4096 + cl * 4112 + 16 * k);
    }
}

#define HY_G 0
#define HY_GSTRIDE 8448
#define HY_GOFF(sh) ((0x8D518D50u >> (4 * (sh))) & 15u)
#define HY_U 67584
#define HY_UROW 6160
#define HY_PAD 15
#define HY_GATE (HY_U + 8 * HY_UROW)

DI void conv32(const bf16_t* src, int J, float w0, float w1, float w2, uint4 (&o)[4]) {
    const uint4* p = (const uint4*)(src + 32 * J);
    const uint4 q0 = p[0], q1 = p[1], q2 = p[2], q3 = p[3];
    const float prev = (J > 0) ? bf2f(src[32 * J - 1]) : 0.f;
    const float next = (J < 63) ? bf2f(src[32 * J + 32]) : 0.f;
    const unsigned wv[16] = {q0.x, q0.y, q0.z, q0.w, q1.x, q1.y, q1.z, q1.w, q2.x, q2.y, q2.z, q2.w, q3.x, q3.y, q3.z, q3.w};
    float x[34];
    x[0] = prev;
#pragma unroll
    for (int i = 0; i < 16; ++i) {
        x[1 + 2 * i] = __uint_as_float(wv[i] << 16);
        x[2 + 2 * i] = __uint_as_float(wv[i] & 0xffff0000u);
    }
    x[33] = next;
    unsigned y[16];
#pragma unroll
    for (int i = 0; i < 16; ++i) {
        const float a = w0 * x[2 * i] + w1 * x[2 * i + 1] + w2 * x[2 * i + 2];
        const float b = w0 * x[2 * i + 1] + w1 * x[2 * i + 2] + w2 * x[2 * i + 3];
        y[i] = pack2(a, b);
    }
    o[0] = make_uint4(y[0], y[1], y[2], y[3]);
    o[1] = make_uint4(y[4], y[5], y[6], y[7]);
    o[2] = make_uint4(y[8], y[9], y[10], y[11]);
    o[3] = make_uint4(y[12], y[13], y[14], y[15]);
}

DI void hyena_item(const Params& P, int c, char* lds, int tid) {
#ifdef PROBE_HY
    const unsigned long long hy_it0 = __builtin_amdgcn_s_memrealtime();
#endif
    const bf16_t* PHT = (const bf16_t*)(P.ws + OFF_PHT);
    const bf16_t* RALL = (const bf16_t*)(P.ws + OFF_RALL) + (size_t)c * 2 * 4104;
    const float* NRM2 = (const float*)(P.ws + OFF_NRM2);
    bf16_t* YBT = (bf16_t*)(P.ws + OFF_YBT);
    const float* cw = P.in[15];
    const int lane = tid & 63;
    const int w = __builtin_amdgcn_readfirstlane(tid >> 6);
    const int g = w & 3, par = w >> 2;
    const int h = lane >> 5, i_ = lane & 31;
    const int lb = tid >> 6, lJ = tid & 63;
    __syncthreads();
    for (int q = tid; q < 8 * 2 * 60; q += NTHR) {
        const int b = q / 120, rem = q % 120, side = rem / 60, k = rem % 60;
        *(uint4*)(lds + HY_U + b * HY_UROW + (side ? (HY_PAD + 64) * 64 : 0) + k * 16) = make_uint4(0u, 0u, 0u, 0u);
    }
    {
        uint4 o[4];
        conv32(PHT + (size_t)c * NL_ + lb * S_, lJ, cw[c], cw[1536 + c], cw[3072 + c], o);
        uint4* d = (uint4*)(lds + HY_U + lb * HY_UROW + (HY_PAD + lJ) * 64);
        d[0] = o[0]; d[1] = o[1]; d[2] = o[2]; d[3] = o[3];
        conv32(PHT + (size_t)(512 + c) * NL_ + lb * S_, lJ, cw[512 + c], cw[1536 + 512 + c], cw[3072 + 512 + c], o);
        uint4* e = (uint4*)(lds + HY_GATE + lb * 4096 + lJ * 64);
        e[0] = o[0]; e[1] = o[1]; e[2] = o[2]; e[3] = o[3];
    }
    const int sh_ = (-i_) & 7;
    const int a_base = HY_G + sh_ * HY_GSTRIDE + (int)HY_GOFF(sh_) * 16 + (2048 - i_ + 8 * h - sh_) * 2;
    const int batch = i_ >> 2, blk = i_ & 3;
    const int b_base = HY_U + batch * HY_UROW + ((HY_PAD + blk) * 32 + 8 * h) * 2;
    for (int o_ = 0; o_ < 2; ++o_) {
        __syncthreads();
        if (o_ == 1) {
            uint4 o[4];
            conv32(PHT + (size_t)(1024 + c) * NL_ + lb * S_, lJ, cw[1024 + c], cw[1536 + 1024 + c], cw[3072 + 1024 + c], o);
            uint4* e = (uint4*)(lds + HY_GATE + lb * 4096 + lJ * 64);
            e[0] = o[0]; e[1] = o[1]; e[2] = o[2]; e[3] = o[3];
        }
        {
            const uint4* Rg = (const uint4*)(RALL + (size_t)o_ * 4104);
            const uint4 lo = Rg[tid], hi = Rg[tid + 1];
            const unsigned wv[8] = {lo.x, lo.y, lo.z, lo.w, hi.x, hi.y, hi.z, hi.w};
#pragma unroll
            for (int sh = 0; sh < 8; ++sh) {
                const int s2 = sh >> 1;
                uint4 ov;
                if (sh & 1) {
                    ov.x = (wv[s2] >> 16) | (wv[s2 + 1] << 16);
                    ov.y = (wv[s2 + 1] >> 16) | (wv[s2 + 2] << 16);
                    ov.z = (wv[s2 + 2] >> 16) | (wv[s2 + 3] << 16);
                    ov.w = (wv[s2 + 3] >> 16) | (wv[s2 + 4] << 16);
                } else {
                    ov = make_uint4(wv[s2], wv[s2 + 1], wv[s2 + 2], wv[s2 + 3]);
                }
                *(uint4*)(lds + HY_G + sh * HY_GSTRIDE + (int)HY_GOFF(sh) * 16 + tid * 16) = ov;
            }
        }
        __syncthreads();
        f32x16 acc[4];
#pragma unroll
        for (int tt = 0; tt < 4; ++tt)
#pragma unroll
            for (int e = 0; e < 16; ++e) acc[tt][e] = 0.f;
#ifdef PROBE_HY
        unsigned long long hy_t0 = __builtin_amdgcn_s_memrealtime();
#endif
#pragma unroll 2
        for (int D = 16 * g - 63 + par; D <= 16 * g + 15; D += 2) {
#pragma unroll
            for (int ks = 0; ks < 2; ++ks) {
                const bf16x8 fa = *(const bf16x8*)(lds + a_base + (-64 * D + 32 * ks));
#pragma unroll
                for (int tt = 0; tt < 4; ++tt) {
                    const bf16x8 fb = *(const bf16x8*)(lds + b_base + ((4 * (4 * g + tt) - D) * 64 + 32 * ks));
                    acc[tt] = MFMA32(fa, fb, acc[tt]);
                }
            }
        }
        __syncthreads();
#ifdef PROBE_HY
        if (tid == 0) { volatile unsigned* mm = (volatile unsigned*)(lds + LDS_MISC); mm[200] += (unsigned)(__builtin_amdgcn_s_memrealtime() - hy_t0); mm[201] += 1u; }
#endif
        float* scr = (float*)(lds + HY_G);
        if (par == 1) {
#pragma unroll
            for (int tt = 0; tt < 4; ++tt)
#pragma unroll
                for (int e = 0; e < 16; ++e) scr[((g * 4 + tt) * 16 + e) * 64 + lane] = acc[tt][e];
        }
        __syncthreads();
        if (par == 0) {
            const float inv = 1.f / (NRM2[(0 * 2 + o_) * 512 + c] + NRM2[(1 * 2 + o_) * 512 + c]);
            const float bias = P.in[24][o_ * 512 + c];
#pragma unroll
            for (int tt = 0; tt < 4; ++tt) {
                const int I = 4 * (4 * g + tt) + blk;
#pragma unroll
                for (int q = 0; q < 4; ++q) {
                    const int i0 = 8 * q + 4 * h;
                    char* up = lds + HY_U + batch * HY_UROW + ((HY_PAD + I) * 32 + i0) * 2;
                    const uint2 uu = *(const uint2*)up;
                    const uint2 gg = *(const uint2*)(lds + HY_GATE + batch * 4096 + (32 * I + i0) * 2);
                    float rr[4];
#pragma unroll
                    for (int e = 0; e < 4; ++e) {
                        const float a = acc[tt][4 * q + e] + scr[((g * 4 + tt) * 16 + 4 * q + e) * 64 + lane];
                        const unsigned uw = (e < 2) ? uu.x : uu.y, gw = (e < 2) ? gg.x : gg.y;
                        const float uf = (e & 1) ? __uint_as_float(uw & 0xffff0000u) : __uint_as_float(uw << 16);
                        const float gf = (e & 1) ? __uint_as_float(gw & 0xffff0000u) : __uint_as_float(gw << 16);
                        rr[e] = gf * (a * inv + uf * bias);
                    }
                    uint2 ov;
                    ov.x = pack2(rr[0], rr[1]);
                    ov.y = pack2(rr[2], rr[3]);
                    *(uint2*)up = ov;
                }
            }
        }
    }
    __syncthreads();
    {
        const uint4* sp = (const uint4*)(lds + HY_U + lb * HY_UROW + (HY_PAD + lJ) * 64);
        uint4* gp = (uint4*)(YBT + (size_t)c * NL_ + lb * S_ + lJ * 32);
        gp[0] = sp[0]; gp[1] = sp[1]; gp[2] = sp[2]; gp[3] = sp[3];
    }
#ifdef PROBE_HY
    if (tid == 0) { volatile unsigned* mm = (volatile unsigned*)(lds + LDS_MISC); mm[202] += (unsigned)(__builtin_amdgcn_s_memrealtime() - hy_it0); }
#endif
}

#define RN_V 0
#define RN_W 36864
#define RN_AGG 55296
#define RN_CARRY 59392

DI void rnn_item(const Params& P, int it, char* lds, int tid) {
    const int b = it >> 4, hd = (it >> 1) & 7, dir = it & 1;
    const bf16_t* PU = (const bf16_t*)(P.ws + OFF_PU);
    const bf16_t* WR = (const bf16_t*)(P.ws + OFF_WRNN_T);
    bf16_t* HS = (bf16_t*)(P.ws + OFF_HS) + (size_t)dir * NL_ * 512;
    const int lane = tid & 63, w = __builtin_amdgcn_readfirstlane(tid >> 6), r = lane & 31, h = lane >> 5;
    float* AGG = (float*)(lds + RN_AGG);
    float* CARRY = (float*)(lds + RN_CARRY);
    __syncthreads();
    for (int q = tid; q < 1024; q += NTHR) {
        const int n = q >> 3, ch = q & 7;
        *(uint4*)(lds + RN_W + n * LROW + ch * 16) = *(const uint4*)(WR + (size_t)(hd * 256 + dir * 128 + n) * 64 + ch * 8);
    }
    if (tid < 64) CARRY[tid] = 0.f;
    float ba[2], bx[2], sp[2];
#pragma unroll
    for (int jh = 0; jh < 2; ++jh) {
        const int ch = hd * 64 + jh * 32 + r;
        ba[jh] = P.in[11][dir * 512 + ch];
        bx[jh] = P.in[13][dir * 512 + ch];
        sp[jh] = log1pf(expf(-P.in[14][dir * 512 + ch]));
    }
    const int cc = tid & 7, tg = tid >> 3;
    for (int ci = 0; ci < 9; ++ci) {
        const bool isctx = (ci == 0);
        const int n = isctx ? CT_ : S_;
        const int tbase = isctx ? 0 : (dir ? (8 - ci) * 256 : (ci - 1) * 256);
        const bf16_t* src = (isctx ? PU + (size_t)(NL_ + b * CT_) * 512 : PU + (size_t)(b * S_) * 512) + hd * 64 + cc * 8;
        const int tlo = dir ? (tbase + 255 - 4 * tg - 3) : (tbase + 4 * tg);
        {
            float cwv[4][8], cbv[8];
            {
                const float4* cb4 = (const float4*)(P.in[9] + hd * 64 + cc * 8);
                const float4 c0 = cb4[0], c1 = cb4[1];
                cbv[0] = c0.x; cbv[1] = c0.y; cbv[2] = c0.z; cbv[3] = c0.w; cbv[4] = c1.x; cbv[5] = c1.y; cbv[6] = c1.z; cbv[7] = c1.w;
#pragma unroll
                for (int m = 0; m < 4; ++m) {
                    const float4* cw4 = (const float4*)(P.in[8] + m * 512 + hd * 64 + cc * 8);
                    const float4 d0 = cw4[0], d1 = cw4[1];
                    cwv[m][0] = d0.x; cwv[m][1] = d0.y; cwv[m][2] = d0.z; cwv[m][3] = d0.w;
                    cwv[m][4] = d1.x; cwv[m][5] = d1.y; cwv[m][6] = d1.z; cwv[m][7] = d1.w;
                }
            }
            float x[7][8];
#pragma unroll
            for (int m = 0; m < 7; ++m) {
                const int t = tlo - 2 + m;
                uint4 q = make_uint4(0u, 0u, 0u, 0u);
                if (t >= 0 && t < n) q = *(const uint4*)(src + (size_t)t * 512);
                x[m][0] = __uint_as_float(q.x << 16); x[m][1] = __uint_as_float(q.x & 0xffff0000u);
                x[m][2] = __uint_as_float(q.y << 16); x[m][3] = __uint_as_float(q.y & 0xffff0000u);
                x[m][4] = __uint_as_float(q.z << 16); x[m][5] = __uint_as_float(q.z & 0xffff0000u);
                x[m][6] = __uint_as_float(q.w << 16); x[m][7] = __uint_as_float(q.w & 0xffff0000u);
            }
#pragma unroll
            for (int k = 0; k < 4; ++k) {
                float v[8];
#pragma unroll
                for (int j = 0; j < 8; ++j)
                    v[j] = cbv[j] + cwv[0][j] * x[k][j] + cwv[1][j] * x[k + 1][j] + cwv[2][j] * x[k + 2][j] + cwv[3][j] * x[k + 3][j];
                const int rho = dir ? (4 * tg + 3 - k) : (4 * tg + k);
                *(uint4*)(lds + RN_V + rho * LROW + cc * 16) = make_uint4(pack2(v[0], v[1]), pack2(v[2], v[3]), pack2(v[4], v[5]), pack2(v[6], v[7]));
            }
        }
        __syncthreads();
        f32x16 acc[4];
#pragma unroll
        for (int nt = 0; nt < 4; ++nt)
#pragma unroll
            for (int e = 0; e < 16; ++e) acc[nt][e] = 0.f;
#pragma unroll
        for (int ks = 0; ks < 4; ++ks) {
            const bf16x8 fa = *(const bf16x8*)(lds + RN_V + (32 * w + r) * LROW + ks * 32 + h * 16);
#pragma unroll
            for (int nt = 0; nt < 4; ++nt) {
                const bf16x8 fb = *(const bf16x8*)(lds + RN_W + (32 * nt + r) * LROW + ks * 32 + h * 16);
                acc[nt] = MFMA32(fa, fb, acc[nt]);
            }
        }
        float av[2][16], bv[2][16];
#pragma unroll
        for (int jh = 0; jh < 2; ++jh)
#pragma unroll
            for (int e = 0; e < 16; ++e) {
                const int rho = 32 * w + crow(e, h);
                const float vv = bf2f(*(const bf16_t*)(lds + RN_V + rho * LROW + (jh * 32 + r) * 2));
                const float ra = acc[jh][e] + ba[jh], ri = acc[2 + jh][e] + bx[jh];
                const float rg = __builtin_amdgcn_rcpf(1.f + __expf(-ra));
                const float ig = __builtin_amdgcn_rcpf(1.f + __expf(-ri));
                const float la = -8.f * rg * sp[jh];
                const float x2 = 2.f * la;
                const float em = -x2 * (1.f + x2 * (0.5f + x2 * (0.16666667f + x2 * (0.041666668f + x2 * (0.0083333338f + x2 * 0.0013888889f)))));
                av[jh][e] = __expf(la);
                bv[jh][e] = __builtin_amdgcn_sqrtf(fmaxf(em, 0.f)) * ig * vv;
            }
        float s0A[2][4], s0B[2][4], PA_[2][4], PB_[2][4], WA[2], WB[2];
#pragma unroll
        for (int jh = 0; jh < 2; ++jh) {
#pragma unroll
            for (int q = 0; q < 4; ++q) {
                const float A = av[jh][4 * q] * av[jh][4 * q + 1] * av[jh][4 * q + 2] * av[jh][4 * q + 3];
                float x = bv[jh][4 * q];
                x = av[jh][4 * q + 1] * x + bv[jh][4 * q + 1];
                x = av[jh][4 * q + 2] * x + bv[jh][4 * q + 2];
                x = av[jh][4 * q + 3] * x + bv[jh][4 * q + 3];
                const float oA = shx(A, 32, lane), oB = shx(x, 32, lane);
                s0A[jh][q] = h ? oA : A;
                s0B[jh][q] = h ? oB : x;
                const float s1A = h ? A : oA, s1B = h ? x : oB;
                PA_[jh][q] = s1A * s0A[jh][q];
                PB_[jh][q] = s1A * s0B[jh][q] + s1B;
            }
            WA[jh] = PA_[jh][0] * PA_[jh][1] * PA_[jh][2] * PA_[jh][3];
            float x = PB_[jh][0];
            x = PA_[jh][1] * x + PB_[jh][1];
            x = PA_[jh][2] * x + PB_[jh][2];
            x = PA_[jh][3] * x + PB_[jh][3];
            WB[jh] = x;
            if (h == 0) {
                AGG[(w * 64 + jh * 32 + r) * 2] = WA[jh];
                AGG[(w * 64 + jh * 32 + r) * 2 + 1] = WB[jh];
            }
        }
        __syncthreads();
        float cout_[2];
        char* hvp = lds + RN_V + (32 * w + 4 * h) * LROW + r * 2;
#pragma unroll
        for (int jh = 0; jh < 2; ++jh) {
            const int j = jh * 32 + r;
            float cin = CARRY[j];
            for (int w2 = 0; w2 < w; ++w2) cin = AGG[(w2 * 64 + j) * 2] * cin + AGG[(w2 * 64 + j) * 2 + 1];
            cout_[jh] = WA[jh] * cin + WB[jh];
            float C = cin;
#pragma unroll
            for (int q = 0; q < 4; ++q) {
                const float c1 = s0A[jh][q] * C + s0B[jh][q];
                float x = h ? c1 : C;
#pragma unroll
                for (int e4 = 0; e4 < 4; ++e4) {
                    x = av[jh][4 * q + e4] * x + bv[jh][4 * q + e4];
                    if (!isctx) *(bf16_t*)(hvp + (e4 + 8 * q) * LROW + jh * 64) = f2bf(x);
                }
                C = PA_[jh][q] * C + PB_[jh][q];
            }
        }
        __syncthreads();
        if (w == 7 && h == 0) {
            CARRY[r] = cout_[0];
            CARRY[32 + r] = cout_[1];
        }
        if (!isctx) {
            const int rho = tid >> 1, hf2 = tid & 1;
            const int t = dir ? (tbase + 255 - rho) : (tbase + rho);
            const uint4* sp = (const uint4*)(lds + RN_V + rho * LROW + hf2 * 64);
            uint4* gp = (uint4*)(HS + (size_t)(b * S_ + t) * 512 + hd * 64 + hf2 * 32);
            const uint4 v0 = sp[0], v1 = sp[1], v2 = sp[2], v3 = sp[3];
            gp[0] = v0; gp[1] = v1; gp[2] = v2; gp[3] = v3;
            __syncthreads();
        }
    }
}

#define P2_RNN 128
#define P2_HY 512
DI void phase2(const Params& P, char* lds, int tid, volatile unsigned* misc, int pass) {
    unsigned* qctr = (unsigned*)(P.ws + OFF_CTL) + QUEUE_WORD + pass;
    for (;;) {
        __syncthreads();
        if (tid == 0) misc[8] = atomicAdd(qctr, 1u);
        __syncthreads();
        const int it = __builtin_amdgcn_readfirstlane((int)misc[8]);
        if (it >= P2_RNN + P2_HY) break;
        int tq = tid;
        asm volatile("" : "+v"(tq));
#ifdef PROBE_P2
        if (pass == 1 && ((PROBE_P2 == 1) != (it < P2_RNN))) continue;
#endif
        if (it < P2_RNN) rnn_item(P, it, lds, tq);
        else hyena_item(P, it - P2_RNN, lds, tq);
    }
}

#define P3_A 0
#define P3_AROW 2064
#define P3_LG 132096
#define P3_SC 148480
#define P3_RED 149760
#define CNT_WORD 4160

DI float gelu_tanh(float x) {
    const float u = 0.7978845608028654f * (x + 0.044715f * x * x * x);
    const float t = 1.f - 2.f * __builtin_amdgcn_rcpf(1.f + __expf(2.f * u));
    return 0.5f * x * (1.f + t);
}
DI float bflo(unsigned v) { return __uint_as_float(v << 16); }
DI float bfhi(unsigned v) { return __uint_as_float(v & 0xffff0000u); }

DI void p2b_item(const Params& P, int it, char* lds, int tid) {
    const int tok0 = it * 64;
    const bf16_t* PA = (const bf16_t*)(P.ws + OFF_PA);
    const bf16_t* HF = (const bf16_t*)(P.ws + OFF_HS);
    const bf16_t* HB = HF + (size_t)NL_ * 512;
    const bf16_t* YBT = (const bf16_t*)(P.ws + OFF_YBT);
    bf16_t* YN = (bf16_t*)(P.ws + OFF_YN);
    float* sc = (float*)(lds + P3_SC);
    float* red = (float*)(lds + P3_RED);
    const int lane = tid & 63, w = __builtin_amdgcn_readfirstlane(tid >> 6);
    __syncthreads();
#pragma unroll 1
    for (int i0 = 0; i0 < 8; i0 += 4) {
        uint4 pa4[4], hf4[4], hb4[4];
#pragma unroll
        for (int q = 0; q < 4; ++q) {
            const size_t g = (size_t)(tok0 + w + 8 * (i0 + q)) * 512 + lane * 8;
            pa4[q] = *(const uint4*)(PA + g); hf4[q] = *(const uint4*)(HF + g); hb4[q] = *(const uint4*)(HB + g);
        }
#pragma unroll
        for (int q = 0; q < 4; ++q) {
            const int tok = w + 8 * (i0 + q), c8 = lane;
            const unsigned pw[4] = {pa4[q].x, pa4[q].y, pa4[q].z, pa4[q].w}, fw[4] = {hf4[q].x, hf4[q].y, hf4[q].z, hf4[q].w}, bw[4] = {hb4[q].x, hb4[q].y, hb4[q].z, hb4[q].w};
            unsigned ow[4];
            float ss = 0.f;
#pragma unroll
            for (int k = 0; k < 4; ++k) {
                const float y0 = gelu_tanh(bflo(pw[k])) * (bflo(fw[k]) + bflo(bw[k]));
                const float y1 = gelu_tanh(bfhi(pw[k])) * (bfhi(fw[k]) + bfhi(bw[k]));
                ss += y0 * y0 + y1 * y1;
                ow[k] = pack2(y0, y1);
            }
            *(uint4*)(lds + P3_A + tok * P3_AROW + c8 * 16) = make_uint4(ow[0], ow[1], ow[2], ow[3]);
#pragma unroll
            for (int o = 32; o > 0; o >>= 1) ss += shx(ss, o, lane);
            if (lane == 0) sc[tok] = ss;
        }
    }
    {
        float sb[8];
#pragma unroll
        for (int e = 0; e < 8; ++e) sb[e] = 0.f;
        const int j = tid & 7;
        uint4 yv8[8];
#pragma unroll
        for (int pass = 0; pass < 8; ++pass) yv8[pass] = *(const uint4*)(YBT + (size_t)(pass * 64 + (tid >> 3)) * NL_ + tok0 + 8 * j);
#pragma unroll
        for (int pass = 0; pass < 8; ++pass) {
            const int c = pass * 64 + (tid >> 3);
            const uint4 v = yv8[pass];
            const unsigned vw[4] = {v.x, v.y, v.z, v.w};
#pragma unroll
            for (int k = 0; k < 4; ++k) {
                const float f0 = bflo(vw[k]), f1 = bfhi(vw[k]);
                sb[2 * k] += f0 * f0;
                sb[2 * k + 1] += f1 * f1;
                *(bf16_t*)(lds + P3_A + (8 * j + 2 * k) * P3_AROW + (512 + c) * 2) = (bf16_t)(vw[k] & 0xffffu);
                *(bf16_t*)(lds + P3_A + (8 * j + 2 * k + 1) * P3_AROW + (512 + c) * 2) = (bf16_t)(vw[k] >> 16);
            }
        }
#pragma unroll
        for (int e = 0; e < 8; ++e) {
            float v = sb[e];
            v += shx(v, 8, lane); v += shx(v, 16, lane); v += shx(v, 32, lane);
            if (lane < 8) red[w * 64 + 8 * j + e] = v;
        }
    }
    __syncthreads();
    if (tid < 64) {
        float ssb = 0.f;
#pragma unroll
        for (int ww = 0; ww < 8; ++ww) ssb += red[ww * 64 + tid];
        sc[128 + tid] = rsqrtf(sc[tid] * (1.f / 512.f) + 1e-6f);
        sc[192 + tid] = rsqrtf(ssb * (1.f / 512.f) + 1e-6f);
    }
    __syncthreads();
#pragma unroll 4
    for (int i = 0; i < 16; ++i) {
        const int q = tid + NTHR * i, row = q >> 7, c16 = q & 127;
        const uint4 v = *(const uint4*)(lds + P3_A + row * P3_AROW + c16 * 16);
        const float scl = sc[(c16 < 64 ? 128 : 192) + row];
        uint4 o;
        o.x = pack2(bflo(v.x) * scl, bfhi(v.x) * scl);
        o.y = pack2(bflo(v.y) * scl, bfhi(v.y) * scl);
        o.z = pack2(bflo(v.z) * scl, bfhi(v.z) * scl);
        o.w = pack2(bflo(v.w) * scl, bfhi(v.w) * scl);
        *(uint4*)(YN + (size_t)(tok0 + row) * 1024 + c16 * 8) = o;
    }
}
DI void phase2b(const Params& P, char* lds, int tid) {
    for (int it = blockIdx.x; it < NL_ / 64; it += gridDim.x) p2b_item(P, it, lds, tid);
}

struct P3Sched {
    const char* yn; const char* wt; bf16_t* y; int x, j, nj;
    DI bool next(int i, pg8::GUnit& u) const {
        const int k = j + i * nj;
        if (k >= 32) return false;
        const int pm = (k >> 2) * 8 + x, pn = k & 3;
        u.A = yn + (size_t)pm * 256 * 2048;
        u.B = wt + (size_t)pn * 256 * 2048;
        u.B1 = u.B + (size_t)128 * 2048;
        u.O = y + (size_t)pm * 256 * 1024 + pn * 256;
        u.ldc = 1024; u.valid = 256; u.aux = 0;
        return true;
    }
};
DI void phase3(const Params& P, char* lds, int tid) {
    char* ws = P.ws;
    P3Sched S{ws + OFF_YN, ws + OFF_WOUT_T, (bf16_t*)(ws + OFF_Y), (int)(blockIdx.x & 7), (int)(blockIdx.x >> 3), (int)(gridDim.x >> 3)};
    pg8::EpiStore E;
    pg8::gemm_phase<false>(lds, 1024, S, E, tid);
}

DI void p3b_item(const Params& P, int it, char* lds, int tid, int pass) {
    const int tok0 = it * 64, b = tok0 >> 11;
    const bf16_t* WRT = (const bf16_t*)(P.ws + OFF_WR_T);
    bf16_t* H2 = (bf16_t*)(P.ws + OFF_H2);
    const float* mod = (const float*)(P.ws + OFF_MOD) + b * 6144;
    float* LG = (float*)(lds + P3_LG);
    const int lane = tid & 63, w = __builtin_amdgcn_readfirstlane(tid >> 6), r = lane & 31, h = lane >> 5;
    __syncthreads();
    const bf16_t* Y = (const bf16_t*)(P.ws + OFF_Y);
    const float* pe = (const float*)(P.ws + OFF_PE);
#pragma unroll 1
    for (int rb = 0; rb < 8; rb += 4) {
        float4 xv[4][4];
#pragma unroll
        for (int q = 0; q < 4; ++q) {
            const int tok = tok0 + w * 8 + rb + q, t = tok & 2047;
#pragma unroll
            for (int i2 = 0; i2 < 2; ++i2) {
                const int d = i2 * 512 + lane * 8;
                const float4 xa = *(const float4*)(P.in[0] + (size_t)tok * 1024 + d), xb = *(const float4*)(P.in[0] + (size_t)tok * 1024 + d + 4);
                const uint4 yv = *(const uint4*)(Y + (size_t)tok * 1024 + d);
                const float* pp = i2 ? pe + (t & 63) * 512 + lane * 8 : pe + (t >> 6) * 512 + lane * 8;
                const float4 pa = *(const float4*)pp, pb = *(const float4*)(pp + 4);
                const float4 ga = *(const float4*)(mod + 2048 + d), gb = *(const float4*)(mod + 2048 + d + 4);
                float4 oa, ob;
                oa.x = xa.x + pa.x + ga.x * bflo(yv.x); oa.y = xa.y + pa.y + ga.y * bfhi(yv.x);
                oa.z = xa.z + pa.z + ga.z * bflo(yv.y); oa.w = xa.w + pa.w + ga.w * bfhi(yv.y);
                ob.x = xb.x + pb.x + gb.x * bflo(yv.z); ob.y = xb.y + pb.y + gb.y * bfhi(yv.z);
                ob.z = xb.z + pb.z + gb.z * bflo(yv.w); ob.w = xb.w + pb.w + gb.w * bfhi(yv.w);
                *(float4*)(P.out + (size_t)tok * 1024 + d) = oa;
                *(float4*)(P.out + (size_t)tok * 1024 + d + 4) = ob;
                xv[q][2 * i2] = oa;
                xv[q][2 * i2 + 1] = ob;
            }
        }
        float ss[4];
#pragma unroll
        for (int q = 0; q < 4; ++q) {
            ss[q] = 0.f;
#pragma unroll
            for (int i = 0; i < 4; ++i) ss[q] += xv[q][i].x * xv[q][i].x + xv[q][i].y * xv[q][i].y + xv[q][i].z * xv[q][i].z + xv[q][i].w * xv[q][i].w;
        }
#pragma unroll
        for (int o = 32; o > 0; o >>= 1)
#pragma unroll
            for (int q = 0; q < 4; ++q) ss[q] += shx(ss[q], o, lane);
#pragma unroll
        for (int i2 = 0; i2 < 2; ++i2) {
            const int d = i2 * 512 + lane * 8;
            float gm[8], shf[8];
#pragma unroll
            for (int hh = 0; hh < 2; ++hh) {
                const float4 gn = *(const float4*)(P.in[28] + d + 4 * hh), s2v = *(const float4*)(mod + 4096 + d + 4 * hh), shv = *(const float4*)(mod + 3072 + d + 4 * hh);
                gm[4 * hh + 0] = gn.x * (1.f + s2v.x); gm[4 * hh + 1] = gn.y * (1.f + s2v.y); gm[4 * hh + 2] = gn.z * (1.f + s2v.z); gm[4 * hh + 3] = gn.w * (1.f + s2v.w);
                shf[4 * hh + 0] = shv.x; shf[4 * hh + 1] = shv.y; shf[4 * hh + 2] = shv.z; shf[4 * hh + 3] = shv.w;
            }
#pragma unroll
            for (int q = 0; q < 4; ++q) {
                const int row = w * 8 + rb + q;
                const float rs = rsqrtf(ss[q] * (1.f / 1024.f) + 1e-6f);
                const float4 a = xv[q][2 * i2], bq = xv[q][2 * i2 + 1];
                uint4 pk;
                pk.x = pack2(a.x * rs * gm[0] + shf[0], a.y * rs * gm[1] + shf[1]);
                pk.y = pack2(a.z * rs * gm[2] + shf[2], a.w * rs * gm[3] + shf[3]);
                pk.z = pack2(bq.x * rs * gm[4] + shf[4], bq.y * rs * gm[5] + shf[5]);
                pk.w = pack2(bq.z * rs * gm[6] + shf[6], bq.w * rs * gm[7] + shf[7]);
                *(uint4*)(H2 + (size_t)(tok0 + row) * 1024 + d) = pk;
                *(uint4*)(lds + P3_A + row * P3_AROW + d * 2) = pk;
            }
        }
    }
    __syncthreads();
    if (w < 4) {
        const int mi = w >> 1, ni = w & 1;
        f32x16 lg;
#pragma unroll
        for (int e = 0; e < 16; ++e) lg[e] = 0.f;
        const bf16_t* wr = WRT + (size_t)(32 * ni + r) * 1024 + 8 * h;
        const char* ar = lds + P3_A + (32 * mi + r) * P3_AROW + 16 * h;
#pragma unroll 8
        for (int ks = 0; ks < 64; ++ks) {
            const bf16x8 fa = *(const bf16x8*)(ar + ks * 32);
            const bf16x8 fbb = *(const bf16x8*)(wr + ks * 16);
            lg = MFMA32(fa, fbb, lg);
        }
        const int nn = 32 * ni + r;
        const float bias = (nn < 4) ? P.in[30][nn] : ((nn < 36) ? P.in[32][nn - 4] : 0.f);
#pragma unroll
        for (int e = 0; e < 16; ++e) LG[(32 * mi + crow(e, h)) * 64 + nn] = lg[e] + bias;
    }
    __syncthreads();
    int* lcnt = (int*)(lds + P3_RED);
    int* lbase = lcnt + 32;
    if (tid < 32) lcnt[tid] = 0;
    __syncthreads();
    int ex0 = 0, ex1 = 0, r0 = 0, r1 = 0;
    float w0 = 0.f, w1 = 0.f;
    if (tid < 64 && pass == 0) {
        const float* l = LG + tid * 64;
        int gi = 0;
        float gmx = l[0];
        for (int j = 1; j < 4; ++j) if (l[j] > gmx) { gmx = l[j]; gi = j; }
        float gs = 0.f;
        for (int j = 0; j < 4; ++j) gs += __expf(l[j] - gmx);
        const float gp = 1.f / gs;
        const float* el = l + 4 + gi * 8;
        int e0 = 0;
        float m0 = el[0];
        for (int j = 1; j < 8; ++j) if (el[j] > m0) { m0 = el[j]; e0 = j; }
        int e1 = 0;
        float m1 = -1e30f;
        for (int j = 0; j < 8; ++j) if (j != e0 && el[j] > m1) { m1 = el[j]; e1 = j; }
        const float p1 = __expf(m1 - m0);
        w0 = gp / (1.f + p1);
        w1 = gp * p1 / (1.f + p1);
        ex0 = gi * 8 + e0;
        ex1 = gi * 8 + e1;
        r0 = atomicAdd(&lcnt[ex0], 1);
        r1 = atomicAdd(&lcnt[ex1], 1);
    }
    __syncthreads();
    if (tid < 32 && pass == 0) {
        const int c = lcnt[tid];
        unsigned* cnt = (unsigned*)(P.ws + OFF_CTL) + CNT_WORD;
        lbase[tid] = (c > 0) ? (int)atomicAdd(&cnt[tid * 64], (unsigned)c) : 0;
    }
    __syncthreads();
    if (tid < 64 && pass == 0) {
        const int tok = tok0 + tid;
        unsigned* LIST = (unsigned*)(P.ws + OFF_LIST);
        unsigned* TS = (unsigned*)(P.ws + OFF_TOKSLOT);
        float* EW = (float*)(P.ws + OFF_EW);
        const unsigned p0 = (unsigned)(lbase[ex0] + r0), p1i = (unsigned)(lbase[ex1] + r1);
        LIST[ex0 * 16384 + p0] = tok * 2;
        TS[tok * 2] = ((unsigned)ex0 << 16) | p0;
        EW[tok * 2] = w0;
        LIST[ex1 * 16384 + p1i] = tok * 2 + 1;
        TS[tok * 2 + 1] = ((unsigned)ex1 << 16) | p1i;
        EW[tok * 2 + 1] = w1;
    }
}
DI void phase3b(const Params& P, char* lds, int tid, int pass) {
    for (int it = blockIdx.x; it < NL_ / 64; it += gridDim.x) p3b_item(P, it, lds, tid, pass);
}

#define MISC_TB 16
#define MISC_SB 56
#define MISC_CNT 96
DI void moe_tables(const Params& P, volatile unsigned* misc, int tid) {
    __syncthreads();
    if (tid == 0) {
        unsigned* cnt = (unsigned*)(P.ws + OFF_CTL) + CNT_WORD;
        unsigned t = 0, sb = 0;
        for (int e = 0; e < 32; ++e) {
            const unsigned c = __hip_atomic_load(&cnt[e * 64], __ATOMIC_RELAXED, __HIP_MEMORY_SCOPE_AGENT);
            misc[MISC_TB + e] = t;
            misc[MISC_SB + e] = sb;
            misc[MISC_CNT + e] = c;
            t += (c + 255u) >> 8;
            sb += c;
        }
        misc[MISC_TB + 32] = t;
    }
    __syncthreads();
}

struct MoeTile { int e, mt, ntile, valid, pos0; };
DI int moe_label_items(volatile unsigned* misc, int x) {
    int n = 0;
#pragma unroll
    for (int q = 0; q < 4; ++q) n += (int)((misc[MISC_CNT + x + 8 * q] + 255u) >> 8);
    return n * 8;
}
DI MoeTile moe_tile(volatile unsigned* misc, int x, int k) {
    MoeTile t;
    int mtg = k >> 3;
    t.ntile = k & 7;
    int e = x;
    bool more = true;
#pragma unroll
    for (int q = 0; q < 3; ++q) {
        const int tiles = (int)((misc[MISC_CNT + e] + 255u) >> 8);
        if (more && mtg >= tiles) { mtg -= tiles; e += 8; } else more = false;
    }
    t.e = e;
    t.mt = mtg;
    t.valid = min(256, (int)misc[MISC_CNT + e] - mtg * 256);
    t.pos0 = (int)misc[MISC_SB + e] + mtg * 256;
    return t;
}
struct EpiAct {
    DI void operator()(const pg8::f32x4r (&acc)[2][2][4][2], const pg8::GUnit& u, int wr, int wc, int fr, int fq, char* lds) const {
        asm volatile("" : "+v"(fr), "+v"(fq));
#pragma unroll
        for (int ai = 0; ai < 2; ++ai)
#pragma unroll
            for (int m = 0; m < 4; ++m) {
                const int r = ai * 128 + wr * 64 + m * 16 + fr;
                if (r < u.valid) {
                    float a[8];
#pragma unroll
                    for (int n = 0; n < 2; ++n)
#pragma unroll
                        for (int k = 0; k < 4; ++k) {
                            const float gt = acc[ai][0][m][n][k], up = acc[ai][1][m][n][k];
                            a[4 * n + k] = gt * __builtin_amdgcn_rcpf(1.f + __expf(-gt)) * up;
                        }
                    u32x4 w;
                    w.x = pg8::cvt_pk_bf16(a[0], a[1]); w.y = pg8::cvt_pk_bf16(a[2], a[3]); w.z = pg8::cvt_pk_bf16(a[4], a[5]); w.w = pg8::cvt_pk_bf16(a[6], a[7]);
                    *(u32x4*)(u.O + (size_t)r * u.ldc + wc * 32 + 8 * fq) = w;
                }
            }
    }
};
struct P4Sched {
    const char* h2; const char* wg; const char* wu; bf16_t* act; const unsigned* list; int x, j, nj, total;
    int c0, c1, c2, c3, b0, b1, b2, b3;
    int r0, cb0, r1, cb1;
    DI bool next(int i, pg8::GUnit& u) const {
        const int k = j + i * nj;
        if (k >= total) return false;
        int mtg = k >> 2;
        const int nu = k & 3;
        const int t0 = (c0 + 255) >> 8, t1 = (c1 + 255) >> 8, t2 = (c2 + 255) >> 8;
        int q = 0, c = c0, b = b0;
        if (mtg >= t0) {
            mtg -= t0; q = 1; c = c1; b = b1;
            if (mtg >= t1) {
                mtg -= t1; q = 2; c = c2; b = b2;
                if (mtg >= t2) { mtg -= t2; q = 3; c = c3; b = b3; }
            }
        }
        const int e = x + 8 * q, pos0 = b + mtg * 256;
        u.A = h2;
        u.B = wg + (size_t)(e * 512 + nu * 128) * 2048;
        u.B1 = wu + (size_t)(e * 512 + nu * 128) * 2048;
        u.O = act + (size_t)pos0 * 512 + nu * 128;
        u.ldc = 512;
        u.valid = min(256, c - mtg * 256);
        u.aux = pos0;
        const unsigned* lp = list + e * 16384 + mtg * 256;
        const int vm = u.valid - 1;
        u.ga[0][0] = h2 + (size_t)(lp[min(r0, vm)] >> 1) * 2048 + cb0;
        u.ga[0][1] = h2 + (size_t)(lp[min(r1, vm)] >> 1) * 2048 + cb1;
        u.ga[1][0] = h2 + (size_t)(lp[min(128 + r0, vm)] >> 1) * 2048 + cb0;
        u.ga[1][1] = h2 + (size_t)(lp[min(128 + r1, vm)] >> 1) * 2048 + cb1;
        return true;
    }
};
DI void phase4(const Params& P, char* lds, int tid, volatile unsigned* misc) {
    moe_tables(P, misc, tid);
    {
        const int p = blockIdx.x * 128 + tid;
        if (tid < 128 && p < 2 * NL_) {
            int e = 0;
            for (int q = 1; q < 32; ++q) e = ((int)misc[MISC_SB + q] <= p) ? q : e;
            const unsigned slot = ((const unsigned*)(P.ws + OFF_LIST))[e * 16384 + (p - (int)misc[MISC_SB + e])];
            ((float*)(P.ws + OFF_EWS))[p] = ((const float*)(P.ws + OFF_EW))[slot];
        }
    }
    char* ws = P.ws;
    const int x = (int)(blockIdx.x & 7);
    const int c0 = __builtin_amdgcn_readfirstlane((int)misc[MISC_CNT + x]), c1 = __builtin_amdgcn_readfirstlane((int)misc[MISC_CNT + x + 8]);
    const int c2 = __builtin_amdgcn_readfirstlane((int)misc[MISC_CNT + x + 16]), c3 = __builtin_amdgcn_readfirstlane((int)misc[MISC_CNT + x + 24]);
    const int b0 = __builtin_amdgcn_readfirstlane((int)misc[MISC_SB + x]), b1 = __builtin_amdgcn_readfirstlane((int)misc[MISC_SB + x + 8]);
    const int b2 = __builtin_amdgcn_readfirstlane((int)misc[MISC_SB + x + 16]), b3 = __builtin_amdgcn_readfirstlane((int)misc[MISC_SB + x + 24]);
    const int total = 4 * (((c0 + 255) >> 8) + ((c1 + 255) >> 8) + ((c2 + 255) >> 8) + ((c3 + 255) >> 8));
    int r0, cc0, r1, cc1;
    pg8::stage_piece(tid, 0, r0, cc0);
    pg8::stage_piece(tid, 1, r1, cc1);
    const P4Sched S{ws + OFF_H2, ws + OFF_WG_T, ws + OFF_WU_T, (bf16_t*)(ws + OFF_ACT), (const unsigned*)(ws + OFF_LIST), x, (int)(blockIdx.x >> 3), (int)(gridDim.x >> 3), total,
                    c0, c1, c2, c3, b0, b1, b2, b3, r0, cc0 * 2, r1, cc1 * 2};
    const EpiAct E;
    pg8::gemm_phase<true>(lds, 1024, S, E, tid);
}

struct EpiDown {
    const float* ews;
    DI void operator()(const pg8::f32x4r (&acc)[2][2][4][2], const pg8::GUnit& u, int wr, int wc, int fr, int fq, char* lds) const {
        asm volatile("" : "+v"(fr), "+v"(fq));
#pragma unroll
        for (int ai = 0; ai < 2; ++ai)
#pragma unroll
            for (int m = 0; m < 4; ++m) {
                const int r = ai * 128 + wr * 64 + m * 16 + fr;
                if (r < u.valid) {
                    const float wv = ews[u.aux + r];
                    bf16_t* rowp = u.O + (size_t)r * u.ldc + wc * 32 + 8 * fq;
#pragma unroll
                    for (int bj = 0; bj < 2; ++bj) {
                        const pg8::f32x4r v0 = acc[ai][bj][m][0] * wv, v1 = acc[ai][bj][m][1] * wv;
                        u32x4 w;
                        w.x = pg8::cvt_pk_bf16(v0[0], v0[1]); w.y = pg8::cvt_pk_bf16(v0[2], v0[3]); w.z = pg8::cvt_pk_bf16(v1[0], v1[1]); w.w = pg8::cvt_pk_bf16(v1[2], v1[3]);
                        *(u32x4*)(rowp + bj * 128) = w;
                    }
                }
                asm volatile("" ::: "memory");
            }
    }
};
struct P5Sched {
    const char* act; const char* wd; bf16_t* slot; int x, j, nj, total;
    int c0, c1, c2, c3, b0, b1, b2, b3;
    DI bool next(int i, pg8::GUnit& u) const {
        const int k = j + i * nj;
        if (k >= total) return false;
        int mtg = k >> 2;
        const int pn = k & 3;
        const int t0 = (c0 + 255) >> 8, t1 = (c1 + 255) >> 8, t2 = (c2 + 255) >> 8;
        int q = 0, c = c0, b = b0;
        if (mtg >= t0) {
            mtg -= t0; q = 1; c = c1; b = b1;
            if (mtg >= t1) {
                mtg -= t1; q = 2; c = c2; b = b2;
                if (mtg >= t2) { mtg -= t2; q = 3; c = c3; b = b3; }
            }
        }
        const int e = x + 8 * q, pos0 = b + mtg * 256;
        u.A = act + (size_t)pos0 * 1024;
        u.B = wd + (size_t)(e * 1024 + pn * 256) * 1024;
        u.B1 = u.B + (size_t)128 * 1024;
        u.O = slot + (size_t)pos0 * 1024 + pn * 256;
        u.ldc = 1024;
        u.valid = min(256, c - mtg * 256);
        u.aux = pos0;
        return true;
    }
};
DI void phase5(const Params& P, char* lds, int tid, volatile unsigned* misc) {
    char* ws = P.ws;
    const int x = (int)(blockIdx.x & 7);
    const int c0 = __builtin_amdgcn_readfirstlane((int)misc[MISC_CNT + x]), c1 = __builtin_amdgcn_readfirstlane((int)misc[MISC_CNT + x + 8]);
    const int c2 = __builtin_amdgcn_readfirstlane((int)misc[MISC_CNT + x + 16]), c3 = __builtin_amdgcn_readfirstlane((int)misc[MISC_CNT + x + 24]);
    const int b0 = __builtin_amdgcn_readfirstlane((int)misc[MISC_SB + x]), b1 = __builtin_amdgcn_readfirstlane((int)misc[MISC_SB + x + 8]);
    const int b2 = __builtin_amdgcn_readfirstlane((int)misc[MISC_SB + x + 16]), b3 = __builtin_amdgcn_readfirstlane((int)misc[MISC_SB + x + 24]);
    const int total = 4 * (((c0 + 255) >> 8) + ((c1 + 255) >> 8) + ((c2 + 255) >> 8) + ((c3 + 255) >> 8));
    const P5Sched S{ws + OFF_ACT, ws + OFF_WD_T, (bf16_t*)(ws + OFF_SLOT), x, (int)(blockIdx.x >> 3), (int)(gridDim.x >> 3), total, c0, c1, c2, c3, b0, b1, b2, b3};
    const EpiDown E{(const float*)(ws + OFF_EWS)};
    pg8::gemm_phase<false>(lds, 512, S, E, tid);
}

DI void phase6(const Params& P, int tid, volatile unsigned* misc, bool dummy) {
    const bf16_t* SLOT = (const bf16_t*)(P.ws + OFF_SLOT);
    const unsigned* TS = (const unsigned*)(P.ws + OFF_TOKSLOT);
    const float* modb = (const float*)(P.ws + OFF_MOD);
    const int lane = tid & 63, w = tid >> 6;
    for (int it = blockIdx.x; it < NL_ / 8; it += gridDim.x) {
        const int tok = it * 8 + w;
        const float* g2 = modb + (tok >> 11) * 6144 + 5120;
        const unsigned t0 = TS[tok * 2], t1 = TS[tok * 2 + 1];
        const bf16_t* s0 = SLOT + (size_t)(misc[MISC_SB + (t0 >> 16)] + (t0 & 0xffffu)) * 1024;
        const bf16_t* s1 = SLOT + (size_t)(misc[MISC_SB + (t1 >> 16)] + (t1 & 0xffffu)) * 1024;
        float* xo = P.out + (size_t)tok * 1024;
        float* xw = dummy ? (float*)(P.ws + OFF_H1) + (size_t)tok * 1024 : xo;
        float v[16];
        float ss = 0.f;
        float4 xv4[4], gv4[4];
        uint2 sa4[4], sb4[4];
#pragma unroll
        for (int i = 0; i < 4; ++i) {
            const int d = i * 256 + lane * 4;
            xv4[i] = *(const float4*)(xo + d);
            gv4[i] = *(const float4*)(g2 + d);
            sa4[i] = *(const uint2*)(s0 + d);
            sb4[i] = *(const uint2*)(s1 + d);
        }
#pragma unroll
        for (int i = 0; i < 4; ++i) {
            const float4 xv = xv4[i], gv = gv4[i];
            const uint2 a = sa4[i], bq = sb4[i];
            v[i * 4 + 0] = xv.x + gv.x * (bflo(a.x) + bflo(bq.x));
            v[i * 4 + 1] = xv.y + gv.y * (bfhi(a.x) + bfhi(bq.x));
            v[i * 4 + 2] = xv.z + gv.z * (bflo(a.y) + bflo(bq.y));
            v[i * 4 + 3] = xv.w + gv.w * (bfhi(a.y) + bfhi(bq.y));
            ss += v[i * 4] * v[i * 4] + v[i * 4 + 1] * v[i * 4 + 1] + v[i * 4 + 2] * v[i * 4 + 2] + v[i * 4 + 3] * v[i * 4 + 3];
        }
#pragma unroll
        for (int o = 32; o > 0; o >>= 1) ss += shx(ss, o, lane);
        const float rstd = rsqrtf(ss * (1.f / 1024.f) + 1e-6f);
#pragma unroll
        for (int i = 0; i < 4; ++i) {
            const int d = i * 256 + lane * 4;
            const float4 fg = *(const float4*)(P.in[36] + d);
            float4 o;
            o.x = v[i * 4 + 0] * rstd * fg.x; o.y = v[i * 4 + 1] * rstd * fg.y;
            o.z = v[i * 4 + 2] * rstd * fg.z; o.w = v[i * 4 + 3] * rstd * fg.w;
            *(float4*)(xw + d) = o;
        }
    }
}

#define NPHASE 10
DI void run_phase(const Params& P, int ph, int pass, int npass, char* lds, int tq, volatile unsigned* misc) {
    if (ph == 0) phase0a(P, lds, tq);
    else if (ph == 1) phase0b(P, lds, tq);
    else if (ph == 2) phase1(P, lds, tq);
    else if (ph == 3) phase2(P, lds, tq, misc, pass);
    else if (ph == 4) phase2b(P, lds, tq);
    else if (ph == 5) phase3(P, lds, tq);
    else if (ph == 6) phase3b(P, lds, tq, pass);
    else if (ph == 7) phase4(P, lds, tq, misc);
    else if (ph == 8) phase5(P, lds, tq, misc);
    else if (ph == 9) phase6(P, tq, misc, pass + 1 < npass);
}
__global__ void __launch_bounds__(NTHR, 2) mk_fwd(Params P, int ph_lo, int ph_hi, int rep_mask) {
    extern __shared__ __attribute__((aligned(16))) char lds[];
    const int tid = threadIdx.x;
    volatile unsigned* misc = (volatile unsigned*)(lds + LDS_MISC);
    if (tid < 256) misc[tid] = 0u;
    __syncthreads();
    XcdBarrier bar = xcd_barrier_post((unsigned*)(P.ws + OFF_CTL), misc);
#ifdef PROBE_PH
    unsigned long long pt0 = 0ull, pdt = 0ull;
#define MK_PROBE_BEGIN(k) if ((k) == PROBE_PH) pt0 = __builtin_amdgcn_s_memrealtime();
#define MK_PROBE_END(k) if ((k) == PROBE_PH) pdt = __builtin_amdgcn_s_memrealtime() - pt0;
#define MK_BAR_ALWAYS 1
#else
#define MK_PROBE_BEGIN(k)
#define MK_PROBE_END(k)
#define MK_BAR_ALWAYS 0
#endif
#define MK_PHASE(k)                                                                                           \
    if (ph_lo <= (k) && (k) < ph_hi) {                                                                        \
        const int npass = ((rep_mask >> (k)) & 1) ? 2 : 1;     \
        MK_PROBE_BEGIN(k)                                                                                     \
        for (int pass = 0; pass < npass; ++pass) {                                                            \
            int tq = tid;                                                                                     \
            asm volatile("" : "+v"(tq));                                                                      \
            run_phase(P, (k), pass, npass, lds, tq, misc);                                                    \
            if (MK_BAR_ALWAYS || pass + 1 < npass || (k) + 1 < ph_hi) xcd_barrier(bar);                        \
        }                                                                                                     \
        MK_PROBE_END(k)                                                                                       \
    }
    MK_PHASE(0) MK_PHASE(1) MK_PHASE(2) MK_PHASE(3) MK_PHASE(4) MK_PHASE(5) MK_PHASE(6) MK_PHASE(7) MK_PHASE(8) MK_PHASE(9)
#ifdef EXTRA_BARRIERS
    for (int q = 0; q < EXTRA_BARRIERS; ++q) xcd_barrier(bar);
#endif
#ifdef PROBE_P0
    if (blockIdx.x == PROBE_BLK) {
        const unsigned long long tend = __builtin_amdgcn_s_memrealtime() + 4ull * misc[PROBE_P0];
        while (__builtin_amdgcn_s_memrealtime() < tend) __builtin_amdgcn_s_sleep(20);
    }
#endif
#ifdef PROBE_HY
    if (blockIdx.x == 0) {
        const unsigned long long tend = __builtin_amdgcn_s_memrealtime() + (PROBE_HY > 0 ? (unsigned long long)PROBE_HY * misc[200] : (PROBE_HY == 0 ? (unsigned long long)misc[201] * 2000ull : (unsigned long long)misc[202]));
        while (__builtin_amdgcn_s_memrealtime() < tend) __builtin_amdgcn_s_sleep(20);
    }
#endif
#ifdef PROBE_PH
    if (blockIdx.x == 0) {
        const unsigned long long tend = __builtin_amdgcn_s_memrealtime() + 4ull * pdt;
        while (__builtin_amdgcn_s_memrealtime() < tend) __builtin_amdgcn_s_sleep(20);
    }
#endif
}

extern "C" void kernel_launch(void* const* d_in, const int* in_sizes, int n_in, void* d_out, int out_size, void* d_ws,
                              size_t ws_size, hipStream_t stream) {
    static int grid = 0;
    if (grid == 0) {
        int dev = 0, cus = 0, per_cu = 0;
        hipGetDevice(&dev);
        hipDeviceGetAttribute(&cus, hipDeviceAttributeMultiprocessorCount, dev);
        hipFuncSetAttribute((const void*)mk_fwd, hipFuncAttributeMaxDynamicSharedMemorySize, LDS_BYTES);
        hipOccupancyMaxActiveBlocksPerMultiprocessor(&per_cu, (const void*)mk_fwd, NTHR, LDS_BYTES);
        (void)hipGetLastError();
        grid = (per_cu >= 1 && ws_size >= WS_END && n_in == 37 && (cus % 8) == 0) ? cus : -1;
        if (grid < 0) fprintf(stderr, "kernel_launch: refusing to launch (per_cu %d, ws %zu, n_in %d)\n", per_cu, ws_size, n_in);
    }
    if (grid < 0) return;
    Params P{};
    for (int i = 0; i < 37; ++i) P.in[i] = (const float*)d_in[i];
    P.out = (float*)d_out;
    P.ws = (char*)d_ws;
    char* ws = (char*)d_ws;

    hipMemsetAsync(ws + OFF_CTL, 0, CTL_BYTES, stream);
    hipLaunchKernelGGL(mk_fwd, dim3(grid), dim3(NTHR), LDS_BYTES, stream, P, 0, NPHASE, REP_MASK);
}
```
